# Optimizing an MI355X kernel written in HIP

```python
import jax, jax.numpy as jnp
from jax import lax
import numpy as np

D_MODEL = 4096
BATCH = 4
SEQ = 4096
DEPTH = 1

HEAD_DIM = 128
SWA_Q_HEADS = D_MODEL // (2 * HEAD_DIM)
SWA_KV_HEADS = SWA_Q_HEADS // 4
SWA_GROUP = SWA_Q_HEADS // SWA_KV_HEADS
SWA_WINDOW = 128
SB_HEADS = D_MODEL // (2 * HEAD_DIM)
BLOCK = 128
D_FF = 4 * D_MODEL
ROPE_THETA = 10000.0
NORM_EPS = 1e-6
N_BRANCHES = 2
N_MOD = 6

SWA_Q_W = SWA_Q_HEADS * HEAD_DIM
SWA_KV_W = SWA_KV_HEADS * HEAD_DIM
SB_W = SB_HEADS * HEAD_DIM
D_IN = SWA_Q_W + 2 * SWA_KV_W + 3 * SB_W
IN_SPLITS = tuple(int(v) for v in np.cumsum(
    [SWA_Q_W, SWA_KV_W, SWA_KV_W, SB_W, SB_W]))

kernel_name = "hybrid_swa_stickbreaking_gated_block"


def rms_norm(x, g):
    xf = x.astype(jnp.float32)
    y = xf * lax.rsqrt(jnp.mean(xf * xf, axis=-1, keepdims=True) + NORM_EPS)
    return (y * g.astype(jnp.float32)).astype(x.dtype)


def rope_tables(seq_len):
    inv_freq = 1.0 / (ROPE_THETA ** (jnp.arange(0, HEAD_DIM, 2, dtype=jnp.float32) / HEAD_DIM))
    ang = jnp.arange(seq_len, dtype=jnp.float32)[:, None] * inv_freq[None, :]
    return jnp.cos(ang), jnp.sin(ang)


def apply_rope(x, cos, sin):
    xf = x.astype(jnp.float32)
    x1, x2 = jnp.split(xf, 2, axis=-1)
    c = cos[None, :, None, :]
    s = sin[None, :, None, :]
    return jnp.concatenate([x1 * c - x2 * s, x2 * c + x1 * s], axis=-1).astype(x.dtype)


def sliding_window_gqa(q, k, v, sinks):
    b, s = q.shape[0], q.shape[1]
    nb = s // BLOCK
    qb = q.reshape(b, nb, BLOCK, SWA_KV_HEADS, SWA_GROUP, HEAD_DIM)

    def with_prev(t):
        tb = t.reshape(b, nb, BLOCK, SWA_KV_HEADS, HEAD_DIM)
        prev = jnp.pad(tb[:, :-1], ((0, 0), (1, 0), (0, 0), (0, 0), (0, 0)))
        return jnp.concatenate([prev, tb], axis=2)

    kw, vw = with_prev(k), with_prev(v)
    scores = jnp.einsum('bnqhgd,bnkhd->bnhgqk', qb, kw).astype(jnp.float32) * (HEAD_DIM ** -0.5)
    qi = jnp.arange(BLOCK)[:, None]
    kj = jnp.arange(2 * BLOCK)[None, :]
    diff = qi + BLOCK - kj
    band = (diff >= 0) & (diff < SWA_WINDOW)
    blk = jnp.arange(nb)[:, None, None]
    valid = band[None] & ((blk > 0) | (kj >= BLOCK)[None])
    scores = jnp.where(valid[None, :, None, None], scores, -jnp.inf)
    sink = sinks.astype(jnp.float32).reshape(SWA_KV_HEADS, SWA_GROUP)[None, None, :, :, None, None]
    m = jnp.maximum(jnp.max(scores, axis=-1, keepdims=True), sink)
    p = jnp.exp(scores - m)
    denom = jnp.sum(p, axis=-1, keepdims=True) + jnp.exp(sink - m)
    probs = (p / denom).astype(v.dtype)
    out = jnp.einsum('bnhgqk,bnkhd->bnqhgd', probs, vw)
    return out.reshape(b, s, SWA_Q_HEADS * HEAD_DIM)


def stick_breaking_attention(q, k, v):
    b, s = q.shape[0], q.shape[1]
    nb = s // BLOCK
    qb = q.reshape(b, nb, BLOCK, SB_HEADS, HEAD_DIM).transpose(1, 0, 2, 3, 4)
    key_pos = jnp.arange(s)

    def one_block(args):
        q_blk, n = args
        z = jnp.einsum('bqhd,bshd->bhqs', q_blk, k).astype(jnp.float32) * (HEAD_DIM ** -0.5)
        t = n * BLOCK + jnp.arange(BLOCK)
        valid = key_pos[None, :] < t[:, None]
        log_beta = jax.nn.log_sigmoid(z)
        log_one_minus = jnp.where(valid, log_beta - z, 0.0)
        suffix = lax.cumsum(log_one_minus, axis=3, reverse=True) - log_one_minus
        att = jnp.where(valid, jnp.exp(log_beta + suffix), 0.0)
        return jnp.einsum('bhqs,bshd->bqhd', att.astype(v.dtype), v)

    out = lax.map(one_block, (qb, jnp.arange(nb)))
    return out.transpose(1, 0, 2, 3, 4).reshape(b, s, SB_HEADS * HEAD_DIM)


def setup_inputs(seed: int = 0) -> dict:
    key = jax.random.key(seed)
    ks = jax.random.split(key, 20)
    f32 = jnp.float32

    def nrm(k, shape, fan_in):
        return jax.random.normal(k, shape, f32) * (fan_in ** -0.5)

    def gain(k):
        return 1.0 + 0.05 * jax.random.normal(k, (DEPTH, D_MODEL), f32)

    return {
        "x": jax.random.normal(ks[0], (BATCH, SEQ, D_MODEL), f32),
        "c": jax.random.normal(ks[1], (BATCH, D_MODEL), f32),
        "w_ada": nrm(ks[2], (DEPTH, D_MODEL, N_MOD * D_MODEL), D_MODEL) * 0.5,
        "b_ada": 0.02 * jax.random.normal(ks[3], (DEPTH, N_MOD * D_MODEL), f32),
        "g_pre_mix": gain(ks[4]),
        "g_post_mix": gain(ks[5]),
        "g_pre_mlp": gain(ks[6]),
        "g_post_mlp": gain(ks[7]),
        "w_in": nrm(ks[8], (DEPTH, D_MODEL, D_IN), D_MODEL),
        "attn_sinks": 0.5 * jax.random.normal(ks[9], (DEPTH, SWA_Q_HEADS), f32),
        "w_branch_gate": nrm(ks[10], (DEPTH, D_MODEL, N_BRANCHES * D_MODEL), D_MODEL),
        "b_branch_gate": 0.02 * jax.random.normal(ks[11], (DEPTH, N_BRANCHES * D_MODEL), f32),
        "w_proj_swa": nrm(ks[12], (DEPTH, SWA_Q_W, D_MODEL), SWA_Q_W),
        "w_proj_sb": nrm(ks[13], (DEPTH, SB_W, D_MODEL), SB_W),
        "w_out": nrm(ks[14], (DEPTH, D_MODEL, D_MODEL), D_MODEL),
        "w_ff_in": nrm(ks[15], (DEPTH, D_MODEL, D_FF), D_MODEL),
        "w_ff_out": nrm(ks[16], (DEPTH, D_FF, D_MODEL), D_FF),
    }


def reference(x, c, w_ada, b_ada, g_pre_mix, g_post_mix, g_pre_mlp, g_post_mlp,
              w_in, attn_sinks, w_branch_gate, b_branch_gate, w_proj_swa, w_proj_sb,
              w_out, w_ff_in, w_ff_out):
    b, s = x.shape[0], x.shape[1]
    cos, sin = rope_tables(s)
    c_act = jax.nn.silu(c)
    for l in range(DEPTH):
        mod = c_act @ w_ada[l] + b_ada[l]
        shift1, scale1, gate1, shift2, scale2, gate2 = [m[:, None, :] for m in jnp.split(mod, N_MOD, axis=-1)]

        h = rms_norm(x, g_pre_mix[l]) * (1.0 + scale1) + shift1
        proj = h @ w_in[l]
        qa, ka, va, qb_, kb_, vb_ = jnp.split(proj, IN_SPLITS, axis=-1)
        qa = apply_rope(qa.reshape(b, s, SWA_Q_HEADS, HEAD_DIM), cos, sin)
        ka = apply_rope(ka.reshape(b, s, SWA_KV_HEADS, HEAD_DIM), cos, sin)
        va = va.reshape(b, s, SWA_KV_HEADS, HEAD_DIM)
        y_swa = sliding_window_gqa(qa, ka, va, attn_sinks[l]) @ w_proj_swa[l]
        y_sb = stick_breaking_attention(
            qb_.reshape(b, s, SB_HEADS, HEAD_DIM),
            kb_.reshape(b, s, SB_HEADS, HEAD_DIM),
            vb_.reshape(b, s, SB_HEADS, HEAD_DIM)) @ w_proj_sb[l]
        gate_a, gate_b = jnp.split(jax.nn.sigmoid(h @ w_branch_gate[l] + b_branch_gate[l]), N_BRANCHES, axis=-1)
        mixed = (gate_a * y_swa + gate_b * y_sb) @ w_out[l]
        x = x + gate1 * rms_norm(mixed, g_post_mix[l])

        h = rms_norm(x, g_pre_mlp[l]) * (1.0 + scale2) + shift2
        f = jnp.square(jax.nn.relu(h @ w_ff_in[l])) @ w_ff_out[l]
        x = x + gate2 * rms_norm(f, g_post_mlp[l])
    return x
```

```cpp
#include <hip/hip_runtime.h>
#include <cstdio>
#include <cstdint>
#define MK_N_LAUNCHES 1

namespace pg8 {
#define PG8_LAS __attribute__((address_space(3)))
typedef unsigned short bf16_t;
typedef short bf16x8 __attribute__((ext_vector_type(8)));
typedef float f32x4 __attribute__((ext_vector_type(4)));
typedef unsigned u32x4 __attribute__((ext_vector_type(4)));
constexpr int BM = 256, BK = 64, HALF = 128, HTB = HALF * BK * 2  , STAGE_BYTES = 8 * HTB, NXCD = 8, WGM = 8;

__host__ __device__ __forceinline__ int lds_byte(int r, int c) { const int st = (r >> 4) * 2 + (c >> 5), rr = r & 15, cc = c & 31, ob = rr * 64 + cc * 2; return st * 1024 + (ob ^ (((ob >> 9) & 1) << 5)); }
__host__ __device__ __forceinline__ void stage_rc(int b, int& R, int& C) { const int st = b / 1024, sb = b % 1024, swz = sb ^ (((sb >> 9) & 1) << 5); R = (st >> 1) * 16 + swz / 64; C = (st & 1) * 32 + (swz % 64) / 2; }
__host__ __device__ __forceinline__ int perm32(int rho) { const int n = rho >> 4, i = rho & 15; return 8 * (i >> 2) + 4 * n + (i & 3); }

struct Unit { int pm, pn, kind; };
struct Gemm { const bf16_t* A0; const bf16_t* B0; const bf16_t* A1; const bf16_t* B1; int M, N, K; };

struct StaticOrder {
    int nM, nN, nwg, G, c;
    __host__ __device__ void init(int M, int N, int G_, int c_) { nM = M / BM; nN = N / BM; nwg = nM * nN; G = G_; c = c_; }
    __host__ __device__ bool next(int i, Unit& u) const {
        const long L = (long)i * G + c; if (L >= nwg) return false;
        int wgid = (int)L; { const int q = nwg / NXCD, r = nwg % NXCD, xcd = wgid % NXCD, off = wgid / NXCD; wgid = (xcd < r ? xcd * (q + 1) : r * (q + 1) + (xcd - r) * q) + off; }
        const int nig = WGM * nN, gid = wgid / nig, fm = gid * WGM, gsz = (nM - fm) < WGM ? (nM - fm) : WGM;
        u.pm = fm + ((wgid % nig) % gsz); u.pn = (wgid % nig) / gsz; u.kind = 0; return true;
    }
    __device__ __forceinline__ void a_ready(const Unit&) const {}
    __device__ __forceinline__ void done(const Unit&) const {}
};
struct PairOrder {
    StaticOrder S;
    __host__ __device__ bool next(int i, Unit& u) const { if (!S.next(i >> 1, u)) return false; u.kind = i & 1; return true; }
    __device__ __forceinline__ void a_ready(const Unit&) const {}
    __device__ __forceinline__ void done(const Unit&) const {}
};

typedef float f32x2_t __attribute__((ext_vector_type(2))); typedef __bf16 bf16x2_t __attribute__((ext_vector_type(2)));
__device__ __forceinline__ unsigned cvt_pk_bf16(float lo, float hi) { f32x2_t v = {lo, hi}; bf16x2_t b = __builtin_convertvector(v, bf16x2_t); return __builtin_bit_cast(unsigned, b); }
__device__ __forceinline__ f32x4 bf_lo4(unsigned a, unsigned b) { return (f32x4){__uint_as_float(a << 16), __uint_as_float(a & 0xffff0000u), __uint_as_float(b << 16), __uint_as_float(b & 0xffff0000u)}; }
__device__ __forceinline__ u32x4 pack8(f32x4 v0, f32x4 v1) { u32x4 w; w.x = cvt_pk_bf16(v0[0], v0[1]); w.y = cvt_pk_bf16(v0[2], v0[3]); w.z = cvt_pk_bf16(v1[0], v1[1]); w.w = cvt_pk_bf16(v1[2], v1[3]); return w; }

template <int ACT  > struct EpiSimple {
    static constexpr bool PERM = true, AFTER_DRAIN = false;
    bf16_t* O; int ldc;
    __device__ __forceinline__ void operator()(const f32x4 (&acc)[2][2][4][2], const Unit& u, int wr, int wc, int fr, int fq) const {
        const int row0 = u.pm * BM + wr * 64 + fr, col0 = u.pn * BM + wc * 32 + 8 * fq;
#pragma unroll
        for (int ai = 0; ai < 2; ++ai)
#pragma unroll
            for (int m = 0; m < 4; ++m) { bf16_t* rowp = O + (size_t)(row0 + ai * HALF + m * 16) * ldc + col0;
#pragma unroll
                for (int bj = 0; bj < 2; ++bj) { f32x4 v0 = acc[ai][bj][m][0], v1 = acc[ai][bj][m][1];
                    if (ACT == 1) {
#pragma unroll
                        for (int j = 0; j < 4; ++j) { const float a = fmaxf(v0[j], 0.f), b = fmaxf(v1[j], 0.f); v0[j] = a * a; v1[j] = b * b; } }
                    *(u32x4*)(rowp + bj * HALF) = pack8(v0, v1); } }
    }
};

struct EpiProj {
    static constexpr bool PERM = true, AFTER_DRAIN = false;
    bf16_t *QA, *KA, *VA, *QB, *KB, *VB, *GT; const float* cosT; const float* sinT; const float* gbias; float qscale;
    __device__ __forceinline__ void operator()(const f32x4 (&acc)[2][2][4][2], const Unit& u, int wr, int wc, int fr, int fq) const {
        const int pn = u.pn, row0 = u.pm * BM + wr * 64 + fr, cl = wc * 32 + 8 * fq;
        bf16_t* base; int ld, colt, mode; float sc = 1.f;
        if (pn < 8)       { base = QA; ld = 2048; colt = pn * 256;        mode = 1; sc = qscale; }
        else if (pn < 10) { base = KA; ld = 512;  colt = (pn - 8) * 256;  mode = 1; }
        else if (pn < 12) { base = VA; ld = 512;  colt = (pn - 10) * 256; mode = 0; }
        else if (pn < 20) { base = QB; ld = 2048; colt = (pn - 12) * 256; mode = 0; sc = qscale; }
        else if (pn < 28) { base = KB; ld = 2048; colt = (pn - 20) * 256; mode = 0; }
        else if (pn < 36) { base = VB; ld = 2048; colt = (pn - 28) * 256; mode = 0; }
        else              { base = GT; ld = 8192; colt = (pn - 36) * 256; mode = 2; }
        if (mode == 1) {
#pragma unroll
            for (int ai = 0; ai < 2; ++ai)
#pragma unroll
                for (int m = 0; m < 4; ++m) { const int row = row0 + ai * HALF + m * 16; const int pos = row & 4095;
                    const f32x4 c4 = *(const f32x4*)(cosT + pos * 64 + (cl >> 1)) * sc, s4 = *(const f32x4*)(sinT + pos * 64 + (cl >> 1)) * sc;
                    bf16_t* rowp = base + (size_t)row * ld + colt + cl;
#pragma unroll
                    for (int bj = 0; bj < 2; ++bj) { const f32x4 x1 = acc[ai][bj][m][0], x2 = acc[ai][bj][m][1];
                        *(u32x4*)(rowp + bj * HALF) = pack8(x1 * c4 - x2 * s4, x2 * c4 + x1 * s4); } }
        } else if (mode == 2) {
            f32x4 bv[2][2];
#pragma unroll
            for (int bj = 0; bj < 2; ++bj)
#pragma unroll
                for (int n = 0; n < 2; ++n) bv[bj][n] = *(const f32x4*)(gbias + colt + bj * HALF + cl + 4 * n);
#pragma unroll
            for (int ai = 0; ai < 2; ++ai)
#pragma unroll
                for (int m = 0; m < 4; ++m) { bf16_t* rowp = base + (size_t)(row0 + ai * HALF + m * 16) * ld + colt + cl;
#pragma unroll
                    for (int bj = 0; bj < 2; ++bj) { f32x4 v0 = acc[ai][bj][m][0] + bv[bj][0], v1 = acc[ai][bj][m][1] + bv[bj][1];
#pragma unroll
                        for (int j = 0; j < 4; ++j) { v0[j] = __builtin_amdgcn_rcpf(1.f + __builtin_amdgcn_exp2f(v0[j] * -1.44269504089f)); v1[j] = __builtin_amdgcn_rcpf(1.f + __builtin_amdgcn_exp2f(v1[j] * -1.44269504089f)); }
                        *(u32x4*)(rowp + bj * HALF) = pack8(v0, v1); } }
        } else {
#pragma unroll
            for (int ai = 0; ai < 2; ++ai)
#pragma unroll
                for (int m = 0; m < 4; ++m) { bf16_t* rowp = base + (size_t)(row0 + ai * HALF + m * 16) * ld + colt + cl;
#pragma unroll
                    for (int bj = 0; bj < 2; ++bj) *(u32x4*)(rowp + bj * HALF) = pack8(acc[ai][bj][m][0] * sc, acc[ai][bj][m][1] * sc); }
        }
    }
};

struct EpiMix {
    static constexpr bool PERM = true, AFTER_DRAIN = false;
    bf16_t* O; const bf16_t* G;
    __device__ __forceinline__ void operator()(const f32x4 (&acc)[2][2][4][2], const Unit& u, int wr, int wc, int fr, int fq) const {
        const int row0 = u.pm * BM + wr * 64 + fr, col0 = u.pn * BM + wc * 32 + 8 * fq; const int kind = u.kind;
#pragma unroll
        for (int ai = 0; ai < 2; ++ai)
#pragma unroll
            for (int m = 0; m < 4; ++m) { const size_t row = (size_t)(row0 + ai * HALF + m * 16);
#pragma unroll
                for (int bj = 0; bj < 2; ++bj) { const int col = col0 + bj * HALF;
                    const u32x4 g = *(const u32x4*)(G + row * 8192 + (kind ? 4096 : 0) + col);
                    f32x4 v0 = acc[ai][bj][m][0] * bf_lo4(g.x, g.y), v1 = acc[ai][bj][m][1] * bf_lo4(g.z, g.w);
                    bf16_t* op = O + row * 4096 + col;
                    if (kind) { const u32x4 p = *(const u32x4*)op; v0 += bf_lo4(p.x, p.y); v1 += bf_lo4(p.z, p.w); }
                    *(u32x4*)op = pack8(v0, v1); } }
    }
};

template <class Epi, class Sched, bool ALIGN_EPI = false, bool SP2 = false>
__device__ __forceinline__ void gemm_phase(PG8_LAS unsigned char* lds, const Gemm g, const Sched& S, const Epi& E) {
    int tid_ = threadIdx.x; asm volatile("" : "+v"(tid_));
    const int tid = tid_, wid = __builtin_amdgcn_readfirstlane(tid >> 6), lane = tid & 63, wr = wid >> 2, wc = wid & 3, fr = lane & 15, fq = lane >> 4;
    const int K = g.K, nt = K / BK;
    unsigned voffA[2], voffB[2];
#pragma unroll
    for (int i = 0; i < 2; ++i) { int R, C; stage_rc(tid * 16 + i * 8192, R, C); const int Rb = Epi::PERM ? ((R & ~31) + perm32(R & 31)) : R;
        voffA[i] = (unsigned)(R * K + C) * 2u; voffB[i] = (unsigned)(Rb * K + C) * 2u; }
    const size_t kstep = (size_t)(BK * 2);
    const size_t hstep = (size_t)HALF * K * 2;
    const size_t tstep = 2 * hstep;
    const unsigned ldsw = (unsigned)wid * 1024u;
    const int aoff = lds_byte(wr * 64 + fr, fq * 8), boff = lds_byte(wc * 32 + fr, fq * 8);
#define PG8_SA(b, h) (((b) * 2 + (h)) * HTB)
#define PG8_SB(b, h) ((4 + (b) * 2 + (h)) * HTB)
#define PG8_STAGE(bufoff, gbase, voff) do { _Pragma("unroll") for (int _i = 0; _i < 2; ++_i) \
        __builtin_amdgcn_global_load_lds((const unsigned*)((const char*)(gbase) + (voff)[_i]), (PG8_LAS unsigned*)(lds + (bufoff) + ldsw + _i * 8192), 16, 0, 0); } while (0)
#define PG8_LDA(dst, b, h) do { _Pragma("unroll") for (int m = 0; m < 4; ++m) _Pragma("unroll") for (int k = 0; k < 2; ++k) dst[m][k] = *(const PG8_LAS bf16x8*)(lds + PG8_SA(b, h) + aoff + m * 2048 + k * 1024); } while (0)
#define PG8_LDB(dst, b, h) do { _Pragma("unroll") for (int n = 0; n < 2; ++n) _Pragma("unroll") for (int k = 0; k < 2; ++k) dst[n][k] = *(const PG8_LAS bf16x8*)(lds + PG8_SB(b, h) + boff + n * 2048 + k * 1024); } while (0)
#define PG8_MMA(ai, bj, At, Bt) do { __builtin_amdgcn_s_setprio(1); _Pragma("unroll") for (int m = 0; m < 4; ++m) _Pragma("unroll") for (int n = 0; n < 2; ++n) _Pragma("unroll") for (int k = 0; k < 2; ++k) \
        acc[ai][bj][m][n] = __builtin_amdgcn_mfma_f32_16x16x32_bf16(Bt[n][k], At[m][k], acc[ai][bj][m][n], 0, 0, 0); __builtin_amdgcn_s_setprio(0); } while (0)
#define PG8_WAIT_V(n) asm volatile("s_waitcnt vmcnt(" #n ")" ::: "memory")
#define PG8_WAIT_L(n) asm volatile("s_waitcnt lgkmcnt(" #n ")" ::: "memory")
#define PG8_BAR __builtin_amdgcn_s_barrier()
#define PG8_SCHED __builtin_amdgcn_sched_barrier(0)
    Unit cur, nxt; int ui = 0;
    if (!S.next(0, cur)) return;
    f32x4 acc[2][2][4][2];
#pragma unroll
    for (int a = 0; a < 2; ++a)
#pragma unroll
        for (int b = 0; b < 2; ++b)
#pragma unroll
            for (int m = 0; m < 4; ++m)
#pragma unroll
                for (int n = 0; n < 2; ++n) acc[a][b][m][n] = (f32x4){0.f, 0.f, 0.f, 0.f};
    bf16x8 At[4][2], B0[2][2], B1[2][2];
    const char* cA = (const char*)(cur.kind ? g.A1 : g.A0) + (size_t)cur.pm * tstep; const char* cB = (const char*)(cur.kind ? g.B1 : g.B0) + (size_t)cur.pn * tstep;
    S.a_ready(cur);
    if constexpr (SP2) {
        PG8_STAGE(PG8_SB(0, 0), cB, voffB); PG8_STAGE(PG8_SB(0, 1), cB + hstep, voffB); PG8_STAGE(PG8_SA(0, 0), cA, voffA); PG8_STAGE(PG8_SA(0, 1), cA + hstep, voffA);
        if (wr == 1) PG8_BAR;
        PG8_WAIT_V(2); PG8_BAR;
        PG8_STAGE(PG8_SB(1, 0), cB + kstep, voffB); PG8_STAGE(PG8_SA(1, 0), cA + kstep, voffA); PG8_STAGE(PG8_SB(1, 1), cB + hstep + kstep, voffB);
        PG8_WAIT_V(6); PG8_BAR;
    } else {
        PG8_STAGE(PG8_SB(0, 0), cB, voffB); PG8_STAGE(PG8_SA(0, 0), cA, voffA); PG8_STAGE(PG8_SB(0, 1), cB + hstep, voffB); PG8_STAGE(PG8_SA(0, 1), cA + hstep, voffA);
        if (wr == 1) PG8_BAR;
        PG8_WAIT_V(4); PG8_BAR;
        PG8_STAGE(PG8_SB(1, 0), cB + kstep, voffB); PG8_STAGE(PG8_SA(1, 0), cA + kstep, voffA); PG8_STAGE(PG8_SB(1, 1), cB + hstep + kstep, voffB);
        PG8_WAIT_V(6); PG8_BAR;
    }
    for (;;) {
        const bool has_next = S.next(ui + 1, nxt);
        const char* nA = has_next ? (const char*)(nxt.kind ? g.A1 : g.A0) + (size_t)nxt.pm * tstep : cA; const char* nB = has_next ? (const char*)(nxt.kind ? g.B1 : g.B0) + (size_t)nxt.pn * tstep : cB;
        for (int t = 0; t < nt; t += 2) {
            const bool last = (t == nt - 2);
            const char* a1 = cA + (size_t)(t + 1) * kstep;
            const char* a2 = last ? nA : cA + (size_t)(t + 2) * kstep; const char* b2 = last ? nB : cB + (size_t)(t + 2) * kstep;
            const char* a3 = a2 + kstep; const char* b3 = b2 + kstep;
            if (last && has_next) S.a_ready(nxt);
            if constexpr (SP2) {
            PG8_LDB(B0, 0, 0); PG8_LDB(B1, 0, 1); PG8_SCHED; PG8_LDA(At, 0, 0); PG8_STAGE(PG8_SA(1, 1), a1 + hstep, voffA);
            PG8_WAIT_V(8); PG8_WAIT_L(0); PG8_BAR; PG8_MMA(0, 0, At, B0); PG8_MMA(0, 1, At, B1); PG8_BAR; PG8_SCHED;
            PG8_LDA(At, 0, 1); PG8_STAGE(PG8_SB(0, 0), b2, voffB); PG8_STAGE(PG8_SB(0, 1), b2 + hstep, voffB); PG8_STAGE(PG8_SA(0, 0), a2, voffA);
            PG8_WAIT_V(8); PG8_WAIT_L(0); PG8_BAR; PG8_MMA(1, 0, At, B0); PG8_MMA(1, 1, At, B1); PG8_BAR; PG8_SCHED;
            PG8_LDB(B0, 1, 0); PG8_LDB(B1, 1, 1); PG8_SCHED; PG8_LDA(At, 1, 0); PG8_STAGE(PG8_SA(0, 1), a2 + hstep, voffA);
            PG8_WAIT_V(8); PG8_WAIT_L(0); PG8_BAR; PG8_MMA(0, 0, At, B0); PG8_MMA(0, 1, At, B1); PG8_BAR; PG8_SCHED;
            PG8_LDA(At, 1, 1); PG8_STAGE(PG8_SB(1, 0), b3, voffB); PG8_STAGE(PG8_SB(1, 1), b3 + hstep, voffB); PG8_STAGE(PG8_SA(1, 0), a3, voffA);
            PG8_WAIT_V(8); PG8_WAIT_L(0); PG8_BAR; PG8_MMA(1, 0, At, B0); PG8_MMA(1, 1, At, B1); PG8_BAR; PG8_SCHED;
            } else {
            PG8_LDB(B0, 0, 0); PG8_SCHED; PG8_LDA(At, 0, 0); PG8_STAGE(PG8_SA(1, 1), a1 + hstep, voffA);
            PG8_WAIT_L(8); PG8_BAR; PG8_WAIT_L(0); PG8_MMA(0, 0, At, B0); PG8_BAR; PG8_SCHED;
            PG8_LDB(B1, 0, 1); PG8_STAGE(PG8_SB(0, 0), b2, voffB);
            PG8_BAR; PG8_WAIT_L(0); PG8_MMA(0, 1, At, B1); PG8_BAR;
            PG8_LDA(At, 0, 1); PG8_STAGE(PG8_SA(0, 0), a2, voffA);
            PG8_BAR; PG8_WAIT_L(0); PG8_MMA(1, 0, At, B0); PG8_BAR; PG8_SCHED;
            PG8_STAGE(PG8_SB(0, 1), b2 + hstep, voffB);
            PG8_WAIT_V(6); PG8_BAR; PG8_MMA(1, 1, At, B1); PG8_BAR;
            PG8_LDB(B0, 1, 0); PG8_SCHED; PG8_LDA(At, 1, 0); PG8_STAGE(PG8_SA(0, 1), a2 + hstep, voffA);
            PG8_WAIT_L(8); PG8_BAR; PG8_WAIT_L(0); PG8_MMA(0, 0, At, B0); PG8_BAR; PG8_SCHED;
            PG8_LDB(B1, 1, 1); PG8_STAGE(PG8_SB(1, 0), b3, voffB);
            PG8_BAR; PG8_WAIT_L(0); PG8_MMA(0, 1, At, B1); PG8_BAR;
            PG8_LDA(At, 1, 1); PG8_STAGE(PG8_SA(1, 0), a3, voffA);
            PG8_BAR; PG8_WAIT_L(0); PG8_MMA(1, 0, At, B0); PG8_BAR; PG8_SCHED;
            PG8_STAGE(PG8_SB(1, 1), b3 + hstep, voffB);
            PG8_WAIT_V(6); PG8_BAR; PG8_MMA(1, 1, At, B1); PG8_BAR;
            }
        }
        if constexpr (ALIGN_EPI) { if (wr == 0) PG8_BAR; }
        if constexpr (!Epi::AFTER_DRAIN) { E(acc, cur, wr, wc, fr, fq); S.done(cur); }
        if (!has_next) break;
#pragma unroll
        for (int a = 0; a < 2; ++a)
#pragma unroll
            for (int b = 0; b < 2; ++b)
#pragma unroll
                for (int m = 0; m < 4; ++m)
#pragma unroll
                    for (int n = 0; n < 2; ++n) acc[a][b][m][n] = (f32x4){0.f, 0.f, 0.f, 0.f};
        cur = nxt; cA = nA; cB = nB; ++ui;
        if constexpr (ALIGN_EPI) { if (wr == 1) PG8_BAR; }
    }
    PG8_WAIT_V(0);
    if constexpr (!ALIGN_EPI) { if (wr == 0) PG8_BAR; }
    PG8_BAR;
#undef PG8_SA
#undef PG8_SB
#undef PG8_STAGE
#undef PG8_LDA
#undef PG8_LDB
#undef PG8_MMA
#undef PG8_WAIT_V
#undef PG8_WAIT_L
#undef PG8_BAR
#undef PG8_SCHED
}
}


namespace att {
#define ATT_LAS __attribute__((address_space(3)))
typedef unsigned short bf16;
typedef short bf16x8 __attribute__((ext_vector_type(8)));
typedef short s16x4 __attribute__((ext_vector_type(4)));
typedef float f32x16 __attribute__((ext_vector_type(16)));
typedef float f32x2_t __attribute__((ext_vector_type(2)));
typedef __bf16 bf16x2_t __attribute__((ext_vector_type(2)));
typedef unsigned u32x4 __attribute__((ext_vector_type(4)));
typedef unsigned u32x2 __attribute__((ext_vector_type(2)));
constexpr int TILE_BYTES = 64 * 256, BUF_BYTES = 2 * TILE_BYTES, FLAG_OFF = 2 * BUF_BYTES, LDS_BYTES = FLAG_OFF + 256;
__device__ __forceinline__ unsigned cvtpk(float lo, float hi) { f32x2_t v = {lo, hi}; bf16x2_t b = __builtin_convertvector(v, bf16x2_t); return __builtin_bit_cast(unsigned, b); }
__device__ __forceinline__ int crow(int i, int h) { return (i & 3) + 8 * (i >> 2) + 4 * h; }
__device__ __forceinline__ unsigned off_b(unsigned row, unsigned ch) { return 256u * row + 16u * (ch ^ (((row & 3) << 2) | ((row >> 2) & 3))); }
__device__ __forceinline__ s16x4 trread(const ATT_LAS unsigned char* p) { return __builtin_bit_cast(s16x4, __builtin_amdgcn_ds_read_tr16_b64_v4i16((ATT_LAS s16x4*)p)); }
#define ATT_MFMA(a, b, c) __builtin_amdgcn_mfma_f32_32x32x16_bf16((a), (b), (c), 0, 0, 0)

template <int MODE, bool EARLY>
__device__ __forceinline__ void attn_unit(ATT_LAS unsigned char* lds, const bf16* __restrict__ Qh, const bf16* __restrict__ Kh, const bf16* __restrict__ Vh, bf16* __restrict__ Oh,
                                          int pq, int pk, int po, int b, int qb, float sink2, int tid, int wid, int lane) {
    int ln_ = lane, td_ = tid; asm volatile("" : "+v"(ln_), "+v"(td_));
    const int r32 = ln_ & 31, h = ln_ >> 5;
    const int t0 = 256 * qb + 32 * wid, tq = t0 + r32;
    const size_t rowbase = (size_t)b * 4096;
    bf16x8 qf[8];
    { const char* qb_ = (const char*)(Qh + rowbase * pq); const unsigned qo = (unsigned)(tq * pq + 8 * h) * 2u;
#pragma unroll
      for (int s = 0; s < 8; ++s) qf[s] = *(const bf16x8*)(qb_ + qo + 32 * s); }
    f32x16 oacc[4];
#pragma unroll
    for (int c = 0; c < 4; ++c)
#pragma unroll
        for (int i = 0; i < 16; ++i) oacc[c][i] = 0.f;
    float carry = 0.f, mrun = sink2, lrun = (h == 0) ? 1.f : 0.f;
    const int kt_hi = 4 * qb + 3, kt_lo = (MODE == 0) ? ((4 * qb - 2) > 0 ? (4 * qb - 2) : 0) : 0;
    const int lrow = td_ >> 4, lch = td_ & 15;
    const unsigned lw = off_b((unsigned)lrow, (unsigned)lch);
    const unsigned kvo = (unsigned)(lrow * pk + 8 * lch) * 2u;
    const char* kgb = (const char*)(Kh + rowbase * pk); const char* vgb = (const char*)(Vh + rowbase * pk);
    const unsigned xk = (unsigned)(((r32 & 3) << 2) | ((r32 >> 2) & 3));
    const int q4 = (ln_ & 15) >> 2, p4 = ln_ & 3, blk = (ln_ >> 4) & 1;
    unsigned vaddr[4][2];
#pragma unroll
    for (int c = 0; c < 4; ++c)
#pragma unroll
        for (int t = 0; t < 2; ++t) { const unsigned row = (unsigned)(8 * t + 4 * h + q4), x = (unsigned)((q4 << 2) | ((2 * t + h) & 3)), ch = (unsigned)(4 * c + 2 * blk + (p4 >> 1));
            vaddr[c][t] = 256u * row + 16u * (ch ^ x) + 8u * (unsigned)(p4 & 1); }
    u32x4 kr0, kr1, vr0, vr1;
#define ATT_GLOAD(kt) do { const size_t _o = (size_t)(64 * (kt)) * pk * 2; const char* _k = kgb + _o; const char* _v = vgb + _o; kr0 = *(const u32x4*)(_k + kvo); kr1 = *(const u32x4*)(_k + (size_t)64 * pk + kvo); vr0 = *(const u32x4*)(_v + kvo); vr1 = *(const u32x4*)(_v + (size_t)64 * pk + kvo); } while (0)
#define ATT_LSTORE(bf) do { ATT_LAS unsigned char* _b = lds + (bf) * BUF_BYTES + lw; *(ATT_LAS u32x4*)_b = kr0; *(ATT_LAS u32x4*)(_b + 8192) = kr1; *(ATT_LAS u32x4*)(_b + TILE_BYTES) = vr0; *(ATT_LAS u32x4*)(_b + TILE_BYTES + 8192) = vr1; } while (0)
    int buf = 0;
    ATT_GLOAD(kt_hi); ATT_LSTORE(0); __syncthreads();
    for (int kt = kt_hi; kt >= kt_lo; --kt) {
        const bool more = kt > kt_lo;
        if (more) ATT_GLOAD(kt - 1);
        const int kbase = 64 * kt;
        bool relevant, masked;
        if (MODE == 1) { relevant = kbase <= t0 + 30; masked = kbase + 63 >= t0; }
        else { relevant = (kbase <= t0 + 31) && (kbase + 63 >= t0 - 127); masked = !((kbase + 63 <= t0) && (kbase >= t0 - 96)); }
        if (relevant) {
            const ATT_LAS unsigned char* Kb = lds + buf * BUF_BYTES; const ATT_LAS unsigned char* Vb = Kb + TILE_BYTES;
            f32x16 sacc[2];
#pragma unroll
            for (int kb = 0; kb < 2; ++kb) {
#pragma unroll
                for (int i = 0; i < 16; ++i) sacc[kb][i] = 0.f;
#pragma unroll
                for (int s = 0; s < 8; ++s) { const bf16x8 kf = *(const ATT_LAS bf16x8*)(Kb + kb * 8192 + 256 * r32 + 16 * (((unsigned)(2 * s + h)) ^ xk)); sacc[kb] = ATT_MFMA(kf, qf[s], sacc[kb]); }
            }
            bf16x8 pf[2][2];
            if (MODE == 1) {
#pragma unroll
                for (int kk = 0; kk < 2; ++kk) { const int kb = 1 - kk; const int sb0 = kbase + 32 * kb;
                    float sp[16], A[16];
#pragma unroll
                    for (int i = 0; i < 16; ++i) { const float z = sacc[kb][i]; const float e = __builtin_amdgcn_exp2f(-__builtin_fabsf(z)); sp[i] = fmaxf(z, 0.f) + __builtin_amdgcn_logf(1.f + e); }
                    if (masked) {
#pragma unroll
                        for (int i = 0; i < 16; ++i) sp[i] = (sb0 + crow(i, h) < tq) ? sp[i] : 0.f; }
                    float G[4], Gp[4], T[4];
#pragma unroll
                    for (int g = 0; g < 4; ++g) { G[g] = (sp[4 * g] + sp[4 * g + 1]) + (sp[4 * g + 2] + sp[4 * g + 3]); Gp[g] = __shfl_xor(G[g], 32); T[g] = G[g] + Gp[g]; }
                    float R[4]; R[3] = carry; R[2] = R[3] + T[3]; R[1] = R[2] + T[2]; R[0] = R[1] + T[1]; carry = R[0] + T[0];
#pragma unroll
                    for (int g = 0; g < 4; ++g) { const float S3 = R[g] + (h == 0 ? Gp[g] : 0.f), S2 = S3 + sp[4 * g + 3], S1 = S2 + sp[4 * g + 2], S0 = S1 + sp[4 * g + 1];
                        A[4 * g + 3] = __builtin_amdgcn_exp2f(sacc[kb][4 * g + 3] - sp[4 * g + 3] - S3); A[4 * g + 2] = __builtin_amdgcn_exp2f(sacc[kb][4 * g + 2] - sp[4 * g + 2] - S2);
                        A[4 * g + 1] = __builtin_amdgcn_exp2f(sacc[kb][4 * g + 1] - sp[4 * g + 1] - S1); A[4 * g + 0] = __builtin_amdgcn_exp2f(sacc[kb][4 * g + 0] - sp[4 * g + 0] - S0); }
                    if (masked) {
#pragma unroll
                        for (int i = 0; i < 16; ++i) A[i] = (sb0 + crow(i, h) < tq) ? A[i] : 0.f; }
#pragma unroll
                    for (int s2 = 0; s2 < 2; ++s2) { u32x4 w; w.x = cvtpk(A[8 * s2], A[8 * s2 + 1]); w.y = cvtpk(A[8 * s2 + 2], A[8 * s2 + 3]); w.z = cvtpk(A[8 * s2 + 4], A[8 * s2 + 5]); w.w = cvtpk(A[8 * s2 + 6], A[8 * s2 + 7]); pf[kb][s2] = __builtin_bit_cast(bf16x8, w); }
                }
            } else {
                if (masked) {
#pragma unroll
                    for (int kb = 0; kb < 2; ++kb)
#pragma unroll
                        for (int i = 0; i < 16; ++i) { const int key = kbase + 32 * kb + crow(i, h); const bool valid = (key <= tq) && (key + 127 >= tq); sacc[kb][i] = valid ? sacc[kb][i] : -__builtin_inff(); } }
                float tmax = sacc[0][0];
#pragma unroll
                for (int kb = 0; kb < 2; ++kb)
#pragma unroll
                    for (int i = 0; i < 16; ++i) tmax = fmaxf(tmax, sacc[kb][i]);
                tmax = fmaxf(tmax, __shfl_xor(tmax, 32));
                const float mnew = fmaxf(mrun, tmax), alpha = __builtin_amdgcn_exp2f(mrun - mnew); mrun = mnew;
                float psum = 0.f;
#pragma unroll
                for (int kb = 0; kb < 2; ++kb) { float P[16];
#pragma unroll
                    for (int i = 0; i < 16; ++i) { P[i] = __builtin_amdgcn_exp2f(sacc[kb][i] - mnew); psum += P[i]; }
#pragma unroll
                    for (int s2 = 0; s2 < 2; ++s2) { u32x4 w; w.x = cvtpk(P[8 * s2], P[8 * s2 + 1]); w.y = cvtpk(P[8 * s2 + 2], P[8 * s2 + 3]); w.z = cvtpk(P[8 * s2 + 4], P[8 * s2 + 5]); w.w = cvtpk(P[8 * s2 + 6], P[8 * s2 + 7]); pf[kb][s2] = __builtin_bit_cast(bf16x8, w); } }
                lrun = lrun * alpha + psum;
#pragma unroll
                for (int c = 0; c < 4; ++c)
#pragma unroll
                    for (int i = 0; i < 16; ++i) oacc[c][i] *= alpha;
            }
#pragma unroll
            for (int kb = 0; kb < 2; ++kb)
#pragma unroll
                for (int s2 = 0; s2 < 2; ++s2)
#pragma unroll
                    for (int c = 0; c < 4; ++c) { const s16x4 lo = trread(Vb + vaddr[c][0] + 4096 * (2 * kb + s2)), hi = trread(Vb + vaddr[c][1] + 4096 * (2 * kb + s2));
                        const bf16x8 vf = __builtin_shufflevector(lo, hi, 0, 1, 2, 3, 4, 5, 6, 7); oacc[c] = ATT_MFMA(vf, pf[kb][s2], oacc[c]); }
        }
        if (more) ATT_LSTORE(buf ^ 1);
        if (EARLY && MODE == 1) {
            volatile ATT_LAS unsigned* fl = (volatile ATT_LAS unsigned*)(lds + FLAG_OFF) + (kt & 1) * 8;
            const bool done = __all(carry > 48.f);
            if (lane == 0) fl[wid] = done ? 1u : 0u;
            __syncthreads();
            unsigned alld = 1u;
#pragma unroll
            for (int w = 0; w < 8; ++w) alld &= fl[w];
            buf ^= 1;
            if (alld) break;
        } else { __syncthreads(); buf ^= 1; }
    }
#undef ATT_GLOAD
#undef ATT_LSTORE
    if (MODE == 0) { const float lt = lrun + __shfl_xor(lrun, 32); const float inv = 1.f / lt;
#pragma unroll
        for (int c = 0; c < 4; ++c)
#pragma unroll
            for (int i = 0; i < 16; ++i) oacc[c][i] *= inv; }
    { int l2 = lane; asm volatile("" : "+v"(l2)); const int r2 = l2 & 31, h2 = l2 >> 5;
      char* ob = (char*)(Oh + rowbase * po); const unsigned oo = (unsigned)((t0 + r2) * po + 4 * h2) * 2u;
#pragma unroll
      for (int c = 0; c < 4; ++c)
#pragma unroll
        for (int g = 0; g < 4; ++g) { u32x2 w; w.x = cvtpk(oacc[c][4 * g], oacc[c][4 * g + 1]); w.y = cvtpk(oacc[c][4 * g + 2], oacc[c][4 * g + 3]); *(u32x2*)(ob + oo + 64 * c + 16 * g) = w; } }
    if (EARLY && MODE == 1) __syncthreads();
}
}


constexpr int NWAVES = 8;
constexpr int BATCH = 4, SEQ = 4096, D = 4096, M = BATCH * SEQ, HD = 128, FF = 4 * D;
constexpr int D_IN = 9216, NG = 8192, N1 = D_IN + NG, NMOD = 6 * D;
constexpr float NORM_EPS = 1e-6f;
constexpr size_t MiB = 1u << 20;
constexpr size_t WS_CTL = 0, CTL_ZERO_BYTES = 1 * MiB;
constexpr size_t WS_MOD = 1 * MiB, WS_COS = 2 * MiB, WS_SIN = 3 * MiB;
constexpr size_t WS_W1 = 4 * MiB;
constexpr size_t WS_WPS = 140 * MiB, WS_WPB = 156 * MiB;
constexpr size_t WS_WO = 172 * MiB;
constexpr size_t WS_WF1 = 204 * MiB;
constexpr size_t WS_WF2 = 332 * MiB;
constexpr size_t WS_A = 460 * MiB;
constexpr size_t WS_B = 588 * MiB;
constexpr size_t WS_C = 716 * MiB;
constexpr size_t WS_END = WS_C + 544 * MiB;
constexpr int CW_BAR = 4096;
constexpr int RING_OFF = 0, RING_BYTES = 131072, LDSCTL_OFF = 139264, MISC_OFF = LDSCTL_OFF + 320, LDS_BYTES = 147456;

#define GAS __attribute__((address_space(1)))
#define LAS __attribute__((address_space(3)))
typedef unsigned short bf16;
typedef unsigned v4u __attribute__((ext_vector_type(4)));
typedef unsigned v2u __attribute__((ext_vector_type(2)));
typedef float f32x4 __attribute__((ext_vector_type(4)));
#define LDS_WAIT() asm volatile("s_waitcnt lgkmcnt(0)" ::: "memory")
__device__ __forceinline__ unsigned f2bf(float f) { unsigned u = __builtin_bit_cast(unsigned, f); return (u + 0x7fffu + ((u >> 16) & 1u)) >> 16; }
__device__ __forceinline__ unsigned pk2(float lo, float hi) { return f2bf(lo) | (f2bf(hi) << 16); }

#define XB_TMO      128
#define XB_XCNT(j)  (256  + 64 * (j))
#define XB_XSUB(j)  (1280 + 64 * (j))
#define XB_XGEN(j)  (2304 + 64 * (j))
#define XB_TOP      3328
#define XB_TOPGEN   3392
#define XCD_BAR_WORDS 3456
#define XB_SPIN_CAP (1u << 18)
__device__ __forceinline__ unsigned xb_ld(unsigned* p)              { return __hip_atomic_load(p, __ATOMIC_RELAXED, __HIP_MEMORY_SCOPE_AGENT); }
__device__ __forceinline__ unsigned xb_add(unsigned* p, unsigned v) { return __hip_atomic_fetch_add(p, v, __ATOMIC_RELAXED, __HIP_MEMORY_SCOPE_AGENT); }
__device__ __forceinline__ unsigned xb_xcc_id() { return (unsigned)__builtin_amdgcn_s_getreg((3 << 11) | 20) & 0xFu; }
#define XB_SPIN(cond, bar) do { unsigned _sp = 0; while (cond) { __builtin_amdgcn_s_sleep(1); \
    if ((++_sp & 255u) == 0u) { if (xb_ld(&(bar)[XB_TMO])) break; if (_sp > XB_SPIN_CAP) { atomicAdd(&(bar)[XB_TMO], 1u); break; } } } } while (0)
struct XcdBarrier { unsigned* bar; unsigned x; volatile LAS unsigned* st; };
__device__ __forceinline__ XcdBarrier xcd_barrier_post(unsigned* bar, volatile LAS unsigned* st) {
    XcdBarrier b; b.bar = bar; b.x = xb_xcc_id(); b.st = st;
    if (threadIdx.x == 0) (void)xb_add(&bar[XB_XCNT(b.x)], 1u);
    return b;
}
__device__ __forceinline__ void xcd_barrier_complete(unsigned* bar, unsigned x, unsigned& nloc, unsigned& nx) {
    const unsigned G = gridDim.x * gridDim.y * gridDim.z;
    unsigned sum, cnt, mine, sp = 0u;
    for (;;) {
        sum = 0u; cnt = 0u; mine = 0u;
#pragma unroll
        for (unsigned j = 0; j < 16; ++j) { const unsigned c = xb_ld(&bar[XB_XCNT(j)]); sum += c; cnt += (c > 0u) ? 1u : 0u; mine = (j == x) ? c : mine; }
        if (sum == G) break;
        __builtin_amdgcn_s_sleep(1);
        if ((++sp & 255u) == 0u) { if (xb_ld(&bar[XB_TMO])) break; if (sp > XB_SPIN_CAP) { atomicAdd(&bar[XB_TMO], 1u); break; } }
    }
    nloc = mine > 0u ? mine : 1u; nx = cnt > 0u ? cnt : 1u;
}
__device__ __forceinline__ void xcd_barrier(const XcdBarrier& b) {
    asm volatile("s_waitcnt vmcnt(0)" ::: "memory");
    __syncthreads();
    if (threadIdx.x == 0) {
        unsigned* bar = b.bar;
        __builtin_amdgcn_s_waitcnt(0);
        unsigned nloc = b.st[0], nx = b.st[1];
        if (nloc == 0u) { xcd_barrier_complete(bar, b.x, nloc, nx); b.st[0] = nloc; b.st[1] = nx; }
        const unsigned old = xb_add(&bar[XB_XSUB(b.x)], 1u);
        const unsigned gen = old / nloc;
        if (old + 1u == (gen + 1u) * nloc) {
            __builtin_amdgcn_fence(__ATOMIC_RELEASE, "agent");
            asm volatile("s_waitcnt vmcnt(0)" ::: "memory");
            const unsigned og = xb_add(&bar[XB_TOP], 1u);
            const unsigned tg = og / nx;
            if (og + 1u == (tg + 1u) * nx) xb_add(&bar[XB_TOPGEN], 1u);
            else XB_SPIN(xb_ld(&bar[XB_TOPGEN]) == tg, bar);
            __builtin_amdgcn_fence(__ATOMIC_ACQUIRE, "agent");
            xb_add(&bar[XB_XGEN(b.x)], 1u);
            asm volatile("s_waitcnt vmcnt(0)" ::: "memory");
        } else {
            XB_SPIN(xb_ld(&bar[XB_XGEN(b.x)]) == gen, bar);
            __builtin_amdgcn_fence(__ATOMIC_ACQUIRE, "agent");
            asm volatile("s_waitcnt vmcnt(0)" ::: "memory");
        }
    }
    __syncthreads();
}

struct Frame {
    LAS unsigned char* lds;
    int tid, lane, wave, vcu, G;
};
struct Args {
    const float *x, *c, *w_ada, *b_ada, *g_pre_mix, *g_post_mix, *g_pre_mlp, *g_post_mlp, *w_in, *sinks, *w_bg, *b_bg, *w_ps, *w_pb, *w_out, *w_f1, *w_f2;
    float* out; unsigned char* ws; int ph_lo, ph_hi;
};

__device__ __forceinline__ float wave_sum(float v) {
#pragma unroll
    for (int o = 1; o < 64; o <<= 1) v += __shfl_xor(v, o);
    return v;
}
__device__ const double ROPE_INVF[64] = {1.0, 0.8659643233600653, 0.7498942093324559, 0.6493816315762113, 0.5623413251903491, 0.4869675251658631, 0.4216965034285822, 0.3651741272548377, 0.31622776601683794, 0.27384196342643613, 0.23713737056616552, 0.2053525026457146, 0.1778279410038923, 0.1539926526059492, 0.1333521432163324, 0.11547819846894582, 0.1, 0.08659643233600653, 0.07498942093324558, 0.06493816315762113, 0.05623413251903491, 0.04869675251658631, 0.042169650342858224, 0.03651741272548377, 0.03162277660168379, 0.027384196342643614, 0.023713737056616554, 0.02053525026457146, 0.01778279410038923, 0.01539926526059492, 0.01333521432163324, 0.011547819846894581, 0.01, 0.008659643233600654, 0.007498942093324558, 0.006493816315762113, 0.005623413251903491, 0.004869675251658631, 0.004216965034285823, 0.003651741272548377, 0.0031622776601683794, 0.0027384196342643613, 0.0023713737056616554, 0.002053525026457146, 0.0017782794100389228, 0.001539926526059492, 0.001333521432163324, 0.0011547819846894581, 0.001, 0.0008659643233600654, 0.0007498942093324559, 0.0006493816315762113, 0.0005623413251903491, 0.0004869675251658631, 0.00042169650342858224, 0.0003651741272548377, 0.00031622776601683794, 0.0002738419634264361, 0.00023713737056616554, 0.0002053525026457146, 0.00017782794100389227, 0.0001539926526059492, 0.0001333521432163324, 0.00011547819846894582};

__device__ __forceinline__ void p0_transpose_item(const float* __restrict__ W, int K, int N, bf16* __restrict__ WT, int row_off, int rope_lim, LAS float* scr, int item, int lane) {
    const int nblk = N / 64, kb = item / nblk, nb = item % nblk, k0 = 64 * kb, n0 = 64 * nb;
    const int kq = lane >> 4, nn = 4 * (lane & 15);
    f32x4 v[16];
#pragma unroll
    for (int i = 0; i < 16; ++i) v[i] = *(const f32x4*)(W + (size_t)(k0 + 4 * i + kq) * N + n0 + nn);
#pragma unroll
    for (int i = 0; i < 16; ++i) { LAS float* s = scr + (4 * i + kq) * 65 + nn; s[0] = v[i].x; s[1] = v[i].y; s[2] = v[i].z; s[3] = v[i].w; }
    LDS_WAIT(); asm volatile("" ::: "memory");
    const int c = lane & 7;
#pragma unroll
    for (int j = 0; j < 8; ++j) { const int n = (lane >> 3) + 8 * j; const LAS float* s = scr + (8 * c) * 65 + n;
        v4u o; o.x = pk2(s[0 * 65], s[1 * 65]); o.y = pk2(s[2 * 65], s[3 * 65]); o.z = pk2(s[4 * 65], s[5 * 65]); o.w = pk2(s[6 * 65], s[7 * 65]);
        int nd = n0 + n;
        if (nd < rope_lim) { const int d = nd & 127; nd = (nd & ~127) + (d < 64 ? 8 * (d >> 2) + (d & 3) : 8 * ((d - 64) >> 2) + 4 + (d & 3)); }
        *(v4u*)(WT + (size_t)(row_off + nd) * K + k0 + 8 * c) = o; }
    LDS_WAIT(); asm volatile("" ::: "memory");
}
__device__ __forceinline__ void p0_gemv(Frame& F, const Args& a, float* mod) {
    LAS f32x4* cact = (LAS f32x4*)F.lds;
    LAS float* red = (LAS float*)(F.lds + 65536);
    for (int k = F.tid; k < D; k += NWAVES * 64) { f32x4 v;
#pragma unroll
        for (int b = 0; b < 4; ++b) { const float xx = a.c[b * D + k]; v[b] = xx / (1.f + expf(-xx)); }
        cact[k] = v; }
    __syncthreads();
    const int half = F.lane >> 5, l32 = F.lane & 31; const bool act = l32 < 24;
    for (int cg = F.vcu; cg < NMOD / 96; cg += F.G) {
        f32x4 acc[4];
#pragma unroll
        for (int b = 0; b < 4; ++b) acc[b] = (f32x4){0.f, 0.f, 0.f, 0.f};
        const int kbase = 512 * F.wave + half;
        const float* wp = a.w_ada + (size_t)kbase * NMOD + 96 * cg + 4 * (act ? l32 : 0);
        for (int kk = 0; kk < 256; kk += 8) {
            f32x4 w[8];
#pragma unroll
            for (int u = 0; u < 8; ++u) w[u] = *(const f32x4*)(wp + (size_t)(2 * (kk + u)) * NMOD);
#pragma unroll
            for (int u = 0; u < 8; ++u) { const f32x4 ca = cact[kbase + 2 * (kk + u)];
#pragma unroll
                for (int b = 0; b < 4; ++b) acc[b] += w[u] * ca[b]; }
        }
#pragma unroll
        for (int b = 0; b < 4; ++b)
#pragma unroll
            for (int j = 0; j < 4; ++j) acc[b][j] += __shfl_xor(acc[b][j], 32);
        if (half == 0 && act) {
#pragma unroll
            for (int b = 0; b < 4; ++b) *(LAS f32x4*)(red + (F.wave * 4 + b) * 96 + 4 * l32) = acc[b]; }
        __syncthreads();
        if (F.tid < 384) { const int b = F.tid / 96, j = F.tid % 96; float s = 0.f;
#pragma unroll
            for (int w = 0; w < 8; ++w) s += red[(w * 4 + b) * 96 + j];
            mod[b * NMOD + 96 * cg + j] = s + a.b_ada[96 * cg + j]; }
        __syncthreads();
    }
}
__device__ __forceinline__ void p0_rope_table(Frame& F, float* cosT, float* sinT) {
    const double TWO_PI_HI = 6.283185307179586232, TWO_PI_LO = 2.4492935982947064e-16, INV_2PI = 0.15915494309189533577;
    for (int idx = F.vcu * (NWAVES * 64) + F.tid; idx < SEQ * 64; idx += F.G * NWAVES * 64) {
        const int pos = idx >> 6, i = idx & 63;
        const double ang = (double)pos * ROPE_INVF[i];
        const double n = __builtin_rint(ang * INV_2PI);
        double r = __builtin_fma(-n, TWO_PI_HI, ang); r = __builtin_fma(-n, TWO_PI_LO, r);
        const double r2 = r * r; double tc = 1.0, ts = r, sc = 1.0, ss = r;
#pragma unroll 1
        for (int k = 1; k <= 15; ++k) { tc *= -r2 / (double)((2 * k - 1) * (2 * k)); ts *= -r2 / (double)((2 * k) * (2 * k + 1)); sc += tc; ss += ts; }
        cosT[idx] = (float)sc; sinT[idx] = (float)ss;
    }
}

__device__ __forceinline__ f32x4 ld_bf4(const bf16* p) { const v2u w = *(const v2u*)p; return (f32x4){__uint_as_float(w.x << 16), __uint_as_float(w.x & 0xffff0000u), __uint_as_float(w.y << 16), __uint_as_float(w.y & 0xffff0000u)}; }
__device__ __forceinline__ void st_bf4(bf16* p, f32x4 v) { v2u w; w.x = pk2(v.x, v.y); w.y = pk2(v.z, v.w); *(v2u*)p = w; }
__device__ __forceinline__ float sumsq4(f32x4 v) { return (v.x * v.x + v.y * v.y) + (v.z * v.z + v.w * v.w); }

#define LAUNDER_PTR(p) asm volatile("" : "+s"(p))
__device__ __forceinline__ void p1_rows(Frame& F, const Args& a, const float* mod, bf16* H) {
    int lane_ = F.lane; asm volatile("" : "+v"(lane_)); const int LN = lane_;
    const int gw = F.vcu * NWAVES + F.wave, NGW = F.G * NWAVES;
    for (int r0 = gw * 8; r0 < M; r0 += NGW * 8) {
        const int b = r0 >> 12;
#pragma unroll 1
        for (int r = 0; r < 8; ++r) { const size_t row = (size_t)(r0 + r);
            const float* mb = mod + b * NMOD; const float* gp = a.g_pre_mix; LAUNDER_PTR(mb); LAUNDER_PTR(gp);
            f32x4 v[16]; float ss = 0.f;
#pragma unroll
            for (int j = 0; j < 16; ++j) { v[j] = *(const f32x4*)(a.x + row * D + 4 * LN + 256 * j); ss += sumsq4(v[j]); }
            const float rstd = 1.f / sqrtf(wave_sum(ss) * (1.f / D) + NORM_EPS);
#pragma unroll
            for (int j = 0; j < 16; ++j) { const int col = 4 * LN + 256 * j; if ((j & 3) == 0) asm volatile("" ::: "memory");
                const f32x4 av = *(const GAS f32x4*)(gp + col) * (*(const GAS f32x4*)(mb + D + col) + 1.f);
                st_bf4(H + row * D + col, v[j] * rstd * av + *(const GAS f32x4*)(mb + col)); }
        }
    }
}
__device__ __forceinline__ void p6_rows(Frame& F, const Args& a, const float* mod, const bf16* MX, bf16* H2) {
    int lane_ = F.lane; asm volatile("" : "+v"(lane_)); const int LN = lane_;
    const int gw = F.vcu * NWAVES + F.wave, NGW = F.G * NWAVES;
    for (int r0 = gw * 8; r0 < M; r0 += NGW * 8) {
        const int b = r0 >> 12;
#pragma unroll 1
        for (int r = 0; r < 8; ++r) { const size_t row = (size_t)(r0 + r);
            const float* mb = mod + b * NMOD; LAUNDER_PTR(mb);
            f32x4 v[16]; float ss = 0.f;
#pragma unroll
            for (int j = 0; j < 16; ++j) { v[j] = ld_bf4(MX + row * D + 4 * LN + 256 * j); ss += sumsq4(v[j]); }
            const float rstd = 1.f / sqrtf(wave_sum(ss) * (1.f / D) + NORM_EPS);
            float ss2 = 0.f;
#pragma unroll
            for (int j = 0; j < 16; ++j) { const int col = 4 * LN + 256 * j; if ((j & 3) == 0) asm volatile("" ::: "memory");
                const f32x4 g1 = *(const GAS f32x4*)(mb + 2 * D + col) * *(const f32x4*)(a.g_post_mix + col);
                v[j] = *(const f32x4*)(a.x + row * D + col) + g1 * (v[j] * rstd);
                *(f32x4*)(a.out + row * D + col) = v[j]; ss2 += sumsq4(v[j]); }
            const float rstd2 = 1.f / sqrtf(wave_sum(ss2) * (1.f / D) + NORM_EPS);
#pragma unroll
            for (int j = 0; j < 16; ++j) { const int col = 4 * LN + 256 * j; if ((j & 3) == 0) asm volatile("" ::: "memory");
                const f32x4 a2 = *(const f32x4*)(a.g_pre_mlp + col) * (*(const GAS f32x4*)(mb + 4 * D + col) + 1.f);
                st_bf4(H2 + row * D + col, v[j] * rstd2 * a2 + *(const GAS f32x4*)(mb + 3 * D + col)); }
        }
    }
}
__device__ __forceinline__ void p9_rows(Frame& F, const Args& a, const float* mod, const bf16* FB) {
    int lane_ = F.lane; asm volatile("" : "+v"(lane_)); const int LN = lane_;
    const int gw = F.vcu * NWAVES + F.wave, NGW = F.G * NWAVES;
    for (int r0 = gw * 8; r0 < M; r0 += NGW * 8) {
        const int b = r0 >> 12;
#pragma unroll 1
        for (int r = 0; r < 8; ++r) { const size_t row = (size_t)(r0 + r);
            const float* mb = mod + b * NMOD; LAUNDER_PTR(mb);
            f32x4 v[16]; float ss = 0.f;
#pragma unroll
            for (int j = 0; j < 16; ++j) { v[j] = ld_bf4(FB + row * D + 4 * LN + 256 * j); ss += sumsq4(v[j]); }
            const float rstd = 1.f / sqrtf(wave_sum(ss) * (1.f / D) + NORM_EPS);
#pragma unroll
            for (int j = 0; j < 16; ++j) { const int col = 4 * LN + 256 * j; if ((j & 3) == 0) asm volatile("" ::: "memory");
                const f32x4 g2 = *(const GAS f32x4*)(mb + 5 * D + col) * *(const f32x4*)(a.g_post_mlp + col);
                float* op = a.out + row * D + col; *(f32x4*)op = *(const f32x4*)op + g2 * (v[j] * rstd); }
        }
    }
}

#ifndef SB_EARLY
#define SB_EARLY 0
#endif
__global__ void __launch_bounds__(NWAVES * 64, 2) fwd_kernel(Args args) {
    extern __shared__ __attribute__((aligned(16))) unsigned char lds[];
    Frame F;
    F.lds = (LAS unsigned char*)lds;
    F.tid = threadIdx.x; F.lane = F.tid & 63; F.wave = __builtin_amdgcn_readfirstlane(F.tid >> 6);
    F.G = gridDim.x; { const int bx = blockIdx.x; F.vcu = (F.G % 8 == 0) ? (bx % 8) * (F.G / 8) + bx / 8 : bx; }
    unsigned char* ws = args.ws;
    unsigned* ctl = (unsigned*)(ws + WS_CTL);
    float* mod = (float*)(ws + WS_MOD); float* cosT = (float*)(ws + WS_COS); float* sinT = (float*)(ws + WS_SIN);
    bf16* W1 = (bf16*)(ws + WS_W1); bf16* WPS = (bf16*)(ws + WS_WPS); bf16* WPB = (bf16*)(ws + WS_WPB); bf16* WO = (bf16*)(ws + WS_WO); bf16* WF1 = (bf16*)(ws + WS_WF1); bf16* WF2 = (bf16*)(ws + WS_WF2);
    bf16* BA = (bf16*)(ws + WS_A); bf16* BB = (bf16*)(ws + WS_B);
    bf16* QA = (bf16*)(ws + WS_C); bf16* KA = (bf16*)(ws + WS_C + 64 * MiB); bf16* VA = (bf16*)(ws + WS_C + 80 * MiB); bf16* QB = (bf16*)(ws + WS_C + 96 * MiB);
    bf16* KB = (bf16*)(ws + WS_C + 160 * MiB); bf16* VB = (bf16*)(ws + WS_C + 224 * MiB); bf16* GT = (bf16*)(ws + WS_C + 288 * MiB); bf16* UB = (bf16*)(ws + WS_C);
    bf16* ATT_SWA = BB; bf16* ATT_SB = BB + (size_t)M * 2048;
    for (int u = F.tid; u < (LDS_BYTES - LDSCTL_OFF) / 4; u += NWAVES * 64) ((LAS unsigned*)(F.lds + LDSCTL_OFF))[u] = 0u;
    __syncthreads();
    XcdBarrier bar = xcd_barrier_post(ctl + CW_BAR, (volatile LAS unsigned*)(F.lds + MISC_OFF) + 8);

    const int lo = args.ph_lo, hi = args.ph_hi;
#define IN(k) (lo <= (k) && (k) < hi)
#define BOTH(k) (IN(k) && IN((k) + 1))
    if (IN(0)) {
    {
        p0_gemv(F, args, mod);
        p0_rope_table(F, cosT, sinT);
        LAS float* scr = (LAS float*)(F.lds + F.wave * 16640);
        const int gw = F.vcu * NWAVES + F.wave, NGW = F.G * NWAVES;
        constexpr int I_IN = (D / 64) * (D_IN / 64), I_BG = (D / 64) * (NG / 64), I_PS = (2048 / 64) * (D / 64), I_O = (D / 64) * (D / 64), I_F1 = (D / 64) * (FF / 64), I_F2 = (FF / 64) * (D / 64);
        constexpr int NITEMS = I_IN + I_BG + 2 * I_PS + I_O + I_F1 + I_F2;
        for (int it = gw; it < NITEMS; it += NGW) {
            int r = it;
            if (r < I_IN) { p0_transpose_item(args.w_in, D, D_IN, W1, 0, 2560, scr, r, F.lane); continue; } r -= I_IN;
            if (r < I_BG) { p0_transpose_item(args.w_bg, D, NG, W1, D_IN, 0, scr, r, F.lane); continue; } r -= I_BG;
            if (r < I_PS) { p0_transpose_item(args.w_ps, 2048, D, WPS, 0, 0, scr, r, F.lane); continue; } r -= I_PS;
            if (r < I_PS) { p0_transpose_item(args.w_pb, 2048, D, WPB, 0, 0, scr, r, F.lane); continue; } r -= I_PS;
            if (r < I_O) { p0_transpose_item(args.w_out, D, D, WO, 0, 0, scr, r, F.lane); continue; } r -= I_O;
            if (r < I_F1) { p0_transpose_item(args.w_f1, D, FF, WF1, 0, 0, scr, r, F.lane); continue; } r -= I_F1;
            p0_transpose_item(args.w_f2, FF, D, WF2, 0, 0, scr, r, F.lane);
        }
    }
        if (BOTH(0)) xcd_barrier(bar);
    }
    if (IN(1)) {
    p1_rows(F, args, mod, BA);
        if (BOTH(1)) xcd_barrier(bar);
    }
    if (IN(2)) {
    {
        pg8::Gemm g{BA, W1, BA, W1, M, N1, D}; pg8::StaticOrder S; S.init(M, N1, F.G, (int)blockIdx.x);
        pg8::EpiProj E{QA, KA, VA, QB, KB, VB, GT, cosT, sinT, args.b_bg, 0.12751743f  };
        pg8::gemm_phase<pg8::EpiProj, pg8::StaticOrder, true, true>(F.lds + RING_OFF, g, S, E);
    }
        if (BOTH(2)) xcd_barrier(bar);
    }
    if (IN(3)) {
    {
        int atid = F.tid; asm volatile("" : "+v"(atid)); const int alane = atid & 63, awave = __builtin_amdgcn_readfirstlane(atid >> 6);
        for (int quad = F.vcu; quad < 256; quad += F.G) { const int bh = quad >> 2, r = quad & 3, b = bh >> 4, hh = bh & 15;
            for (int j = 0; j < 4; ++j) { const int qb = (j == 0) ? 15 - r : (j == 1) ? 11 - r : (j == 2) ? 4 + r : r;
                att::attn_unit<1, (SB_EARLY != 0)>(F.lds, QB + hh * HD, KB + hh * HD, VB + hh * HD, ATT_SB + hh * HD, 2048, 2048, 2048, b, qb, 0.f, atid, awave, alane); } }
        for (int quad = F.vcu; quad < 256; quad += F.G) {
            for (int j = 0; j < 4; ++j) { const int id = quad * 4 + j, b = id >> 8, hq = (id >> 4) & 15, qb = id & 15;
                att::attn_unit<0, false>(F.lds, QA + hq * HD, KA + (hq >> 2) * HD, VA + (hq >> 2) * HD, ATT_SWA + hq * HD, 2048, 512, 2048, b, qb, args.sinks[hq] * 1.44269504089f, atid, awave, alane); } }
    }
        if (BOTH(3)) xcd_barrier(bar);
    }
    if (IN(4)) {
    {
        pg8::Gemm g{ATT_SWA, WPS, ATT_SB, WPB, M, D, 2048}; pg8::PairOrder S; S.S.init(M, D, F.G, (int)blockIdx.x);
        pg8::EpiMix E{BA, GT};
        pg8::gemm_phase<pg8::EpiMix, pg8::PairOrder, true, true>(F.lds + RING_OFF, g, S, E);
    }
        if (BOTH(4)) xcd_barrier(bar);
    }
    if (IN(5)) {
    {
        pg8::Gemm g{BA, WO, BA, WO, M, D, D}; pg8::StaticOrder S; S.init(M, D, F.G, (int)blockIdx.x);
        pg8::EpiSimple<0> E{BB, D};
        pg8::gemm_phase<pg8::EpiSimple<0>, pg8::StaticOrder, true, true>(F.lds + RING_OFF, g, S, E);
    }
        if (BOTH(5)) xcd_barrier(bar);
    }
    if (IN(6)) {
    p6_rows(F, args, mod, BB, BA);
        if (BOTH(6)) xcd_barrier(bar);
    }
    if (IN(7)) {
    {
        pg8::Gemm g{BA, WF1, BA, WF1, M, FF, D}; pg8::StaticOrder S; S.init(M, FF, F.G, (int)blockIdx.x);
        pg8::EpiSimple<1> E{UB, FF};
        pg8::gemm_phase<pg8::EpiSimple<1>, pg8::StaticOrder, true, true>(F.lds + RING_OFF, g, S, E);
    }
        if (BOTH(7)) xcd_barrier(bar);
    }
    if (IN(8)) {
    {
        pg8::Gemm g{UB, WF2, UB, WF2, M, D, FF}; pg8::StaticOrder S; S.init(M, D, F.G, (int)blockIdx.x);
        pg8::EpiSimple<0> E{BB, D};
        pg8::gemm_phase<pg8::EpiSimple<0>, pg8::StaticOrder, true, true>(F.lds + RING_OFF, g, S, E);
    }
        if (BOTH(8)) xcd_barrier(bar);
    }
    if (IN(9)) {
    p9_rows(F, args, mod, BB);
        if (BOTH(9)) xcd_barrier(bar);
    }
#undef IN
#undef BOTH
}

extern "C" void kernel_launch(void* const* d_in, const int* in_sizes, int n_in, void* d_out, int out_size, void* d_ws, size_t ws_size, hipStream_t stream) {
    static int grid = 0;
    if (grid == 0) {
        if (n_in != 17 || in_sizes[0] != M * D || out_size != M * D || ws_size < WS_END) { fprintf(stderr, "kernel_launch: unexpected shapes / workspace (n_in %d, in0 %d, out %d, ws %zu, need %zu); nothing launched\n", n_in, n_in > 0 ? in_sizes[0] : -1, out_size, ws_size, (size_t)WS_END); grid = -1; return; }
        int dev = 0, cus = 0, per_cu = 0;
        if (hipGetDevice(&dev) != hipSuccess || hipDeviceGetAttribute(&cus, hipDeviceAttributeMultiprocessorCount, dev) != hipSuccess) { fprintf(stderr, "kernel_launch: device query failed\n"); grid = -1; return; }
        if (hipFuncSetAttribute((const void*)fwd_kernel, hipFuncAttributeMaxDynamicSharedMemorySize, LDS_BYTES) != hipSuccess) { fprintf(stderr, "kernel_launch: hipFuncSetAttribute failed\n"); grid = -1; return; }
        if (hipOccupancyMaxActiveBlocksPerMultiprocessor(&per_cu, (const void*)fwd_kernel, NWAVES * 64, LDS_BYTES) != hipSuccess || per_cu < 1) { fprintf(stderr, "kernel_launch: occupancy query says %d blocks per CU\n", per_cu); }
        (void)hipGetLastError();
        grid = cus;
    }
    if (grid < 0) return;
    if (hipMemsetAsync((char*)d_ws + WS_CTL, 0, CTL_ZERO_BYTES, stream) != hipSuccess) { fprintf(stderr, "kernel_launch: memset failed\n"); return; }
    Args a{};
    a.x = (const float*)d_in[0]; a.c = (const float*)d_in[1]; a.w_ada = (const float*)d_in[2]; a.b_ada = (const float*)d_in[3]; a.g_pre_mix = (const float*)d_in[4]; a.g_post_mix = (const float*)d_in[5];
    a.g_pre_mlp = (const float*)d_in[6]; a.g_post_mlp = (const float*)d_in[7]; a.w_in = (const float*)d_in[8]; a.sinks = (const float*)d_in[9]; a.w_bg = (const float*)d_in[10]; a.b_bg = (const float*)d_in[11];
    a.w_ps = (const float*)d_in[12]; a.w_pb = (const float*)d_in[13]; a.w_out = (const float*)d_in[14]; a.w_f1 = (const float*)d_in[15]; a.w_f2 = (const float*)d_in[16];
    a.out = (float*)d_out; a.ws = (unsigned char*)d_ws;
#ifndef MK_N_LAUNCHES
#define MK_N_LAUNCHES 1
#endif
    constexpr int NPH = 10;
    for (int li = 0; li < MK_N_LAUNCHES; ++li) {
        a.ph_lo = (MK_N_LAUNCHES == 1) ? 0 : li; a.ph_hi = (MK_N_LAUNCHES == 1) ? NPH : li + 1;
        hipLaunchKernelGGL(fwd_kernel, dim3(grid), dim3(NWAVES * 64), LDS_BYTES, stream, a);
        const hipError_t le = hipPeekAtLastError();
        if (le != hipSuccess) { fprintf(stderr, "kernel_launch: launch failed: %s\n", hipGetErrorName(le)); break; }
    }
}
```

```cpp
#include <hip/hip_runtime.h>
#include <cstdio>
#include <cstdint>
#define MK_N_LAUNCHES 1
#ifndef DUP_PHASE
#define DUP_PHASE -1
#endif
#ifndef DUP_SUB
#define DUP_SUB 0
#endif

namespace pg8 {
#define PG8_LAS __attribute__((address_space(3)))
typedef unsigned short bf16_t;
typedef short bf16x8 __attribute__((ext_vector_type(8)));
typedef float f32x4 __attribute__((ext_vector_type(4)));
typedef unsigned u32x4 __attribute__((ext_vector_type(4)));
typedef int v4i_t __attribute__((ext_vector_type(4)));
typedef unsigned u32x2 __attribute__((ext_vector_type(2)));
constexpr int BM = 256, BK = 64, HALF = 128, HTB = HALF * BK * 2  , STAGE_BYTES = 8 * HTB, NXCD = 8, WGM = 8;

__host__ __device__ __forceinline__ int lds_byte(int r, int c) { const int st = (r >> 4) * 2 + (c >> 5), rr = r & 15, cc = c & 31, ob = rr * 64 + cc * 2; return st * 1024 + (ob ^ (((ob >> 9) & 1) << 5)); }
__host__ __device__ __forceinline__ void stage_rc(int b, int& R, int& C) { const int st = b / 1024, sb = b % 1024, swz = sb ^ (((sb >> 9) & 1) << 5); R = (st >> 1) * 16 + swz / 64; C = (st & 1) * 32 + (swz % 64) / 2; }
__host__ __device__ __forceinline__ int perm32(int rho) { const int n = rho >> 4, i = rho & 15; return 8 * (i >> 2) + 4 * n + (i & 3); }

struct Unit { int pm, pn, kind; };
struct Gemm { const bf16_t* A0; const bf16_t* B0; const bf16_t* A1; const bf16_t* B1; int M, N, K; };

struct StaticOrder {
    int nM, nN, nwg, G, c, wgm;
    __host__ __device__ void init(int M, int N, int G_, int c_, int wgm_ = WGM) { nM = M / BM; nN = N / BM; nwg = nM * nN; G = G_; c = c_; wgm = wgm_; }
    __host__ __device__ bool next(int i, Unit& u) const {
        const long L = (long)i * G + c; if (L >= nwg) return false;
        int wgid = (int)L; { const int q = nwg / NXCD, r = nwg % NXCD, xcd = wgid % NXCD, off = wgid / NXCD; wgid = (xcd < r ? xcd * (q + 1) : r * (q + 1) + (xcd - r) * q) + off; }
        const int nig = wgm * nN, gid = wgid / nig, fm = gid * wgm, gsz = (nM - fm) < wgm ? (nM - fm) : wgm;
        u.pm = fm + ((wgid % nig) % gsz); u.pn = (wgid % nig) / gsz; u.kind = 0; return true;
    }
    __device__ __forceinline__ void a_ready(const Unit&) const {}
    __device__ __forceinline__ void done(const Unit&) const {}
};
struct PairOrder {
    StaticOrder S;
    __host__ __device__ bool next(int i, Unit& u) const { if (!S.next(i >> 1, u)) return false; u.kind = i & 1; return true; }
    __device__ __forceinline__ void a_ready(const Unit&) const {}
    __device__ __forceinline__ void done(const Unit&) const {}
};

typedef float f32x2_t __attribute__((ext_vector_type(2))); typedef __bf16 bf16x2_t __attribute__((ext_vector_type(2)));
__device__ __forceinline__ unsigned cvt_pk_bf16(float lo, float hi) { f32x2_t v = {lo, hi}; bf16x2_t b = __builtin_convertvector(v, bf16x2_t); return __builtin_bit_cast(unsigned, b); }
__device__ __forceinline__ f32x4 bf_lo4(unsigned a, unsigned b) { return (f32x4){__uint_as_float(a << 16), __uint_as_float(a & 0xffff0000u), __uint_as_float(b << 16), __uint_as_float(b & 0xffff0000u)}; }
__device__ __forceinline__ u32x4 pack8(f32x4 v0, f32x4 v1) { u32x4 w; w.x = cvt_pk_bf16(v0[0], v0[1]); w.y = cvt_pk_bf16(v0[2], v0[3]); w.z = cvt_pk_bf16(v1[0], v1[1]); w.w = cvt_pk_bf16(v1[2], v1[3]); return w; }

template <int ACT  , bool NT = false> struct EpiSimple {
    static constexpr bool PERM = true, AFTER_DRAIN = false, CHAIN = false;
    __device__ __forceinline__ bool keep_acc(const Unit&) const { return false; }
    bf16_t* O; int ldc;
    __device__ __forceinline__ void operator()(const f32x4 (&acc)[2][2][4][2], const Unit& u, int wr, int wc, int fr, int fq) const {
        const int row0 = u.pm * BM + wr * 64 + fr, col0 = u.pn * BM + wc * 32 + 8 * fq;
#pragma unroll
        for (int ai = 0; ai < 2; ++ai)
#pragma unroll
            for (int m = 0; m < 4; ++m) { bf16_t* rowp = O + (size_t)(row0 + ai * HALF + m * 16) * ldc + col0;
#pragma unroll
                for (int bj = 0; bj < 2; ++bj) { f32x4 v0 = acc[ai][bj][m][0], v1 = acc[ai][bj][m][1];
                    if (ACT == 1) {
#pragma unroll
                        for (int j = 0; j < 4; ++j) { const float a = fmaxf(v0[j], 0.f), b = fmaxf(v1[j], 0.f); v0[j] = a * a; v1[j] = b * b; } }
                    if (NT) __builtin_nontemporal_store(pack8(v0, v1), (u32x4*)(rowp + bj * HALF)); else *(u32x4*)(rowp + bj * HALF) = pack8(v0, v1); } }
    }
};

struct EpiProj {
    static constexpr bool PERM = true, AFTER_DRAIN = false, CHAIN = false;
    __device__ __forceinline__ bool keep_acc(const Unit&) const { return false; }
    bf16_t *KA, *VA, *VB; const float* cosT; const float* sinT;
    __device__ __forceinline__ void operator()(const f32x4 (&acc)[2][2][4][2], const Unit& u, int wr, int wc, int fr, int fq) const {
        const int pn = u.pn, row0 = u.pm * BM + wr * 64 + fr, cl = wc * 32 + 8 * fq;
        bf16_t* base; int ld, colt; bool rope = false;
        if (pn < 2)       { base = KA; ld = 512;  colt = pn * 256; rope = true; }
        else if (pn < 4)  { base = VA; ld = 512;  colt = (pn - 2) * 256; }
        else              { base = VB; ld = 2048; colt = (pn - 4) * 256; }
        if (rope) {
#pragma unroll
            for (int ai = 0; ai < 2; ++ai)
#pragma unroll
                for (int m = 0; m < 4; ++m) { const int row = row0 + ai * HALF + m * 16; const int pos = row & 4095;
                    const f32x4 c4 = *(const f32x4*)(cosT + pos * 64 + (cl >> 1)), s4 = *(const f32x4*)(sinT + pos * 64 + (cl >> 1));
                    bf16_t* rowp = base + (size_t)row * ld + colt + cl;
#pragma unroll
                    for (int bj = 0; bj < 2; ++bj) { const f32x4 x1 = acc[ai][bj][m][0], x2 = acc[ai][bj][m][1];
                        *(u32x4*)(rowp + bj * HALF) = pack8(x1 * c4 - x2 * s4, x2 * c4 + x1 * s4); } }
        } else {
#pragma unroll
            for (int ai = 0; ai < 2; ++ai)
#pragma unroll
                for (int m = 0; m < 4; ++m) { bf16_t* rowp = base + (size_t)(row0 + ai * HALF + m * 16) * ld + colt + cl;
#pragma unroll
                    for (int bj = 0; bj < 2; ++bj) *(u32x4*)(rowp + bj * HALF) = pack8(acc[ai][bj][m][0], acc[ai][bj][m][1]); }
        }
    }
};

__device__ __forceinline__ f32x4 i2f4(f32x4 a) { const v4i_t i = __builtin_bit_cast(v4i_t, a); return (f32x4){(float)i[0], (float)i[1], (float)i[2], (float)i[3]}; }
struct EpiI8Proj {
    static constexpr bool PERM = true, AFTER_DRAIN = false, CHAIN = false;
    __device__ __forceinline__ bool keep_acc(const Unit&) const { return false; }
    bf16_t *QA, *QB, *KB, *GT; const float* cosT; const float* sinT; const float* gbias; const float* sa; const float* sb; float qscale;
    __device__ __forceinline__ void operator()(const f32x4 (&acc)[2][2][4][2], const Unit& u, int wr, int wc, int fr, int fq) const {
        const int pn = u.pn, row0 = u.pm * BM + wr * 64 + fr, cl = wc * 32 + 8 * fq;
        f32x4 sv[2][2];
#pragma unroll
        for (int bj = 0; bj < 2; ++bj)
#pragma unroll
            for (int n = 0; n < 2; ++n) sv[bj][n] = *(const f32x4*)(sb + pn * 256 + bj * HALF + cl + 4 * n);
        if (pn < 8) {
            const int colt = pn * 256;
#pragma unroll
            for (int ai = 0; ai < 2; ++ai)
#pragma unroll
                for (int m = 0; m < 4; ++m) { const int row = row0 + ai * HALF + m * 16; const int pos = row & 4095; const float sr = sa[row] * qscale;
                    const f32x4 c4 = *(const f32x4*)(cosT + pos * 64 + (cl >> 1)), s4 = *(const f32x4*)(sinT + pos * 64 + (cl >> 1));
                    bf16_t* rowp = QA + (size_t)row * 2048 + colt + cl;
#pragma unroll
                    for (int bj = 0; bj < 2; ++bj) { const f32x4 x1 = i2f4(acc[ai][bj][m][0]) * (sv[bj][0] * sr), x2 = i2f4(acc[ai][bj][m][1]) * (sv[bj][1] * sr);
                        *(u32x4*)(rowp + bj * HALF) = pack8(x1 * c4 - x2 * s4, x2 * c4 + x1 * s4); } }
        } else if (pn < 24) {
            const bool isq = pn < 16; const int colt = (isq ? pn - 8 : pn - 16) * 256; bf16_t* basep = isq ? QB : KB; const float qs = isq ? qscale : 1.f;
#pragma unroll
            for (int ai = 0; ai < 2; ++ai)
#pragma unroll
                for (int m = 0; m < 4; ++m) { const int row = row0 + ai * HALF + m * 16; const float sr = sa[row] * qs; bf16_t* rowp = basep + (size_t)row * 2048 + colt + cl;
#pragma unroll
                    for (int bj = 0; bj < 2; ++bj) *(u32x4*)(rowp + bj * HALF) = pack8(i2f4(acc[ai][bj][m][0]) * (sv[bj][0] * sr), i2f4(acc[ai][bj][m][1]) * (sv[bj][1] * sr)); }
        } else {
            const int colt = (pn - 24) * 256;
            f32x4 bv[2][2];
#pragma unroll
            for (int bj = 0; bj < 2; ++bj)
#pragma unroll
                for (int n = 0; n < 2; ++n) { bv[bj][n] = *(const f32x4*)(gbias + colt + bj * HALF + cl + 4 * n) * -1.44269504089f; sv[bj][n] = sv[bj][n] * -1.44269504089f; }
            unsigned char* tp = (unsigned char*)GT + ((size_t)(u.pm * 32 + (pn - 24)) << 16) + (wr * 4 + wc) * 8192 + (fr + 16 * fq) * 16;
#pragma unroll
            for (int ai = 0; ai < 2; ++ai)
#pragma unroll
                for (int m = 0; m < 4; ++m) { const int row = row0 + ai * HALF + m * 16; const float sr = sa[row]; u32x4 w4;
#pragma unroll
                    for (int bj = 0; bj < 2; ++bj) { f32x4 v0 = i2f4(acc[ai][bj][m][0]) * (sv[bj][0] * sr) + bv[bj][0], v1 = i2f4(acc[ai][bj][m][1]) * (sv[bj][1] * sr) + bv[bj][1];
#pragma unroll
                        for (int j = 0; j < 4; ++j) { v0[j] = __builtin_rintf(255.f * __builtin_amdgcn_rcpf(1.f + __builtin_amdgcn_exp2f(v0[j]))); v1[j] = __builtin_rintf(255.f * __builtin_amdgcn_rcpf(1.f + __builtin_amdgcn_exp2f(v1[j]))); }
                        const unsigned wx = (unsigned)v0[0] | ((unsigned)v0[1] << 8) | ((unsigned)v0[2] << 16) | ((unsigned)v0[3] << 24), wy = (unsigned)v1[0] | ((unsigned)v1[1] << 8) | ((unsigned)v1[2] << 16) | ((unsigned)v1[3] << 24);
                        if (bj == 0) { w4.x = wx; w4.y = wy; } else { w4.z = wx; w4.w = wy; } }
                    *(u32x4*)(tp + (ai * 4 + m) * 1024) = w4; }
        }
    }
};
struct EpiFfOutI8 {
    static constexpr bool PERM = true, AFTER_DRAIN = false, CHAIN = false;
    __device__ __forceinline__ bool keep_acc(const Unit&) const { return false; }
    bf16_t* O; int ldc; const float* sa; const float* sb; const int* cs;
    __device__ __forceinline__ void operator()(const f32x4 (&acc)[2][2][4][2], const Unit& u, int wr, int wc, int fr, int fq) const {
        const int row0 = u.pm * BM + wr * 64 + fr, col0 = u.pn * BM + wc * 32 + 8 * fq;
        f32x4 sv[2][2]; v4i_t cv[2][2];
#pragma unroll
        for (int bj = 0; bj < 2; ++bj)
#pragma unroll
            for (int n = 0; n < 2; ++n) { sv[bj][n] = *(const f32x4*)(sb + col0 + bj * HALF + 4 * n); cv[bj][n] = *(const v4i_t*)(cs + col0 + bj * HALF + 4 * n) * 128; }
#pragma unroll
        for (int ai = 0; ai < 2; ++ai)
#pragma unroll
            for (int m = 0; m < 4; ++m) { const int row = row0 + ai * HALF + m * 16; const float sr = sa[row]; bf16_t* rowp = O + (size_t)row * ldc + col0;
#pragma unroll
                for (int bj = 0; bj < 2; ++bj) { const v4i_t i0 = __builtin_bit_cast(v4i_t, acc[ai][bj][m][0]) + cv[bj][0], i1 = __builtin_bit_cast(v4i_t, acc[ai][bj][m][1]) + cv[bj][1];
                    *(u32x4*)(rowp + bj * HALF) = pack8((f32x4){(float)i0[0], (float)i0[1], (float)i0[2], (float)i0[3]} * (sv[bj][0] * sr), (f32x4){(float)i1[0], (float)i1[1], (float)i1[2], (float)i1[3]} * (sv[bj][1] * sr)); } }
    }
};
struct EpiRelu2I8 {
    static constexpr bool PERM = true, AFTER_DRAIN = false, CHAIN = false;
    __device__ __forceinline__ bool keep_acc(const Unit&) const { return false; }
    bf16_t* O; int ldc; const float* sa; const float* sb;
    __device__ __forceinline__ void operator()(const f32x4 (&acc)[2][2][4][2], const Unit& u, int wr, int wc, int fr, int fq) const {
        const int row0 = u.pm * BM + wr * 64 + fr, col0 = u.pn * BM + wc * 32 + 8 * fq;
        f32x4 sv[2][2];
#pragma unroll
        for (int bj = 0; bj < 2; ++bj)
#pragma unroll
            for (int n = 0; n < 2; ++n) sv[bj][n] = *(const f32x4*)(sb + col0 + bj * HALF + 4 * n);
#pragma unroll
        for (int ai = 0; ai < 2; ++ai)
#pragma unroll
            for (int m = 0; m < 4; ++m) { const int row = row0 + ai * HALF + m * 16; const float sr = sa[row]; bf16_t* rowp = O + (size_t)row * ldc + col0;
#pragma unroll
                for (int bj = 0; bj < 2; ++bj) { f32x4 v0 = i2f4(acc[ai][bj][m][0]) * (sv[bj][0] * sr), v1 = i2f4(acc[ai][bj][m][1]) * (sv[bj][1] * sr);
#pragma unroll
                    for (int j = 0; j < 4; ++j) { const float p = fmaxf(v0[j], 0.f), q = fmaxf(v1[j], 0.f); v0[j] = p * p; v1[j] = q * q; }
                    *(u32x4*)(rowp + bj * HALF) = pack8(v0, v1); } }
    }
};

struct EpiMix {
    static constexpr bool PERM = true, AFTER_DRAIN = false, CHAIN = true;
    bf16_t* O; const unsigned char* G;
    static __device__ __forceinline__ f32x4 ub4(unsigned w) { return (f32x4){(float)(w & 255u), (float)((w >> 8) & 255u), (float)((w >> 16) & 255u), (float)(w >> 24)}; }
    __device__ __forceinline__ void operator()(f32x4 (&acc)[2][2][4][2], const Unit& u, int wr, int wc, int fr, int fq) const {
        const int row0 = u.pm * BM + wr * 64 + fr, col0 = u.pn * BM + wc * 32 + 8 * fq; const int kind = u.kind;
        const unsigned char* ta = G + ((size_t)(u.pm * 32 + u.pn) << 16) + (wr * 4 + wc) * 8192 + (fr + 16 * fq) * 16;
        const unsigned char* tb = ta + ((size_t)16 << 16);
        if (kind == 0) {
#pragma unroll
            for (int ai = 0; ai < 2; ++ai)
#pragma unroll
                for (int m = 0; m < 4; ++m) { const u32x4 ga4 = *(const u32x4*)(ta + (ai * 4 + m) * 1024), gb4 = *(const u32x4*)(tb + (ai * 4 + m) * 1024);
#pragma unroll
                    for (int bj = 0; bj < 2; ++bj) { const unsigned gax = bj ? ga4.z : ga4.x, gay = bj ? ga4.w : ga4.y, gbx = bj ? gb4.z : gb4.x, gby = bj ? gb4.w : gb4.y;
                        f32x4 b0 = ub4(gbx), b1 = ub4(gby);
#pragma unroll
                        for (int j = 0; j < 4; ++j) { b0[j] = __builtin_amdgcn_rcpf(fmaxf(b0[j], 2.3191e-10f)); b1[j] = __builtin_amdgcn_rcpf(fmaxf(b1[j], 2.3191e-10f)); }
                        acc[ai][bj][m][0] *= ub4(gax) * b0; acc[ai][bj][m][1] *= ub4(gay) * b1; } }
        } else {
#pragma unroll
            for (int ai = 0; ai < 2; ++ai)
#pragma unroll
                for (int m = 0; m < 4; ++m) { const size_t row = (size_t)(row0 + ai * HALF + m * 16); const u32x4 gb4 = *(const u32x4*)(tb + (ai * 4 + m) * 1024);
#pragma unroll
                    for (int bj = 0; bj < 2; ++bj) { const int col = col0 + bj * HALF; const unsigned gbx = bj ? gb4.z : gb4.x, gby = bj ? gb4.w : gb4.y;
                        f32x4 b0 = ub4(gbx), b1 = ub4(gby);
#pragma unroll
                        for (int j = 0; j < 4; ++j) { b0[j] = fmaxf(b0[j], 2.3191e-10f) * (1.f / 255.f); b1[j] = fmaxf(b1[j], 2.3191e-10f) * (1.f / 255.f); }
                        *(u32x4*)(O + row * 4096 + col) = pack8(acc[ai][bj][m][0] * b0, acc[ai][bj][m][1] * b1); } }
        }
    }
    __device__ __forceinline__ bool keep_acc(const Unit& u) const { return u.kind == 0; }
};

template <class Epi, class Sched, bool ALIGN_EPI = false, bool SP2 = false, bool I8 = false>
__device__ __forceinline__ void gemm_phase(PG8_LAS unsigned char* lds, const Gemm g, const Sched& S, const Epi& E) {
    int tid_ = threadIdx.x; asm volatile("" : "+v"(tid_));
    const int tid = tid_, wid = __builtin_amdgcn_readfirstlane(tid >> 6), lane = tid & 63, wr = wid >> 2, wc = wid & 3, fr = lane & 15, fq = lane >> 4;
    const int K = g.K, nt = K / BK;
    unsigned voffA[2], voffB[2];
#pragma unroll
    for (int i = 0; i < 2; ++i) { int R, C; stage_rc(tid * 16 + i * 8192, R, C); const int Rb = Epi::PERM ? ((R & ~31) + perm32(R & 31)) : R;
        voffA[i] = (unsigned)(R * K + C) * 2u; voffB[i] = (unsigned)(Rb * K + C) * 2u; }
    const size_t kstep = (size_t)(BK * 2);
    const size_t hstep = (size_t)HALF * K * 2;
    const size_t tstep = 2 * hstep;
    const unsigned ldsw = (unsigned)wid * 1024u;
    const int aoff = lds_byte(wr * 64 + fr, fq * 8), boff = lds_byte(wc * 32 + fr, fq * 8);
#define PG8_SA(b, h) (((b) * 2 + (h)) * HTB)
#define PG8_SB(b, h) ((4 + (b) * 2 + (h)) * HTB)
#define PG8_STAGE(bufoff, gbase, voff) do { _Pragma("unroll") for (int _i = 0; _i < 2; ++_i) \
        __builtin_amdgcn_global_load_lds((const unsigned*)((const char*)(gbase) + (voff)[_i]), (PG8_LAS unsigned*)(lds + (bufoff) + ldsw + _i * 8192), 16, 0, 0); } while (0)
#define PG8_LDA(dst, b, h) do { _Pragma("unroll") for (int m = 0; m < 4; ++m) _Pragma("unroll") for (int k = 0; k < 2; ++k) dst[m][k] = *(const PG8_LAS bf16x8*)(lds + PG8_SA(b, h) + aoff + m * 2048 + k * 1024); } while (0)
#define PG8_LDB(dst, b, h) do { _Pragma("unroll") for (int n = 0; n < 2; ++n) _Pragma("unroll") for (int k = 0; k < 2; ++k) dst[n][k] = *(const PG8_LAS bf16x8*)(lds + PG8_SB(b, h) + boff + n * 2048 + k * 1024); } while (0)
#define PG8_MMA(ai, bj, At, Bt) do { __builtin_amdgcn_s_setprio(1); _Pragma("unroll") for (int m = 0; m < 4; ++m) _Pragma("unroll") for (int n = 0; n < 2; ++n) _Pragma("unroll") for (int k = 0; k < 2; ++k) { \
        if constexpr (I8) acc[ai][bj][m][n] = __builtin_bit_cast(f32x4, __builtin_amdgcn_mfma_i32_16x16x64_i8(__builtin_bit_cast(v4i_t, Bt[n][k]), __builtin_bit_cast(v4i_t, At[m][k]), __builtin_bit_cast(v4i_t, acc[ai][bj][m][n]), 0, 0, 0)); \
        else acc[ai][bj][m][n] = __builtin_amdgcn_mfma_f32_16x16x32_bf16(Bt[n][k], At[m][k], acc[ai][bj][m][n], 0, 0, 0); } __builtin_amdgcn_s_setprio(0); } while (0)
#define PG8_WAIT_V(n) asm volatile("s_waitcnt vmcnt(" #n ")" ::: "memory")
#define PG8_WAIT_L(n) asm volatile("s_waitcnt lgkmcnt(" #n ")" ::: "memory")
#define PG8_BAR __builtin_amdgcn_s_barrier()
#define PG8_SCHED __builtin_amdgcn_sched_barrier(0)
    Unit cur, nxt; int ui = 0;
    if (!S.next(0, cur)) return;
    f32x4 acc[2][2][4][2];
#pragma unroll
    for (int a = 0; a < 2; ++a)
#pragma unroll
        for (int b = 0; b < 2; ++b)
#pragma unroll
            for (int m = 0; m < 4; ++m)
#pragma unroll
                for (int n = 0; n < 2; ++n) acc[a][b][m][n] = (f32x4){0.f, 0.f, 0.f, 0.f};
    bf16x8 At[4][2], B0[2][2], B1[2][2];
    const char* cA = (const char*)(cur.kind ? g.A1 : g.A0) + (size_t)cur.pm * tstep; const char* cB = (const char*)(cur.kind ? g.B1 : g.B0) + (size_t)cur.pn * tstep;
    S.a_ready(cur);
    if constexpr (SP2) {
        PG8_STAGE(PG8_SB(0, 0), cB, voffB); PG8_STAGE(PG8_SB(0, 1), cB + hstep, voffB); PG8_STAGE(PG8_SA(0, 0), cA, voffA); PG8_STAGE(PG8_SA(0, 1), cA + hstep, voffA);
        if (wr == 1) PG8_BAR;
        PG8_WAIT_V(2); PG8_BAR;
        PG8_STAGE(PG8_SB(1, 0), cB + kstep, voffB); PG8_STAGE(PG8_SA(1, 0), cA + kstep, voffA); PG8_STAGE(PG8_SB(1, 1), cB + hstep + kstep, voffB);
        PG8_WAIT_V(6); PG8_BAR;
    } else {
        PG8_STAGE(PG8_SB(0, 0), cB, voffB); PG8_STAGE(PG8_SA(0, 0), cA, voffA); PG8_STAGE(PG8_SB(0, 1), cB + hstep, voffB); PG8_STAGE(PG8_SA(0, 1), cA + hstep, voffA);
        if (wr == 1) PG8_BAR;
        PG8_WAIT_V(4); PG8_BAR;
        PG8_STAGE(PG8_SB(1, 0), cB + kstep, voffB); PG8_STAGE(PG8_SA(1, 0), cA + kstep, voffA); PG8_STAGE(PG8_SB(1, 1), cB + hstep + kstep, voffB);
        PG8_WAIT_V(6); PG8_BAR;
    }
    for (;;) {
        const bool has_next = S.next(ui + 1, nxt);
        const char* nA = has_next ? (const char*)(nxt.kind ? g.A1 : g.A0) + (size_t)nxt.pm * tstep : cA; const char* nB = has_next ? (const char*)(nxt.kind ? g.B1 : g.B0) + (size_t)nxt.pn * tstep : cB;
        for (int t = 0; t < nt; t += 2) {
            const bool last = (t == nt - 2);
            const char* a1 = cA + (size_t)(t + 1) * kstep;
            const char* a2 = last ? nA : cA + (size_t)(t + 2) * kstep; const char* b2 = last ? nB : cB + (size_t)(t + 2) * kstep;
            const char* a3 = a2 + kstep; const char* b3 = b2 + kstep;
            if (last && has_next) S.a_ready(nxt);
            if constexpr (SP2) {
            PG8_LDB(B0, 0, 0); PG8_LDB(B1, 0, 1); PG8_SCHED; PG8_LDA(At, 0, 0); PG8_STAGE(PG8_SA(1, 1), a1 + hstep, voffA);
            PG8_WAIT_V(8); PG8_WAIT_L(0); PG8_BAR; PG8_MMA(0, 0, At, B0); PG8_MMA(0, 1, At, B1); PG8_BAR; PG8_SCHED;
            PG8_LDA(At, 0, 1); PG8_STAGE(PG8_SB(0, 0), b2, voffB); PG8_STAGE(PG8_SB(0, 1), b2 + hstep, voffB); PG8_STAGE(PG8_SA(0, 0), a2, voffA);
            PG8_WAIT_V(8); PG8_WAIT_L(0); PG8_BAR; PG8_MMA(1, 0, At, B0); PG8_MMA(1, 1, At, B1); PG8_BAR; PG8_SCHED;
            PG8_LDB(B0, 1, 0); PG8_LDB(B1, 1, 1); PG8_SCHED; PG8_LDA(At, 1, 0); PG8_STAGE(PG8_SA(0, 1), a2 + hstep, voffA);
            PG8_WAIT_V(8); PG8_WAIT_L(0); PG8_BAR; PG8_MMA(0, 0, At, B0); PG8_MMA(0, 1, At, B1); PG8_BAR; PG8_SCHED;
            PG8_LDA(At, 1, 1); PG8_STAGE(PG8_SB(1, 0), b3, voffB); PG8_STAGE(PG8_SB(1, 1), b3 + hstep, voffB); PG8_STAGE(PG8_SA(1, 0), a3, voffA);
            PG8_WAIT_V(8); PG8_WAIT_L(0); PG8_BAR; PG8_MMA(1, 0, At, B0); PG8_MMA(1, 1, At, B1); PG8_BAR; PG8_SCHED;
            } else {
            PG8_LDB(B0, 0, 0); PG8_SCHED; PG8_LDA(At, 0, 0); PG8_STAGE(PG8_SA(1, 1), a1 + hstep, voffA);
            PG8_WAIT_L(8); PG8_BAR; PG8_WAIT_L(0); PG8_MMA(0, 0, At, B0); PG8_BAR; PG8_SCHED;
            PG8_LDB(B1, 0, 1); PG8_STAGE(PG8_SB(0, 0), b2, voffB);
            PG8_BAR; PG8_WAIT_L(0); PG8_MMA(0, 1, At, B1); PG8_BAR;
            PG8_LDA(At, 0, 1); PG8_STAGE(PG8_SA(0, 0), a2, voffA);
            PG8_BAR; PG8_WAIT_L(0); PG8_MMA(1, 0, At, B0); PG8_BAR; PG8_SCHED;
            PG8_STAGE(PG8_SB(0, 1), b2 + hstep, voffB);
            PG8_WAIT_V(6); PG8_BAR; PG8_MMA(1, 1, At, B1); PG8_BAR;
            PG8_LDB(B0, 1, 0); PG8_SCHED; PG8_LDA(At, 1, 0); PG8_STAGE(PG8_SA(0, 1), a2 + hstep, voffA);
            PG8_WAIT_L(8); PG8_BAR; PG8_WAIT_L(0); PG8_MMA(0, 0, At, B0); PG8_BAR; PG8_SCHED;
            PG8_LDB(B1, 1, 1); PG8_STAGE(PG8_SB(1, 0), b3, voffB);
            PG8_BAR; PG8_WAIT_L(0); PG8_MMA(0, 1, At, B1); PG8_BAR;
            PG8_LDA(At, 1, 1); PG8_STAGE(PG8_SA(1, 0), a3, voffA);
            PG8_BAR; PG8_WAIT_L(0); PG8_MMA(1, 0, At, B0); PG8_BAR; PG8_SCHED;
            PG8_STAGE(PG8_SB(1, 1), b3 + hstep, voffB);
            PG8_WAIT_V(6); PG8_BAR; PG8_MMA(1, 1, At, B1); PG8_BAR;
            }
        }
        if constexpr (ALIGN_EPI) { if (wr == 0) PG8_BAR; }
        if constexpr (!Epi::AFTER_DRAIN) { E(acc, cur, wr, wc, fr, fq); S.done(cur); }
        if (!has_next) break;
        if (!(Epi::CHAIN && E.keep_acc(cur))) {
#pragma unroll
        for (int a = 0; a < 2; ++a)
#pragma unroll
            for (int b = 0; b < 2; ++b)
#pragma unroll
                for (int m = 0; m < 4; ++m)
#pragma unroll
                    for (int n = 0; n < 2; ++n) acc[a][b][m][n] = (f32x4){0.f, 0.f, 0.f, 0.f};
        }
        cur = nxt; cA = nA; cB = nB; ++ui;
        if constexpr (ALIGN_EPI) { if (wr == 1) PG8_BAR; }
    }
    PG8_WAIT_V(0);
    if constexpr (!ALIGN_EPI) { if (wr == 0) PG8_BAR; }
    PG8_BAR;
#undef PG8_SA
#undef PG8_SB
#undef PG8_STAGE
#undef PG8_LDA
#undef PG8_LDB
#undef PG8_MMA
#undef PG8_WAIT_V
#undef PG8_WAIT_L
#undef PG8_BAR
#undef PG8_SCHED
}
}


namespace att {
#define ATT_LAS __attribute__((address_space(3)))
typedef unsigned short bf16;
typedef short bf16x8 __attribute__((ext_vector_type(8)));
typedef short s16x4 __attribute__((ext_vector_type(4)));
typedef float f32x16 __attribute__((ext_vector_type(16)));
typedef float f32x2_t __attribute__((ext_vector_type(2)));
typedef __bf16 bf16x2_t __attribute__((ext_vector_type(2)));
typedef unsigned u32x4 __attribute__((ext_vector_type(4)));
typedef unsigned u32x2 __attribute__((ext_vector_type(2)));
constexpr int TILE_BYTES = 64 * 256, BUF_BYTES = 2 * TILE_BYTES, FLAG_OFF = 2 * BUF_BYTES, LDS_BYTES = FLAG_OFF + 256;
__device__ __forceinline__ unsigned cvtpk(float lo, float hi) { f32x2_t v = {lo, hi}; bf16x2_t b = __builtin_convertvector(v, bf16x2_t); return __builtin_bit_cast(unsigned, b); }
__device__ __forceinline__ int crow(int i, int h) { return (i & 3) + 8 * (i >> 2) + 4 * h; }
__device__ __forceinline__ unsigned off_b(unsigned row, unsigned ch) { return 256u * row + 16u * (ch ^ (((row & 3) << 2) | ((row >> 2) & 3))); }
__device__ __forceinline__ s16x4 trread(const ATT_LAS unsigned char* p) { return __builtin_bit_cast(s16x4, __builtin_amdgcn_ds_read_tr16_b64_v4i16((ATT_LAS s16x4*)p)); }
#define ATT_MFMA(a, b, c) __builtin_amdgcn_mfma_f32_32x32x16_bf16((a), (b), (c), 0, 0, 0)

struct AUnit { const bf16* Q; const bf16* K; const bf16* V; bf16* O; int pq, pk, po, b, qb; float sink2; };
__device__ __forceinline__ void attn_prefetch(const AUnit& u, bf16x8 (&qf)[8], u32x4& kr0, u32x4& kr1, u32x4& vr0, u32x4& vr1, int tid, int wid, int lane) {
    int ln_ = lane, td_ = tid; asm volatile("" : "+v"(ln_), "+v"(td_));
    const int r32 = ln_ & 31, h = ln_ >> 5, tq = 256 * u.qb + 32 * wid + r32; const size_t rowbase = (size_t)u.b * 4096;
    { const char* qb_ = (const char*)(u.Q + rowbase * u.pq); const unsigned qo = (unsigned)(tq * u.pq + 8 * h) * 2u;
#pragma unroll
      for (int s = 0; s < 8; ++s) qf[s] = *(const bf16x8*)(qb_ + qo + 32 * s); }
    const int lrow = td_ >> 4, lch = td_ & 15; const unsigned kvo = (unsigned)(lrow * u.pk + 8 * lch) * 2u;
    const size_t o = ((size_t)rowbase + (size_t)(64 * (4 * u.qb + 3))) * u.pk * 2; const char* k = (const char*)u.K + o; const char* v = (const char*)u.V + o;
    kr0 = *(const u32x4*)(k + kvo); kr1 = *(const u32x4*)(k + (size_t)64 * u.pk + kvo); vr0 = *(const u32x4*)(v + kvo); vr1 = *(const u32x4*)(v + (size_t)64 * u.pk + kvo);
}
template <int MODE, bool EARLY>
__device__ __forceinline__ void attn_unit(ATT_LAS unsigned char* lds, const AUnit& U, bool has_next, const AUnit& N, bf16x8 (&qf)[8], u32x4& kr0, u32x4& kr1, u32x4& vr0, u32x4& vr1, int tid, int wid, int lane) {
    const bf16* __restrict__ Kh = U.K; const bf16* __restrict__ Vh = U.V; bf16* __restrict__ Oh = U.O; const int pk = U.pk, po = U.po, b = U.b, qb = U.qb; const float sink2 = U.sink2;
    int ln_ = lane, td_ = tid; asm volatile("" : "+v"(ln_), "+v"(td_));
    const int r32 = ln_ & 31, h = ln_ >> 5;
    const int t0 = 256 * qb + 32 * wid, tq = t0 + r32;
    const size_t rowbase = (size_t)b * 4096;
    f32x16 oacc[4];
#pragma unroll
    for (int c = 0; c < 4; ++c)
#pragma unroll
        for (int i = 0; i < 16; ++i) oacc[c][i] = 0.f;
    float carry = 0.f, mrun = sink2, lrun = (h == 0) ? 1.f : 0.f;
    const int kt_hi = 4 * qb + 3, kt_lo = (MODE == 0) ? ((4 * qb - 2) > 0 ? (4 * qb - 2) : 0) : 0;
    const int lrow = td_ >> 4, lch = td_ & 15;
    const unsigned lw = off_b((unsigned)lrow, (unsigned)lch);
    const unsigned kvo = (unsigned)(lrow * pk + 8 * lch) * 2u;
    const char* kgb = (const char*)(Kh + rowbase * pk); const char* vgb = (const char*)(Vh + rowbase * pk);
    const unsigned xk = (unsigned)(((r32 & 3) << 2) | ((r32 >> 2) & 3));
    const int q4 = (ln_ & 15) >> 2, p4 = ln_ & 3, blk = (ln_ >> 4) & 1;
    unsigned vaddr[4][2];
#pragma unroll
    for (int c = 0; c < 4; ++c)
#pragma unroll
        for (int t = 0; t < 2; ++t) { const unsigned row = (unsigned)(8 * t + 4 * h + q4), x = (unsigned)((q4 << 2) | ((2 * t + h) & 3)), ch = (unsigned)(4 * c + 2 * blk + (p4 >> 1));
            vaddr[c][t] = 256u * row + 16u * (ch ^ x) + 8u * (unsigned)(p4 & 1); }
#define ATT_GLOAD(kt) do { const size_t _o = (size_t)(64 * (kt)) * pk * 2; const char* _k = kgb + _o; const char* _v = vgb + _o; kr0 = *(const u32x4*)(_k + kvo); kr1 = *(const u32x4*)(_k + (size_t)64 * pk + kvo); vr0 = *(const u32x4*)(_v + kvo); vr1 = *(const u32x4*)(_v + (size_t)64 * pk + kvo); } while (0)
#define ATT_LSTORE(bf) do { ATT_LAS unsigned char* _b = lds + (bf) * BUF_BYTES + lw; *(ATT_LAS u32x4*)_b = kr0; *(ATT_LAS u32x4*)(_b + 8192) = kr1; *(ATT_LAS u32x4*)(_b + TILE_BYTES) = vr0; *(ATT_LAS u32x4*)(_b + TILE_BYTES + 8192) = vr1; } while (0)
    int buf = 0;
    ATT_LSTORE(0); __syncthreads();
    for (int kt = kt_hi; kt >= kt_lo; --kt) {
        const bool more = kt > kt_lo;
        if (more) ATT_GLOAD(kt - 1);
        const int kbase = 64 * kt;
        bool relevant, masked;
        if (MODE == 1) { relevant = kbase <= t0 + 30; masked = kbase + 63 >= t0; }
        else { relevant = (kbase <= t0 + 31) && (kbase + 63 >= t0 - 127); masked = !((kbase + 63 <= t0) && (kbase >= t0 - 96)); }
        if (relevant) {
            const ATT_LAS unsigned char* Kb = lds + buf * BUF_BYTES; const ATT_LAS unsigned char* Vb = Kb + TILE_BYTES;
            f32x16 sacc[2];
#pragma unroll
            for (int kb = 0; kb < 2; ++kb) {
#pragma unroll
                for (int i = 0; i < 16; ++i) sacc[kb][i] = 0.f;
#pragma unroll
                for (int s = 0; s < 8; ++s) { const bf16x8 kf = *(const ATT_LAS bf16x8*)(Kb + kb * 8192 + 256 * r32 + 16 * (((unsigned)(2 * s + h)) ^ xk)); sacc[kb] = ATT_MFMA(kf, qf[s], sacc[kb]); }
            }
            bf16x8 pf[2][2];
            if (MODE == 1) {
#pragma unroll
                for (int kk = 0; kk < 2; ++kk) { const int kb = 1 - kk; const int sb0 = kbase + 32 * kb;
                    float sp[16], A[16];
#pragma unroll
                    for (int i = 0; i < 16; ++i) { const float z = sacc[kb][i]; const float e = __builtin_amdgcn_exp2f(-__builtin_fabsf(z)); sp[i] = fmaxf(z, 0.f) + __builtin_amdgcn_logf(1.f + e); }
                    if (masked) {
#pragma unroll
                        for (int i = 0; i < 16; ++i) sp[i] = (sb0 + crow(i, h) < tq) ? sp[i] : 0.f; }
                    float G[4], Gp[4], T[4];
#pragma unroll
                    for (int g = 0; g < 4; ++g) { G[g] = (sp[4 * g] + sp[4 * g + 1]) + (sp[4 * g + 2] + sp[4 * g + 3]); Gp[g] = __shfl_xor(G[g], 32); T[g] = G[g] + Gp[g]; }
                    float R[4]; R[3] = carry; R[2] = R[3] + T[3]; R[1] = R[2] + T[2]; R[0] = R[1] + T[1]; carry = R[0] + T[0];
#pragma unroll
                    for (int g = 0; g < 4; ++g) { const float S3 = R[g] + (h == 0 ? Gp[g] : 0.f), S2 = S3 + sp[4 * g + 3], S1 = S2 + sp[4 * g + 2], S0 = S1 + sp[4 * g + 1];
                        A[4 * g + 3] = __builtin_amdgcn_exp2f(sacc[kb][4 * g + 3] - sp[4 * g + 3] - S3); A[4 * g + 2] = __builtin_amdgcn_exp2f(sacc[kb][4 * g + 2] - sp[4 * g + 2] - S2);
                        A[4 * g + 1] = __builtin_amdgcn_exp2f(sacc[kb][4 * g + 1] - sp[4 * g + 1] - S1); A[4 * g + 0] = __builtin_amdgcn_exp2f(sacc[kb][4 * g + 0] - sp[4 * g + 0] - S0); }
                    if (masked) {
#pragma unroll
                        for (int i = 0; i < 16; ++i) A[i] = (sb0 + crow(i, h) < tq) ? A[i] : 0.f; }
#pragma unroll
                    for (int s2 = 0; s2 < 2; ++s2) { u32x4 w; w.x = cvtpk(A[8 * s2], A[8 * s2 + 1]); w.y = cvtpk(A[8 * s2 + 2], A[8 * s2 + 3]); w.z = cvtpk(A[8 * s2 + 4], A[8 * s2 + 5]); w.w = cvtpk(A[8 * s2 + 6], A[8 * s2 + 7]); pf[kb][s2] = __builtin_bit_cast(bf16x8, w); }
                }
            } else {
                if (masked) {
#pragma unroll
                    for (int kb = 0; kb < 2; ++kb)
#pragma unroll
                        for (int i = 0; i < 16; ++i) { const int key = kbase + 32 * kb + crow(i, h); const bool valid = (key <= tq) && (key + 127 >= tq); sacc[kb][i] = valid ? sacc[kb][i] : -__builtin_inff(); } }
                float tmax = sacc[0][0];
#pragma unroll
                for (int kb = 0; kb < 2; ++kb)
#pragma unroll
                    for (int i = 0; i < 16; ++i) tmax = fmaxf(tmax, sacc[kb][i]);
                tmax = fmaxf(tmax, __shfl_xor(tmax, 32));
                const float mnew = fmaxf(mrun, tmax), alpha = __builtin_amdgcn_exp2f(mrun - mnew); mrun = mnew;
                float psum = 0.f;
#pragma unroll
                for (int kb = 0; kb < 2; ++kb) { float P[16];
#pragma unroll
                    for (int i = 0; i < 16; ++i) { P[i] = __builtin_amdgcn_exp2f(sacc[kb][i] - mnew); psum += P[i]; }
#pragma unroll
                    for (int s2 = 0; s2 < 2; ++s2) { u32x4 w; w.x = cvtpk(P[8 * s2], P[8 * s2 + 1]); w.y = cvtpk(P[8 * s2 + 2], P[8 * s2 + 3]); w.z = cvtpk(P[8 * s2 + 4], P[8 * s2 + 5]); w.w = cvtpk(P[8 * s2 + 6], P[8 * s2 + 7]); pf[kb][s2] = __builtin_bit_cast(bf16x8, w); } }
                lrun = lrun * alpha + psum;
#pragma unroll
                for (int c = 0; c < 4; ++c)
#pragma unroll
                    for (int i = 0; i < 16; ++i) oacc[c][i] *= alpha;
            }
#pragma unroll
            for (int kb = 0; kb < 2; ++kb)
#pragma unroll
                for (int s2 = 0; s2 < 2; ++s2)
#pragma unroll
                    for (int c = 0; c < 4; ++c) { const s16x4 lo = trread(Vb + vaddr[c][0] + 4096 * (2 * kb + s2)), hi = trread(Vb + vaddr[c][1] + 4096 * (2 * kb + s2));
                        const bf16x8 vf = __builtin_shufflevector(lo, hi, 0, 1, 2, 3, 4, 5, 6, 7); oacc[c] = ATT_MFMA(vf, pf[kb][s2], oacc[c]); }
        }
        if (more) ATT_LSTORE(buf ^ 1);
        if (EARLY && MODE == 1) {
            volatile ATT_LAS unsigned* fl = (volatile ATT_LAS unsigned*)(lds + FLAG_OFF) + (kt & 1) * 8;
            const bool done = __all(carry > 160.f);
            if (lane == 0) fl[wid] = done ? 1u : 0u;
            __syncthreads();
            unsigned alld = 1u;
#pragma unroll
            for (int w = 0; w < 8; ++w) alld &= fl[w];
            buf ^= 1;
            if (alld) break;
        } else { __syncthreads(); buf ^= 1; }
    }
#undef ATT_GLOAD
#undef ATT_LSTORE
    if (MODE == 0) { const float lt = lrun + __shfl_xor(lrun, 32); const float inv = 1.f / lt;
#pragma unroll
        for (int c = 0; c < 4; ++c)
#pragma unroll
            for (int i = 0; i < 16; ++i) oacc[c][i] *= inv; }
    if (has_next) attn_prefetch(N, qf, kr0, kr1, vr0, vr1, tid, wid, lane);
    { int l2 = lane; asm volatile("" : "+v"(l2)); const int r2 = l2 & 31, h2 = l2 >> 5;
      char* ob = (char*)(Oh + rowbase * po); const unsigned oo = (unsigned)((t0 + r2) * po) * 2u + 16u * (unsigned)h2;
#pragma unroll
      for (int c = 0; c < 4; ++c)
#pragma unroll
        for (int gp = 0; gp < 2; ++gp) { const int g0 = 2 * gp;
            const unsigned x0 = cvtpk(oacc[c][4 * g0], oacc[c][4 * g0 + 1]), x1 = cvtpk(oacc[c][4 * g0 + 2], oacc[c][4 * g0 + 3]);
            const unsigned y0 = cvtpk(oacc[c][4 * g0 + 4], oacc[c][4 * g0 + 5]), y1 = cvtpk(oacc[c][4 * g0 + 6], oacc[c][4 * g0 + 7]);
            const auto s0 = __builtin_amdgcn_permlane32_swap(x0, y0, false, false); const auto s1 = __builtin_amdgcn_permlane32_swap(x1, y1, false, false);
            u32x4 w; w.x = s0[0]; w.y = s1[0]; w.z = s0[1]; w.w = s1[1];
            *(u32x4*)(ob + oo + 64 * c + 32 * gp) = w; } }
    if (EARLY && MODE == 1) __syncthreads();
}
}


constexpr int NWAVES = 8;
constexpr int BATCH = 4, SEQ = 4096, D = 4096, M = BATCH * SEQ, HD = 128, FF = 4 * D;
constexpr int D_IN = 9216, NG = 8192, N1 = D_IN + NG, NMOD = 6 * D;
constexpr float NORM_EPS = 1e-6f;
constexpr size_t MiB = 1u << 20;
constexpr size_t WS_CTL = 0, CTL_ZERO_BYTES = 49152;
constexpr size_t WS_CMX = 16384;
constexpr size_t WS_MOD = 1 * MiB, WS_COS = 2 * MiB, WS_SIN = 3 * MiB;
constexpr size_t WS_W1 = 4 * MiB;
constexpr size_t WS_WPS = 140 * MiB, WS_WPB = 156 * MiB;
constexpr size_t WS_WO = 172 * MiB;
constexpr size_t WS_WF1 = 204 * MiB;
constexpr size_t WS_WF2 = 332 * MiB;
constexpr size_t WS_A = 460 * MiB;
constexpr size_t WS_B = 588 * MiB;
constexpr size_t WS_C = 716 * MiB;
constexpr size_t WS_H8 = WS_C + 544 * MiB;
constexpr size_t WS_W8G = WS_H8 + 64 * MiB;
constexpr size_t WS_W8F = WS_W8G + 56 * MiB;
constexpr size_t WS_W8O = WS_W8F + 64 * MiB;
constexpr size_t WS_END = WS_W8O + 64 * MiB;
constexpr size_t WS_U8 = WS_W1;
constexpr size_t WS_SU = 320 * 1024, WS_SO = 384 * 1024, WS_CO = 32768;
constexpr int NB16 = 3072, NI8 = 14336;
constexpr size_t WS_SH = 64 * 1024, WS_S2 = 128 * 1024, WS_SG = 192 * 1024, WS_SF = 256 * 1024;
constexpr int CW_BAR = 0, CW_KS = 3520;
constexpr int RING_OFF = 0, RING_BYTES = 131072, LDSCTL_OFF = 139264, MISC_OFF = LDSCTL_OFF + 320, LDS_BYTES = 147456;

#define GAS __attribute__((address_space(1)))
#define LAS __attribute__((address_space(3)))
typedef unsigned short bf16;
typedef unsigned v4u __attribute__((ext_vector_type(4)));
typedef unsigned v2u __attribute__((ext_vector_type(2)));
typedef float f32x4 __attribute__((ext_vector_type(4)));
#define LDS_WAIT() asm volatile("s_waitcnt lgkmcnt(0)" ::: "memory")
__device__ __forceinline__ unsigned f2bf(float f) { unsigned u = __builtin_bit_cast(unsigned, f); return (u + 0x7fffu + ((u >> 16) & 1u)) >> 16; }
__device__ __forceinline__ unsigned pk2(float lo, float hi) { return f2bf(lo) | (f2bf(hi) << 16); }

#define XB_TMO      128
#define XB_XCNT(j)  (256  + 64 * (j))
#define XB_XSUB(j)  (1280 + 64 * (j))
#define XB_XGEN(j)  (2304 + 64 * (j))
#define XB_TOP      3328
#define XB_TOPGEN   3392
#define XCD_BAR_WORDS 3456
#define XB_SPIN_CAP (1u << 18)
__device__ __forceinline__ unsigned xb_ld(unsigned* p)              { return __hip_atomic_load(p, __ATOMIC_RELAXED, __HIP_MEMORY_SCOPE_AGENT); }
__device__ __forceinline__ unsigned xb_add(unsigned* p, unsigned v) { return __hip_atomic_fetch_add(p, v, __ATOMIC_RELAXED, __HIP_MEMORY_SCOPE_AGENT); }
__device__ __forceinline__ unsigned xb_xcc_id() { return (unsigned)__builtin_amdgcn_s_getreg((3 << 11) | 20) & 0xFu; }
#define XB_SPIN(cond, bar) do { unsigned _sp = 0; while (cond) { __builtin_amdgcn_s_sleep(1); \
    if ((++_sp & 255u) == 0u) { if (xb_ld(&(bar)[XB_TMO])) break; if (_sp > XB_SPIN_CAP) { atomicAdd(&(bar)[XB_TMO], 1u); break; } } } } while (0)
struct XcdBarrier { unsigned* bar; unsigned x; volatile LAS unsigned* st; };
__device__ __forceinline__ XcdBarrier xcd_barrier_post(unsigned* bar, volatile LAS unsigned* st) {
    XcdBarrier b; b.bar = bar; b.x = xb_xcc_id(); b.st = st;
    if (threadIdx.x == 0) (void)xb_add(&bar[XB_XCNT(b.x)], 1u);
    return b;
}
__device__ __forceinline__ void xcd_barrier_complete(unsigned* bar, unsigned x, unsigned& nloc, unsigned& nx) {
    const unsigned G = gridDim.x * gridDim.y * gridDim.z;
    unsigned sum, cnt, mine, sp = 0u;
    for (;;) {
        sum = 0u; cnt = 0u; mine = 0u;
#pragma unroll
        for (unsigned j = 0; j < 16; ++j) { const unsigned c = xb_ld(&bar[XB_XCNT(j)]); sum += c; cnt += (c > 0u) ? 1u : 0u; mine = (j == x) ? c : mine; }
        if (sum == G) break;
        __builtin_amdgcn_s_sleep(1);
        if ((++sp & 255u) == 0u) { if (xb_ld(&bar[XB_TMO])) break; if (sp > XB_SPIN_CAP) { atomicAdd(&bar[XB_TMO], 1u); break; } }
    }
    nloc = mine > 0u ? mine : 1u; nx = cnt > 0u ? cnt : 1u;
}
__device__ __forceinline__ void xcd_barrier(const XcdBarrier& b) {
    asm volatile("s_waitcnt vmcnt(0)" ::: "memory");
    __syncthreads();
    if (threadIdx.x == 0) {
        unsigned* bar = b.bar;
        __builtin_amdgcn_s_waitcnt(0);
        unsigned nloc = b.st[0], nx = b.st[1];
        if (nloc == 0u) { xcd_barrier_complete(bar, b.x, nloc, nx); b.st[0] = nloc; b.st[1] = nx; }
        const unsigned old = xb_add(&bar[XB_XSUB(b.x)], 1u);
        const unsigned gen = old / nloc;
        if (old + 1u == (gen + 1u) * nloc) {
            __builtin_amdgcn_fence(__ATOMIC_RELEASE, "agent");
            asm volatile("s_waitcnt vmcnt(0)" ::: "memory");
            const unsigned og = xb_add(&bar[XB_TOP], 1u);
            const unsigned tg = og / nx;
            if (og + 1u == (tg + 1u) * nx) xb_add(&bar[XB_TOPGEN], 1u);
            else XB_SPIN(xb_ld(&bar[XB_TOPGEN]) == tg, bar);
            __builtin_amdgcn_fence(__ATOMIC_ACQUIRE, "agent");
            xb_add(&bar[XB_XGEN(b.x)], 1u);
            asm volatile("s_waitcnt vmcnt(0)" ::: "memory");
        } else {
            XB_SPIN(xb_ld(&bar[XB_XGEN(b.x)]) == gen, bar);
            __builtin_amdgcn_fence(__ATOMIC_ACQUIRE, "agent");
            asm volatile("s_waitcnt vmcnt(0)" ::: "memory");
        }
    }
    __syncthreads();
}

struct Frame {
    LAS unsigned char* lds;
    int tid, lane, wave, vcu, G;
};
struct Args {
    const float *x, *c, *w_ada, *b_ada, *g_pre_mix, *g_post_mix, *g_pre_mlp, *g_post_mlp, *w_in, *sinks, *w_bg, *b_bg, *w_ps, *w_pb, *w_out, *w_f1, *w_f2;
    float* out; unsigned char* ws; int ph_lo, ph_hi;
};

#define WR_DPP(v, ctrl, rmask) __builtin_bit_cast(float, __builtin_amdgcn_update_dpp(0, __builtin_bit_cast(int, (v)), (ctrl), (rmask), 0xF, false))
__device__ __forceinline__ float wave_sum(float v) {
    v += WR_DPP(v, 0xB1, 0xF); v += WR_DPP(v, 0x4E, 0xF); v += WR_DPP(v, 0x141, 0xF); v += WR_DPP(v, 0x140, 0xF);
    v += WR_DPP(v, 0x142, 0xA); v += WR_DPP(v, 0x143, 0xC);
    return __builtin_bit_cast(float, __builtin_amdgcn_readlane(__builtin_bit_cast(int, v), 63));
}
__device__ const double ROPE_INVF[64] = {1.0, 0.8659643233600653, 0.7498942093324559, 0.6493816315762113, 0.5623413251903491, 0.4869675251658631, 0.4216965034285822, 0.3651741272548377, 0.31622776601683794, 0.27384196342643613, 0.23713737056616552, 0.2053525026457146, 0.1778279410038923, 0.1539926526059492, 0.1333521432163324, 0.11547819846894582, 0.1, 0.08659643233600653, 0.07498942093324558, 0.06493816315762113, 0.05623413251903491, 0.04869675251658631, 0.042169650342858224, 0.03651741272548377, 0.03162277660168379, 0.027384196342643614, 0.023713737056616554, 0.02053525026457146, 0.01778279410038923, 0.01539926526059492, 0.01333521432163324, 0.011547819846894581, 0.01, 0.008659643233600654, 0.007498942093324558, 0.006493816315762113, 0.005623413251903491, 0.004869675251658631, 0.004216965034285823, 0.003651741272548377, 0.0031622776601683794, 0.0027384196342643613, 0.0023713737056616554, 0.002053525026457146, 0.0017782794100389228, 0.001539926526059492, 0.001333521432163324, 0.0011547819846894581, 0.001, 0.0008659643233600654, 0.0007498942093324559, 0.0006493816315762113, 0.0005623413251903491, 0.0004869675251658631, 0.00042169650342858224, 0.0003651741272548377, 0.00031622776601683794, 0.0002738419634264361, 0.00023713737056616554, 0.0002053525026457146, 0.00017782794100389227, 0.0001539926526059492, 0.0001333521432163324, 0.00011547819846894582};

struct TDesc { const float* W; bf16* WT; int K, N, row_off, rope_lim, item, fp8; };
__device__ __forceinline__ void p0_tr_load(const TDesc& t, f32x4 (&v)[16], int lane) {
    const int nblk = t.N / 64, kb = t.item / nblk, nb = t.item % nblk, k0 = 64 * kb, n0 = 64 * nb;
    const int kq = lane >> 4, nn = 4 * (lane & 15);
#pragma unroll
    for (int i = 0; i < 16; ++i) v[i] = *(const f32x4*)(t.W + (size_t)(k0 + 4 * i + kq) * t.N + n0 + nn);
}
__device__ __forceinline__ void p0_tr_store(const TDesc& t, const f32x4 (&v)[16], LAS float* scr, int lane) {
    const int nblk = t.N / 64, kb = t.item / nblk, nb = t.item % nblk, k0 = 64 * kb, n0 = 64 * nb;
    const int kq = lane >> 4, nn = 4 * (lane & 15);
#pragma unroll
    for (int i = 0; i < 16; ++i) { LAS float* s = scr + (4 * i + kq) * 65 + nn; s[0] = v[i].x; s[1] = v[i].y; s[2] = v[i].z; s[3] = v[i].w; }
    LDS_WAIT(); asm volatile("" ::: "memory");
    const int c = lane & 7;
#pragma unroll
    for (int j = 0; j < 8; ++j) { const int n = (lane >> 3) + 8 * j; const LAS float* s = scr + (8 * c) * 65 + n;
        v4u o; o.x = pk2(s[0 * 65], s[1 * 65]); o.y = pk2(s[2 * 65], s[3 * 65]); o.z = pk2(s[4 * 65], s[5 * 65]); o.w = pk2(s[6 * 65], s[7 * 65]);
        int nd = n0 + n;
        if (t.rope_lim) {
            int sb_, sd_; bool rp_ = false;
            if (nd < 2048) { sb_ = 0; sd_ = 3072; rp_ = true; } else if (nd < 2560) { sb_ = 2048; sd_ = 0; rp_ = true; } else if (nd < 3072) { sb_ = 2560; sd_ = 512; }
            else if (nd < 5120) { sb_ = 3072; sd_ = 5120; } else if (nd < 7168) { sb_ = 5120; sd_ = 7168; } else { sb_ = 7168; sd_ = 1024; }
            int loc = nd - sb_; if (rp_) { const int d = loc & 127; loc = (loc & ~127) + (d < 64 ? 8 * (d >> 2) + (d & 3) : 8 * ((d - 64) >> 2) + 4 + (d & 3)); }
            nd = sd_ + loc; }
        *(v4u*)(t.WT + (size_t)(t.row_off + nd) * t.K + k0 + 8 * c) = o; }
    LDS_WAIT(); asm volatile("" ::: "memory");
}
__device__ __forceinline__ void p0_gemv(Frame& F, const Args& a, float* mod) {
    LAS f32x4* cact = (LAS f32x4*)F.lds;
    LAS float* red = (LAS float*)(F.lds + 65536);
    for (int k = F.tid; k < D; k += NWAVES * 64) { f32x4 v;
#pragma unroll
        for (int b = 0; b < 4; ++b) { const float xx = a.c[b * D + k]; v[b] = xx / (1.f + expf(-xx)); }
        cact[k] = v; }
    __syncthreads();
    const int half = F.lane >> 5, l32 = F.lane & 31; const bool act = l32 < 24;
    for (int cg = F.vcu; cg < NMOD / 96; cg += F.G) {
        f32x4 acc[4];
#pragma unroll
        for (int b = 0; b < 4; ++b) acc[b] = (f32x4){0.f, 0.f, 0.f, 0.f};
        const int kbase = 512 * F.wave + half;
        const float* wp = a.w_ada + (size_t)kbase * NMOD + 96 * cg + 4 * (act ? l32 : 0);
#define GV_LOAD(w, kk) _Pragma("unroll") for (int u = 0; u < 16; ++u) w[u] = *(const f32x4*)(wp + (size_t)(2 * ((kk) + u)) * NMOD)
#define GV_FMA(w, kk) _Pragma("unroll") for (int u = 0; u < 16; ++u) { const f32x4 ca = cact[kbase + 2 * ((kk) + u)]; _Pragma("unroll") for (int b = 0; b < 4; ++b) acc[b] += w[u] * ca[b]; }
        f32x4 wA[16], wB[16];
        GV_LOAD(wA, 0);
#pragma unroll 1
        for (int kk = 0; kk < 224; kk += 32) {
            GV_LOAD(wB, kk + 16); asm volatile("" ::: "memory");
            GV_FMA(wA, kk);
            GV_LOAD(wA, kk + 32); asm volatile("" ::: "memory");
            GV_FMA(wB, kk + 16);
        }
        GV_LOAD(wB, 240); asm volatile("" ::: "memory");
        GV_FMA(wA, 224);
        GV_FMA(wB, 240);
#undef GV_LOAD
#undef GV_FMA
#pragma unroll
        for (int b = 0; b < 4; ++b)
#pragma unroll
            for (int j = 0; j < 4; ++j) acc[b][j] += __shfl_xor(acc[b][j], 32);
        if (half == 0 && act) {
#pragma unroll
            for (int b = 0; b < 4; ++b) *(LAS f32x4*)(red + (F.wave * 4 + b) * 96 + 4 * l32) = acc[b]; }
        __syncthreads();
        if (F.tid < 384) { const int b = F.tid / 96, j = F.tid % 96; float s = 0.f;
#pragma unroll
            for (int w = 0; w < 8; ++w) s += red[(w * 4 + b) * 96 + j];
            mod[b * NMOD + 96 * cg + j] = s + a.b_ada[96 * cg + j]; }
        __syncthreads();
    }
}
__device__ __forceinline__ void p0_rope_table(Frame& F, float* cosT, float* sinT) {
    const double TWO_PI_HI = 6.283185307179586232, TWO_PI_LO = 2.4492935982947064e-16, INV_2PI = 0.15915494309189533577;
    for (int idx = F.vcu * (NWAVES * 64) + F.tid; idx < SEQ * 64; idx += F.G * NWAVES * 64) {
        const int pos = idx >> 6, i = idx & 63;
        const double ang = (double)pos * ROPE_INVF[i];
        const double n = __builtin_rint(ang * INV_2PI);
        double r = __builtin_fma(-n, TWO_PI_HI, ang); r = __builtin_fma(-n, TWO_PI_LO, r);
        const double r2 = r * r; double tc = 1.0, ts = r, sc = 1.0, ss = r;
#pragma unroll 1
        for (int k = 1; k <= 15; ++k) { tc *= -r2 / (double)((2 * k - 1) * (2 * k)); ts *= -r2 / (double)((2 * k) * (2 * k + 1)); sc += tc; ss += ts; }
        cosT[idx] = (float)sc; sinT[idx] = (float)ss;
    }
}

__device__ __forceinline__ f32x4 ld_bf4(const bf16* p) { const v2u w = *(const v2u*)p; return (f32x4){__uint_as_float(w.x << 16), __uint_as_float(w.x & 0xffff0000u), __uint_as_float(w.y << 16), __uint_as_float(w.y & 0xffff0000u)}; }
__device__ __forceinline__ void st_bf4(bf16* p, f32x4 v) { v2u w; w.x = pk2(v.x, v.y); w.y = pk2(v.z, v.w); *(v2u*)p = w; }
__device__ __forceinline__ float sumsq4(f32x4 v) { return (v.x * v.x + v.y * v.y) + (v.z * v.z + v.w * v.w); }

#define LAUNDER_PTR(p) asm volatile("" : "+s"(p))
__device__ __forceinline__ float wave_max(float v) {
    v = fmaxf(v, WR_DPP(v, 0xB1, 0xF)); v = fmaxf(v, WR_DPP(v, 0x4E, 0xF)); v = fmaxf(v, WR_DPP(v, 0x141, 0xF)); v = fmaxf(v, WR_DPP(v, 0x140, 0xF));
    v = fmaxf(v, WR_DPP(v, 0x142, 0xA)); v = fmaxf(v, WR_DPP(v, 0x143, 0xC));
    return __builtin_bit_cast(float, __builtin_amdgcn_readlane(__builtin_bit_cast(int, v), 63));
}
__device__ __forceinline__ float amax4(f32x4 v) { return fmaxf(fmaxf(__builtin_fabsf(v.x), __builtin_fabsf(v.y)), fmaxf(__builtin_fabsf(v.z), __builtin_fabsf(v.w))); }
__device__ __forceinline__ unsigned q4_i8(f32x4 v, float inv) {
    const int a = (int)__builtin_rintf(v.x * inv), b = (int)__builtin_rintf(v.y * inv), c = (int)__builtin_rintf(v.z * inv), d = (int)__builtin_rintf(v.w * inv);
    return (unsigned)(a & 255) | ((unsigned)(b & 255) << 8) | ((unsigned)(c & 255) << 16) | ((unsigned)d << 24); }
constexpr int SLAB_PITCH = 8192 + 16;
struct SDesc { const float* W; unsigned char* dst; float* sc; int N, c0, r0, rope; };
template <int H> __device__ __forceinline__ void slab_load(const SDesc& s, f32x4 (&va)[8], f32x4 (&vb)[8], int tid) {
    const float* p = s.W + (size_t)(2 * (tid >> 2) + 2048 * H) * s.N + s.c0 + 4 * (tid & 3);
#pragma unroll
    for (int i = 0; i < 8; ++i) { const float* q = p + (size_t)(256 * i) * s.N; va[i] = *(const f32x4*)q; vb[i] = *(const f32x4*)(q + s.N); }
}
template <int H> __device__ __forceinline__ void slab_stage(LAS unsigned char* lds, const f32x4 (&va)[8], const f32x4 (&vb)[8], int tid) {
    LAS unsigned char* t = lds + (4 * (tid & 3)) * SLAB_PITCH + 4 * (tid >> 2) + 4096 * H;
#pragma unroll
    for (int i = 0; i < 8; ++i)
#pragma unroll
        for (int j = 0; j < 4; ++j) *(LAS unsigned*)(t + j * SLAB_PITCH + 512 * i) = pg8::cvt_pk_bf16(va[i][j], vb[i][j]);
}
__device__ __forceinline__ void slab_quant(const SDesc& s, const LAS unsigned char* lds, int wave, int lane) {
#pragma unroll 1
    for (int rr = 0; rr < 2; ++rr) { const int n = 2 * wave + rr;
        v4u w[8]; float am = 0.f;
#pragma unroll
        for (int j = 0; j < 8; ++j) w[j] = *(const LAS v4u*)(lds + n * SLAB_PITCH + 16 * (lane + 64 * j));
#pragma unroll
        for (int j = 0; j < 8; ++j)
#pragma unroll
            for (int e = 0; e < 4; ++e) { const unsigned x = w[j][e]; am = fmaxf(am, fmaxf(__builtin_fabsf(__uint_as_float(x << 16)), __builtin_fabsf(__uint_as_float(x & 0xffff0000u)))); }
        am = wave_max(am); const float inv = am > 0.f ? 127.f / am : 0.f;
        int loc = s.c0 + n; if (s.rope) { const int d = loc & 127; loc = (loc & ~127) + (d < 64 ? 8 * (d >> 2) + (d & 3) : 8 * ((d - 64) >> 2) + 4 + (d & 3)); }
        const int drow = s.r0 + loc;
        if (lane == 0) s.sc[drow] = am * (1.f / 127.f);
#pragma unroll
        for (int j = 0; j < 8; ++j) { v2u o;
            o.x = q4_i8((f32x4){__uint_as_float(w[j].x << 16), __uint_as_float(w[j].x & 0xffff0000u), __uint_as_float(w[j].y << 16), __uint_as_float(w[j].y & 0xffff0000u)}, inv);
            o.y = q4_i8((f32x4){__uint_as_float(w[j].z << 16), __uint_as_float(w[j].z & 0xffff0000u), __uint_as_float(w[j].w << 16), __uint_as_float(w[j].w & 0xffff0000u)}, inv);
            *(v2u*)(s.dst + (size_t)drow * D + 8 * (lane + 64 * j)) = o; }
    }
}
__device__ __forceinline__ void ks_quant(const LAS unsigned char* lds, unsigned char* dst, float* sc, int* csum, int cs, int q, unsigned mb0, unsigned mb1, int wave, int lane) {
#pragma unroll 1
    for (int rr = 0; rr < 2; ++rr) { const int n = 2 * wave + rr, col = 16 * cs + n;
        v4u w[8];
#pragma unroll
        for (int j = 0; j < 8; ++j) w[j] = *(const LAS v4u*)(lds + n * SLAB_PITCH + 16 * (lane + 64 * j));
        const float am = __uint_as_float(rr ? mb1 : mb0), inv = am > 0.f ? 127.f / am : 0.f;
        if (lane == 0 && q == 0) sc[col] = am * (1.f / 127.f);
        float qs = 0.f;
#pragma unroll
        for (int j = 0; j < 8; ++j) { v2u o; float t[8];
#pragma unroll
            for (int e = 0; e < 4; ++e) { const unsigned x = w[j][e]; t[2 * e] = __builtin_rintf(__uint_as_float(x << 16) * inv); t[2 * e + 1] = __builtin_rintf(__uint_as_float(x & 0xffff0000u) * inv); }
#pragma unroll
            for (int e = 0; e < 8; ++e) qs += t[e];
            o.x = ((unsigned)(int)t[0] & 255u) | (((unsigned)(int)t[1] & 255u) << 8) | (((unsigned)(int)t[2] & 255u) << 16) | ((unsigned)(int)t[3] << 24);
            o.y = ((unsigned)(int)t[4] & 255u) | (((unsigned)(int)t[5] & 255u) << 8) | (((unsigned)(int)t[6] & 255u) << 16) | ((unsigned)(int)t[7] << 24);
            *(v2u*)(dst + (size_t)col * FF + 4096 * q + 8 * (lane + 64 * j)) = o; }
        qs = wave_sum(qs);
        if (lane == 0) atomicAdd(csum + col, (int)qs);
    }
}
__device__ __forceinline__ void p1_rows(Frame& F, const Args& a, const float* mod, bf16* H, unsigned char* H8, float* SH) {
    int lane_ = F.lane; asm volatile("" : "+v"(lane_)); const int LN = lane_;
    const int gw = F.vcu * NWAVES + F.wave, NGW = F.G * NWAVES;
    for (int r0 = gw * 8; r0 < M; r0 += NGW * 8) {
        const int b = r0 >> 12;
#pragma unroll 1
        for (int r = 0; r < 8; ++r) { const size_t row = (size_t)(r0 + r);
            const float* mb = mod + b * NMOD; const float* gp = a.g_pre_mix; LAUNDER_PTR(mb); LAUNDER_PTR(gp);
            f32x4 v[16]; float ss = 0.f;
#pragma unroll
            for (int j = 0; j < 16; ++j) { v[j] = *(const f32x4*)(a.x + row * D + 4 * LN + 256 * j); ss += sumsq4(v[j]); }
            const float rstd = 1.f / sqrtf(wave_sum(ss) * (1.f / D) + NORM_EPS);
            float am = 0.f;
#pragma unroll
            for (int j = 0; j < 16; ++j) { const int col = 4 * LN + 256 * j; if ((j & 3) == 0) asm volatile("" ::: "memory");
                const f32x4 av = *(const GAS f32x4*)(gp + col) * (*(const GAS f32x4*)(mb + D + col) + 1.f);
                v[j] = v[j] * rstd * av + *(const GAS f32x4*)(mb + col);
                st_bf4(H + row * D + col, v[j]); am = fmaxf(am, amax4(v[j])); }
            am = wave_max(am); const float inv = am > 0.f ? 127.f / am : 0.f;
            if (LN == 0) SH[row] = am * (1.f / 127.f);
#pragma unroll
            for (int j = 0; j < 16; ++j) *(unsigned*)(H8 + row * D + 4 * LN + 256 * j) = q4_i8(v[j], inv);
        }
    }
}
__device__ __forceinline__ void quant_rows(Frame& F, const bf16* __restrict__ src, unsigned char* __restrict__ dst, float* __restrict__ sc, int nrows) {
    int lane_ = F.lane; asm volatile("" : "+v"(lane_)); const int LN = lane_;
    const int gw = F.vcu * NWAVES + F.wave, NGW = F.G * NWAVES;
#pragma unroll 1
    for (int n = gw; n < nrows; n += NGW) {
        v4u w[8]; float am = 0.f;
#pragma unroll
        for (int j = 0; j < 8; ++j) w[j] = *(const v4u*)(src + (size_t)n * D + 8 * (LN + 64 * j));
#pragma unroll
        for (int j = 0; j < 8; ++j) {
#pragma unroll
            for (int e = 0; e < 4; ++e) { const unsigned x = w[j][e]; am = fmaxf(am, fmaxf(__builtin_fabsf(__uint_as_float(x << 16)), __builtin_fabsf(__uint_as_float(x & 0xffff0000u)))); } }
        am = wave_max(am); const float inv = am > 0.f ? 127.f / am : 0.f;
        if (LN == 0) sc[n] = am * (1.f / 127.f);
#pragma unroll
        for (int j = 0; j < 8; ++j) { v2u o;
            o.x = q4_i8((f32x4){__uint_as_float(w[j].x << 16), __uint_as_float(w[j].x & 0xffff0000u), __uint_as_float(w[j].y << 16), __uint_as_float(w[j].y & 0xffff0000u)}, inv);
            o.y = q4_i8((f32x4){__uint_as_float(w[j].z << 16), __uint_as_float(w[j].z & 0xffff0000u), __uint_as_float(w[j].w << 16), __uint_as_float(w[j].w & 0xffff0000u)}, inv);
            *(v2u*)(dst + (size_t)n * D + 8 * (LN + 64 * j)) = o; }
    }
}
__device__ __forceinline__ void quant_rows_long(Frame& F, const bf16* __restrict__ src, unsigned char* __restrict__ dst, float* __restrict__ sc, int* __restrict__ csum, int nrows) {
    int lane_ = F.lane; asm volatile("" : "+v"(lane_)); const int LN = lane_;
    const int gw = F.vcu * NWAVES + F.wave, NGW = F.G * NWAVES;
#pragma unroll 1
    for (int n = gw; n < nrows; n += NGW) {
        float am = 0.f;
#pragma unroll 1
        for (int c = 0; c < 4; ++c) { v4u w[8];
#pragma unroll
            for (int j = 0; j < 8; ++j) w[j] = *(const v4u*)(src + (size_t)n * FF + c * 4096 + 8 * (LN + 64 * j));
#pragma unroll
            for (int j = 0; j < 8; ++j)
#pragma unroll
                for (int e = 0; e < 4; ++e) { const unsigned x = w[j][e]; am = fmaxf(am, fmaxf(__builtin_fabsf(__uint_as_float(x << 16)), __builtin_fabsf(__uint_as_float(x & 0xffff0000u)))); } }
        am = wave_max(am); const float inv = am > 0.f ? 127.f / am : 0.f;
        float qs = 0.f;
#pragma unroll 1
        for (int c = 0; c < 4; ++c) { v4u w[8];
#pragma unroll
            for (int j = 0; j < 8; ++j) w[j] = *(const v4u*)(src + (size_t)n * FF + c * 4096 + 8 * (LN + 64 * j));
#pragma unroll
            for (int j = 0; j < 8; ++j) { v2u o; float t[8];
#pragma unroll
                for (int e = 0; e < 4; ++e) { const unsigned x = w[j][e]; t[2 * e] = __builtin_rintf(__uint_as_float(x << 16) * inv); t[2 * e + 1] = __builtin_rintf(__uint_as_float(x & 0xffff0000u) * inv); }
#pragma unroll
                for (int e = 0; e < 8; ++e) qs += t[e];
                o.x = ((unsigned)(int)t[0] & 255u) | (((unsigned)(int)t[1] & 255u) << 8) | (((unsigned)(int)t[2] & 255u) << 16) | ((unsigned)(int)t[3] << 24);
                o.y = ((unsigned)(int)t[4] & 255u) | (((unsigned)(int)t[5] & 255u) << 8) | (((unsigned)(int)t[6] & 255u) << 16) | ((unsigned)(int)t[7] << 24);
                *(v2u*)(dst + (size_t)n * FF + c * 4096 + 8 * (LN + 64 * j)) = o; } }
        qs = wave_sum(qs);
        if (LN == 0) { sc[n] = am * (1.f / 127.f); csum[n] = (int)qs; }
    }
}
__device__ __forceinline__ void requant_u(Frame& F, const bf16* __restrict__ U, unsigned char* __restrict__ U8, float* __restrict__ su) {
    int lane_ = F.lane; asm volatile("" : "+v"(lane_)); const int LN = lane_;
    LAS float* red = (LAS float*)(F.lds + RING_OFF);
    const int q = F.wave & 3, half = F.wave >> 2;
    const size_t coff = (size_t)q * 4096 + 8 * LN;
#define RQ_LOAD(w, r) _Pragma("unroll") for (int j = 0; j < 8; ++j) w[j] = *(const v4u*)(U + (size_t)(r) * FF + coff + 512 * j)
    v4u wc[8], wn[8];
    if (F.vcu < M / 2) RQ_LOAD(wc, 2 * F.vcu + half);
#pragma unroll 1
    for (int pi = F.vcu, p = 0; pi < M / 2; pi += F.G, ++p) { const int r = 2 * pi + half, rn = 2 * (pi + F.G < M / 2 ? pi + F.G : pi) + half;
        float am = 0.f;
#pragma unroll
        for (int j = 0; j < 8; ++j)
#pragma unroll
            for (int e = 0; e < 4; ++e) { const unsigned x = wc[j][e]; am = fmaxf(am, fmaxf(__uint_as_float(x << 16), __uint_as_float(x & 0xffff0000u))); }
        am = wave_max(am);
        if (LN == 0) red[(p & 1) * 8 + F.wave] = am;
        RQ_LOAD(wn, rn);
        __syncthreads();
        { const LAS float* rp = red + (p & 1) * 8 + 4 * half; am = fmaxf(fmaxf(rp[0], rp[1]), fmaxf(rp[2], rp[3])); }
        const float inv = am > 0.f ? 255.f / am : 0.f;
        if (LN == 0 && q == 0) su[r] = am * (1.f / 255.f);
#pragma unroll
        for (int j = 0; j < 8; ++j) { v2u o; int t[8];
#pragma unroll
            for (int e = 0; e < 4; ++e) { const unsigned x = wc[j][e]; t[2 * e] = (int)__builtin_rintf(__uint_as_float(x << 16) * inv) - 128; t[2 * e + 1] = (int)__builtin_rintf(__uint_as_float(x & 0xffff0000u) * inv) - 128; }
            o.x = ((unsigned)t[0] & 255u) | (((unsigned)t[1] & 255u) << 8) | (((unsigned)t[2] & 255u) << 16) | ((unsigned)t[3] << 24);
            o.y = ((unsigned)t[4] & 255u) | (((unsigned)t[5] & 255u) << 8) | (((unsigned)t[6] & 255u) << 16) | ((unsigned)t[7] << 24);
            *(v2u*)(U8 + (size_t)r * FF + coff + 512 * j) = o; }
#pragma unroll
        for (int j = 0; j < 8; ++j) wc[j] = wn[j];
    }
#undef RQ_LOAD
    __syncthreads();
}
__device__ __forceinline__ f32x4 unpk4(v2u w) { return (f32x4){__uint_as_float(w.x << 16), __uint_as_float(w.x & 0xffff0000u), __uint_as_float(w.y << 16), __uint_as_float(w.y & 0xffff0000u)}; }
__device__ __forceinline__ void p6_rows(Frame& F, const Args& a, const float* mod, const bf16* MX, unsigned char* H2, float* S2) {
    int lane_ = F.lane; asm volatile("" : "+v"(lane_)); const int LN = lane_;
    const int gw = F.vcu * NWAVES + F.wave, NGW = F.G * NWAVES;
    for (int r0 = gw * 8; r0 < M; r0 += NGW * 8) {
        const int b = r0 >> 12;
#pragma unroll 1
        for (int r = 0; r < 8; ++r) { const size_t row = (size_t)(r0 + r);
            const float* mb = mod + b * NMOD; LAUNDER_PTR(mb);
            v2u mp[16]; f32x4 xr[16]; float ss = 0.f;
#pragma unroll
            for (int j = 0; j < 16; ++j) mp[j] = *(const v2u*)(MX + row * D + 4 * LN + 256 * j);
#pragma unroll
            for (int j = 0; j < 16; ++j) xr[j] = *(const f32x4*)(a.x + row * D + 4 * LN + 256 * j);
#pragma unroll
            for (int j = 0; j < 16; ++j) ss += sumsq4(unpk4(mp[j]));
            const float rstd = 1.f / sqrtf(wave_sum(ss) * (1.f / D) + NORM_EPS);
            float ss2 = 0.f;
#pragma unroll
            for (int j = 0; j < 16; ++j) { const int col = 4 * LN + 256 * j; if ((j & 3) == 0) asm volatile("" ::: "memory");
                const f32x4 g1 = *(const GAS f32x4*)(mb + 2 * D + col) * *(const f32x4*)(a.g_post_mix + col);
                xr[j] = xr[j] + g1 * (unpk4(mp[j]) * rstd);
                *(f32x4*)(a.out + row * D + col) = xr[j]; ss2 += sumsq4(xr[j]); }
            const float rstd2 = 1.f / sqrtf(wave_sum(ss2) * (1.f / D) + NORM_EPS);
            float am = 0.f;
#pragma unroll
            for (int j = 0; j < 16; ++j) { const int col = 4 * LN + 256 * j; if ((j & 3) == 0) asm volatile("" ::: "memory");
                const f32x4 a2 = *(const f32x4*)(a.g_pre_mlp + col) * (*(const GAS f32x4*)(mb + 4 * D + col) + 1.f);
                xr[j] = xr[j] * rstd2 * a2 + *(const GAS f32x4*)(mb + 3 * D + col); am = fmaxf(am, amax4(xr[j])); }
            am = wave_max(am); const float inv = am > 0.f ? 127.f / am : 0.f;
            if (LN == 0) S2[row] = am * (1.f / 127.f);
#pragma unroll
            for (int j = 0; j < 16; ++j) *(unsigned*)(H2 + row * D + 4 * LN + 256 * j) = q4_i8(xr[j], inv);
        }
    }
}
__device__ __forceinline__ void p9_rows(Frame& F, const Args& a, const float* mod, const bf16* FB) {
    int lane_ = F.lane; asm volatile("" : "+v"(lane_)); const int LN = lane_;
    const int gw = F.vcu * NWAVES + F.wave, NGW = F.G * NWAVES;
    for (int r0 = gw * 8; r0 < M; r0 += NGW * 8) {
        const int b = r0 >> 12;
#pragma unroll 1
        for (int r = 0; r < 8; ++r) { const size_t row = (size_t)(r0 + r);
            const float* mb = mod + b * NMOD; LAUNDER_PTR(mb);
            v2u mp[16]; f32x4 xr[16]; float ss = 0.f;
#pragma unroll
            for (int j = 0; j < 16; ++j) mp[j] = *(const v2u*)(FB + row * D + 4 * LN + 256 * j);
#pragma unroll
            for (int j = 0; j < 16; ++j) xr[j] = *(const f32x4*)(a.out + row * D + 4 * LN + 256 * j);
#pragma unroll
            for (int j = 0; j < 16; ++j) ss += sumsq4(unpk4(mp[j]));
            const float rstd = 1.f / sqrtf(wave_sum(ss) * (1.f / D) + NORM_EPS);
#pragma unroll
            for (int j = 0; j < 16; ++j) { const int col = 4 * LN + 256 * j; if ((j & 3) == 0) asm volatile("" ::: "memory");
                const f32x4 g2 = *(const GAS f32x4*)(mb + 5 * D + col) * *(const f32x4*)(a.g_post_mlp + col);
                *(f32x4*)(a.out + row * D + col) = xr[j] + g2 * (unpk4(mp[j]) * rstd); }
        }
    }
}

#ifndef P7_NT
#define P7_NT false
#endif
#ifndef P8_WGM
#define P8_WGM 8
#endif
#ifndef SB_EARLY
#define SB_EARLY 1
#endif
__global__ void __launch_bounds__(NWAVES * 64, 2) fwd_kernel(Args args) {
    extern __shared__ __attribute__((aligned(16))) unsigned char lds[];
    Frame F;
    F.lds = (LAS unsigned char*)lds;
    F.tid = threadIdx.x; F.lane = F.tid & 63; F.wave = __builtin_amdgcn_readfirstlane(F.tid >> 6);
    F.G = gridDim.x; { const int bx = blockIdx.x; F.vcu = (F.G % 8 == 0) ? (bx % 8) * (F.G / 8) + bx / 8 : bx; }
    unsigned char* ws = args.ws;
    unsigned* ctl = (unsigned*)(ws + WS_CTL);
    float* mod = (float*)(ws + WS_MOD); float* cosT = (float*)(ws + WS_COS); float* sinT = (float*)(ws + WS_SIN);
    bf16* W1 = (bf16*)(ws + WS_W1); bf16* WPS = (bf16*)(ws + WS_WPS); bf16* WPB = (bf16*)(ws + WS_WPB); bf16* WO = (bf16*)(ws + WS_WO); bf16* WF1 = (bf16*)(ws + WS_WF1); bf16* WF2 = (bf16*)(ws + WS_WF2);
    bf16* BA = (bf16*)(ws + WS_A); bf16* BB = (bf16*)(ws + WS_B); unsigned char* H8 = ws + WS_H8; unsigned char* W8G = ws + WS_W8G; unsigned char* W8F = ws + WS_W8F;
    float* SH = (float*)(ws + WS_SH); float* S2 = (float*)(ws + WS_S2); float* SG = (float*)(ws + WS_SG); float* SF = (float*)(ws + WS_SF);
    unsigned char* W8O = ws + WS_W8O; unsigned char* U8 = ws + WS_U8; float* SU = (float*)(ws + WS_SU); float* SO = (float*)(ws + WS_SO); int* CO = (int*)(ws + WS_CO);
    bf16* QA = (bf16*)(ws + WS_C); bf16* KA = (bf16*)(ws + WS_C + 64 * MiB); bf16* VA = (bf16*)(ws + WS_C + 80 * MiB); bf16* QB = (bf16*)(ws + WS_C + 96 * MiB);
    bf16* KB = (bf16*)(ws + WS_C + 160 * MiB); bf16* VB = (bf16*)(ws + WS_C + 224 * MiB); bf16* GT = (bf16*)(ws + WS_C + 288 * MiB); bf16* UB = (bf16*)(ws + WS_C);
    bf16* ATT_SWA = BB; bf16* ATT_SB = BB + (size_t)M * 2048;
    for (int u = F.tid; u < (LDS_BYTES - LDSCTL_OFF) / 4; u += NWAVES * 64) ((LAS unsigned*)(F.lds + LDSCTL_OFF))[u] = 0u;
    __syncthreads();
    XcdBarrier bar = xcd_barrier_post(ctl + CW_BAR, (volatile LAS unsigned*)(F.lds + MISC_OFF) + 8);

    const int lo = args.ph_lo, hi = args.ph_hi;
#define IN(k) (lo <= (k) && (k) < hi)
#define BOTH(k) (IN(k) && IN((k) + 1))
    for (int rep_ = 0; rep_ < ((DUP_PHASE == 0) ? 2 : 1); ++rep_) if (IN(0)) {
        if (rep_) xcd_barrier(bar);
    {
        for (int sr_ = 0; sr_ < ((DUP_SUB == 3) ? 2 : 1); ++sr_) p0_gemv(F, args, mod);
        p0_rope_table(F, cosT, sinT);
        {
            constexpr int NSLAB = 1920;
#define SLAB_DECODE(sd, s_) do { int q_ = (s_); \
                if (q_ < 128) { sd = SDesc{args.w_in, W8G, SG, D_IN, 16 * q_, 0, 1}; break; } q_ -= 128; \
                if (q_ < 256) { sd = SDesc{args.w_in, W8G, SG, D_IN, 3072 + 16 * q_, 2048 - 3072, 0}; break; } q_ -= 256; \
                if (q_ < 512) { sd = SDesc{args.w_bg, W8G, SG, NG, 16 * q_, 6144, 0}; break; } q_ -= 512; \
                sd = SDesc{args.w_f1, W8F, SF, FF, 16 * q_, 0, 0}; } while (0)
            int stid = F.tid; asm volatile("" : "+v"(stid)); const int slane = stid & 63, swave = __builtin_amdgcn_readfirstlane(stid >> 6);
            const int nmine = 7 + ((F.G == 256 && F.vcu >= 128) ? 1 : 0);
            auto slab_of = [&](int i) -> int { if (F.G == 256) return i < 7 ? 256 * i + F.vcu : 1792 + F.vcu - 128; return F.vcu + i * F.G; };
            auto have = [&](int i) -> bool { if (F.G == 256) return i < nmine; return F.vcu + i * F.G < NSLAB; };
            for (int sr_ = 0; sr_ < ((DUP_SUB == 1) ? 2 : 1); ++sr_) if (have(0)) {
                SDesc sc_; SLAB_DECODE(sc_, slab_of(0)); f32x4 va0[8], vb0[8], va1[8], vb1[8]; slab_load<0>(sc_, va0, vb0, stid); slab_load<1>(sc_, va1, vb1, stid);
                for (int i = 0;; ++i) {
                    const bool more = have(i + 1); SDesc sn_ = sc_; if (more) SLAB_DECODE(sn_, slab_of(i + 1));
                    slab_stage<0>(F.lds, va0, vb0, stid); asm volatile("" ::: "memory");
                    if (more) slab_load<0>(sn_, va0, vb0, stid);
                    asm volatile("" ::: "memory");
                    slab_stage<1>(F.lds, va1, vb1, stid); asm volatile("" ::: "memory");
                    if (more) slab_load<1>(sn_, va1, vb1, stid);
                    __syncthreads();
                    slab_quant(sc_, F.lds, swave, slane);
                    __syncthreads();
                    if (!more) break;
                    sc_ = sn_;
                }
            }
#undef SLAB_DECODE
            {
                unsigned* kcnt = ctl + CW_KS; unsigned* cmx = (unsigned*)(ws + WS_CMX);
                int it = F.vcu;
                if (it < 1024) {
                    SDesc sc_{args.w_f2 + (size_t)(it & 3) * 4096 * D, W8O, SO, D, 16 * (it >> 2), 0, 0};
                    f32x4 va0[8], vb0[8], va1[8], vb1[8]; slab_load<0>(sc_, va0, vb0, stid); slab_load<1>(sc_, va1, vb1, stid);
                    for (;;) {
                        const int cs = it >> 2, q = it & 3, itn = it + F.G; const bool more = itn < 1024;
                        slab_stage<0>(F.lds, va0, vb0, stid); slab_stage<1>(F.lds, va1, vb1, stid);
                        __syncthreads();
                        {
                            unsigned got = 0u;
#pragma unroll 1
                            for (int rr = 0; rr < 2; ++rr) { const int n = 2 * swave + rr; float am = 0.f;
#pragma unroll
                                for (int j = 0; j < 8; ++j) { const v4u w = *(const LAS v4u*)(F.lds + n * SLAB_PITCH + 16 * (slane + 64 * j));
#pragma unroll
                                    for (int e = 0; e < 4; ++e) { const unsigned x = w[e]; am = fmaxf(am, fmaxf(__builtin_fabsf(__uint_as_float(x << 16)), __builtin_fabsf(__uint_as_float(x & 0xffff0000u)))); } }
                                am = wave_max(am);
                                if (slane == 0) got |= atomicMax(cmx + 16 * cs + n, __float_as_uint(am)); }
                            asm volatile("" :: "v"(got));
                        }
                        asm volatile("s_waitcnt vmcnt(0)" ::: "memory");
                        __syncthreads();
                        if (stid == 0) { (void)xb_add(&kcnt[cs], 1u); XB_SPIN(xb_ld(&kcnt[cs]) < 4u, ctl + CW_BAR); }
                        __syncthreads();
                        const unsigned mb0 = xb_ld(cmx + 16 * cs + 2 * swave), mb1 = xb_ld(cmx + 16 * cs + 2 * swave + 1);
                        SDesc sn_ = sc_;
                        if (more) { sn_ = SDesc{args.w_f2 + (size_t)(itn & 3) * 4096 * D, W8O, SO, D, 16 * (itn >> 2), 0, 0}; slab_load<0>(sn_, va0, vb0, stid); slab_load<1>(sn_, va1, vb1, stid); }
                        ks_quant(F.lds, W8O, SO, CO, cs, q, mb0, mb1, swave, slane);
                        __syncthreads();
                        if (!more) break;
                        it = itn; sc_ = sn_;
                    }
                }
            }
        }
        LAS float* scr = (LAS float*)(F.lds + F.wave * 16640);
        const int gw = F.vcu * NWAVES + F.wave, NGW = F.G * NWAVES;
        constexpr int I_IN = (D / 64) * 48, I_PS = (2048 / 64) * (D / 64), I_O = (D / 64) * (D / 64);
        constexpr int NITEMS = I_IN + 2 * I_PS + I_O;
#define P0_DECODE(t, it) do { int r_ = (it); \
            if (r_ < I_IN) { const int kb_ = r_ / 48, nb_ = r_ % 48; t = TDesc{args.w_in, W1, D, D_IN, 0, 2560, kb_ * (D_IN / 64) + (nb_ < 16 ? 32 + nb_ : 96 + nb_), 0}; break; } r_ -= I_IN; \
            if (r_ < I_PS) { t = TDesc{args.w_ps, WPS, 2048, D, 0, 0, r_, 0}; break; } r_ -= I_PS; \
            if (r_ < I_PS) { t = TDesc{args.w_pb, WPB, 2048, D, 0, 0, r_, 0}; break; } r_ -= I_PS; \
            t = TDesc{args.w_out, WO, D, D, 0, 0, r_, 0}; } while (0)
        for (int sr_ = 0; sr_ < ((DUP_SUB == 2) ? 2 : 1); ++sr_) { int it = gw;
        if (it < NITEMS) {
            TDesc tc; P0_DECODE(tc, it); f32x4 vc[16]; p0_tr_load(tc, vc, F.lane);
            for (;;) {
                const int itn = it + NGW; const bool more = itn < NITEMS;
                TDesc tn = tc; f32x4 vn[16];
                if (more) { P0_DECODE(tn, itn); p0_tr_load(tn, vn, F.lane); }
                p0_tr_store(tc, vc, scr, F.lane);
                if (!more) break;
                tc = tn; it = itn;
#pragma unroll
                for (int i = 0; i < 16; ++i) vc[i] = vn[i];
            }
        } }
#undef P0_DECODE
    }
        if (BOTH(0)) xcd_barrier(bar);
    }
    for (int rep_ = 0; rep_ < ((DUP_PHASE == 1) ? 2 : 1); ++rep_) if (IN(1)) {
        if (rep_) xcd_barrier(bar);
    p1_rows(F, args, mod, BA, H8, SH);
        if (BOTH(1)) xcd_barrier(bar);
    }
    for (int rep_ = 0; rep_ < ((DUP_PHASE == 2) ? 2 : 1); ++rep_) if (IN(2)) {
        if (rep_) xcd_barrier(bar);
    {
        { pg8::Gemm g{BA, W1, BA, W1, M, NB16, D}; pg8::StaticOrder S; S.init(M, NB16, F.G, (int)blockIdx.x);
          pg8::EpiProj E{KA, VA, VB, cosT, sinT};
          pg8::gemm_phase<pg8::EpiProj, pg8::StaticOrder, true, true>(F.lds + RING_OFF, g, S, E); }
        { pg8::Gemm g{(const bf16*)H8, (const bf16*)W8G, (const bf16*)H8, (const bf16*)W8G, M, NI8, D / 2}; pg8::StaticOrder S; S.init(M, NI8, F.G, (int)blockIdx.x);
          pg8::EpiI8Proj E{QA, QB, KB, GT, cosT, sinT, args.b_bg, SH, SG, 0.12751743f  };
          pg8::gemm_phase<pg8::EpiI8Proj, pg8::StaticOrder, true, true, true>(F.lds + RING_OFF, g, S, E); }
    }
        if (BOTH(2)) xcd_barrier(bar);
    }
    for (int rep_ = 0; rep_ < ((DUP_PHASE == 3) ? 2 : 1); ++rep_) if (IN(3)) {
        if (rep_) xcd_barrier(bar);
    {
        int atid = F.tid; asm volatile("" : "+v"(atid)); const int alane = atid & 63, awave = __builtin_amdgcn_readfirstlane(atid >> 6);
        const int nq = (F.vcu < 256) ? (256 - F.vcu + F.G - 1) / F.G : 0, ntot = 8 * nq;
#define P3_GET(idx, u, md) do { const int i_ = (idx); if (i_ < 4 * nq) { const int quad = F.vcu + (i_ >> 2) * F.G, j = i_ & 3, bh = quad >> 2, r = quad & 3, hh = bh & 15; \
            (u) = att::AUnit{QB + hh * HD, KB + hh * HD, VB + hh * HD, ATT_SB + hh * HD, 2048, 2048, 2048, bh >> 4, (j == 0) ? 15 - r : (j == 1) ? 11 - r : (j == 2) ? 4 + r : r, 0.f}; (md) = 1; } \
          else { const int i2_ = i_ - 4 * nq, quad = F.vcu + (i2_ >> 2) * F.G, id = quad * 4 + (i2_ & 3), hq = (id >> 4) & 15; \
            (u) = att::AUnit{QA + hq * HD, KA + (hq >> 2) * HD, VA + (hq >> 2) * HD, ATT_SWA + hq * HD, 2048, 512, 2048, id >> 8, id & 15, args.sinks[hq] * 1.44269504089f}; (md) = 0; } } while (0)
        if (ntot > 0) {
            att::AUnit cur, nxt; int mcur = 0, mnxt = 0; att::bf16x8 qf[8]; att::u32x4 kr0, kr1, vr0, vr1;
            P3_GET(0, cur, mcur); nxt = cur; att::attn_prefetch(cur, qf, kr0, kr1, vr0, vr1, atid, awave, alane);
            for (int idx = 0; idx < ntot; ++idx) { const bool hn = idx + 1 < ntot; if (hn) P3_GET(idx + 1, nxt, mnxt);
                if (mcur) att::attn_unit<1, (SB_EARLY != 0)>(F.lds, cur, hn, nxt, qf, kr0, kr1, vr0, vr1, atid, awave, alane);
                else      att::attn_unit<0, false>(F.lds, cur, hn, nxt, qf, kr0, kr1, vr0, vr1, atid, awave, alane);
                cur = nxt; mcur = mnxt; }
        }
#undef P3_GET
    }
        if (BOTH(3)) xcd_barrier(bar);
    }
    for (int rep_ = 0; rep_ < ((DUP_PHASE == 4) ? 2 : 1); ++rep_) if (IN(4)) {
        if (rep_) xcd_barrier(bar);
    {
        pg8::Gemm g{ATT_SWA, WPS, ATT_SB, WPB, M, D, 2048}; pg8::PairOrder S; S.S.init(M, D, F.G, (int)blockIdx.x);
        pg8::EpiMix E{BA, (const unsigned char*)GT};
        pg8::gemm_phase<pg8::EpiMix, pg8::PairOrder, true, true>(F.lds + RING_OFF, g, S, E);
    }
        if (BOTH(4)) xcd_barrier(bar);
    }
    for (int rep_ = 0; rep_ < ((DUP_PHASE == 5) ? 2 : 1); ++rep_) if (IN(5)) {
        if (rep_) xcd_barrier(bar);
    {
        pg8::Gemm g{BA, WO, BA, WO, M, D, D}; pg8::StaticOrder S; S.init(M, D, F.G, (int)blockIdx.x);
        pg8::EpiSimple<0> E{BB, D};
        pg8::gemm_phase<pg8::EpiSimple<0>, pg8::StaticOrder, true, true>(F.lds + RING_OFF, g, S, E);
    }
        if (BOTH(5)) xcd_barrier(bar);
    }
    for (int rep_ = 0; rep_ < ((DUP_PHASE == 6) ? 2 : 1); ++rep_) if (IN(6)) {
        if (rep_) xcd_barrier(bar);
    p6_rows(F, args, mod, BB, (unsigned char*)BA, S2);
        if (BOTH(6)) xcd_barrier(bar);
    }
#ifndef IDLE_US
#define IDLE_US 0
#endif
    if (IDLE_US > 0 && IN(7)) { const unsigned long long t0_ = __builtin_amdgcn_s_memrealtime(); while (__builtin_amdgcn_s_memrealtime() - t0_ < (unsigned long long)IDLE_US * 100ull) __builtin_amdgcn_s_sleep(127); }
    for (int rep_ = 0; rep_ < ((DUP_PHASE == 7) ? 2 : 1); ++rep_) if (IN(7)) {
        if (rep_) xcd_barrier(bar);
    {
        pg8::Gemm g{BA, (const bf16*)W8F, BA, (const bf16*)W8F, M, FF, D / 2}; pg8::StaticOrder S; S.init(M, FF, F.G, (int)blockIdx.x);
        pg8::EpiRelu2I8 E{UB, FF, S2, SF};
        pg8::gemm_phase<pg8::EpiRelu2I8, pg8::StaticOrder, true, true, true>(F.lds + RING_OFF, g, S, E);
    }
        if (BOTH(7)) xcd_barrier(bar);
    }
    for (int rep_ = 0; rep_ < ((DUP_PHASE == 8) ? 2 : 1); ++rep_) if (IN(8)) {
        if (rep_) xcd_barrier(bar);
    {
        requant_u(F, UB, U8, SU);
        xcd_barrier(bar);
        pg8::Gemm g{(const bf16*)U8, (const bf16*)W8O, (const bf16*)U8, (const bf16*)W8O, M, D, FF / 2}; pg8::StaticOrder S; S.init(M, D, F.G, (int)blockIdx.x, P8_WGM);
        pg8::EpiFfOutI8 E{BB, D, SU, SO, CO};
        pg8::gemm_phase<pg8::EpiFfOutI8, pg8::StaticOrder, true, true, true>(F.lds + RING_OFF, g, S, E);
    }
        if (BOTH(8)) xcd_barrier(bar);
    }
    for (int rep_ = 0; rep_ < ((DUP_PHASE == 9) ? 2 : 1); ++rep_) if (IN(9)) {
        if (rep_) xcd_barrier(bar);
    p9_rows(F, args, mod, BB);
        if (BOTH(9)) xcd_barrier(bar);
    }
#undef IN
#undef BOTH
}

extern "C" void kernel_launch(void* const* d_in, const int* in_sizes, int n_in, void* d_out, int out_size, void* d_ws, size_t ws_size, hipStream_t stream) {
    static int grid = 0;
    if (grid == 0) {
        if (n_in != 17 || in_sizes[0] != M * D || out_size != M * D || ws_size < WS_END) { fprintf(stderr, "kernel_launch: unexpected shapes / workspace (n_in %d, in0 %d, out %d, ws %zu, need %zu); nothing launched\n", n_in, n_in > 0 ? in_sizes[0] : -1, out_size, ws_size, (size_t)WS_END); grid = -1; return; }
        int dev = 0, cus = 0, per_cu = 0;
        if (hipGetDevice(&dev) != hipSuccess || hipDeviceGetAttribute(&cus, hipDeviceAttributeMultiprocessorCount, dev) != hipSuccess) { fprintf(stderr, "kernel_launch: device query failed\n"); grid = -1; return; }
        if (hipFuncSetAttribute((const void*)fwd_kernel, hipFuncAttributeMaxDynamicSharedMemorySize, LDS_BYTES) != hipSuccess) { fprintf(stderr, "kernel_launch: hipFuncSetAttribute failed\n"); grid = -1; return; }
        if (hipOccupancyMaxActiveBlocksPerMultiprocessor(&per_cu, (const void*)fwd_kernel, NWAVES * 64, LDS_BYTES) != hipSuccess || per_cu < 1) { fprintf(stderr, "kernel_launch: occupancy query says %d blocks per CU\n", per_cu); }
        (void)hipGetLastError();
        grid = cus & ~7;
    }
    if (grid < 0) return;
    if (hipMemsetAsync((char*)d_ws + WS_CTL, 0, CTL_ZERO_BYTES, stream) != hipSuccess) { fprintf(stderr, "kernel_launch: memset failed\n"); return; }
    Args a{};
    a.x = (const float*)d_in[0]; a.c = (const float*)d_in[1]; a.w_ada = (const float*)d_in[2]; a.b_ada = (const float*)d_in[3]; a.g_pre_mix = (const float*)d_in[4]; a.g_post_mix = (const float*)d_in[5];
    a.g_pre_mlp = (const float*)d_in[6]; a.g_post_mlp = (const float*)d_in[7]; a.w_in = (const float*)d_in[8]; a.sinks = (const float*)d_in[9]; a.w_bg = (const float*)d_in[10]; a.b_bg = (const float*)d_in[11];
    a.w_ps = (const float*)d_in[12]; a.w_pb = (const float*)d_in[13]; a.w_out = (const float*)d_in[14]; a.w_f1 = (const float*)d_in[15]; a.w_f2 = (const float*)d_in[16];
    a.out = (float*)d_out; a.ws = (unsigned char*)d_ws;
#ifndef MK_N_LAUNCHES
#define MK_N_LAUNCHES 1
#ifndef DUP_PHASE
#define DUP_PHASE -1
#endif
#endif
    constexpr int NPH = 10;
    for (int li = 0; li < MK_N_LAUNCHES; ++li) {
        a.ph_lo = (MK_N_LAUNCHES == 1) ? 0 : li; a.ph_hi = (MK_N_LAUNCHES == 1) ? NPH : li + 1;
        hipLaunchKernelGGL(fwd_kernel, dim3(grid), dim3(NWAVES * 64), LDS_BYTES, stream, a);
        const hipError_t le = hipPeekAtLastError();
        if (le != hipSuccess) { fprintf(stderr, "kernel_launch: launch failed: %s\n", hipGetErrorName(le)); break; }
    }
}
```

```cpp
#include <hip/hip_runtime.h>
#include <cstdio>
#include <cstdint>
#define MK_N_LAUNCHES 1
#ifndef DUP_PHASE
#define DUP_PHASE -1
#endif
#ifndef DUP_SUB
#define DUP_SUB 0
#endif

namespace pg8 {
#define PG8_LAS __attribute__((address_space(3)))
typedef unsigned short bf16_t;
typedef short bf16x8 __attribute__((ext_vector_type(8)));
typedef float f32x4 __attribute__((ext_vector_type(4)));
typedef unsigned u32x4 __attribute__((ext_vector_type(4)));
typedef int v4i_t __attribute__((ext_vector_type(4)));
typedef unsigned u32x2 __attribute__((ext_vector_type(2)));
constexpr int BM = 256, BK = 64, HALF = 128, HTB = HALF * BK * 2  , STAGE_BYTES = 8 * HTB, NXCD = 8, WGM = 8;

__host__ __device__ __forceinline__ int lds_byte(int r, int c) { const int st = (r >> 4) * 2 + (c >> 5), rr = r & 15, cc = c & 31, ob = rr * 64 + cc * 2; return st * 1024 + (ob ^ (((ob >> 9) & 1) << 5)); }
__host__ __device__ __forceinline__ void stage_rc(int b, int& R, int& C) { const int st = b / 1024, sb = b % 1024, swz = sb ^ (((sb >> 9) & 1) << 5); R = (st >> 1) * 16 + swz / 64; C = (st & 1) * 32 + (swz % 64) / 2; }
__host__ __device__ __forceinline__ int perm32(int rho) { const int n = rho >> 4, i = rho & 15; return 8 * (i >> 2) + 4 * n + (i & 3); }

struct Unit { int pm, pn, kind; };
struct Gemm { const bf16_t* A0; const bf16_t* B0; const bf16_t* A1; const bf16_t* B1; int M, N, K; };

struct StaticOrder {
    int nM, nN, nwg, G, c, wgm;
    __host__ __device__ void init(int M, int N, int G_, int c_, int wgm_ = WGM) { nM = M / BM; nN = N / BM; nwg = nM * nN; G = G_; c = c_; wgm = wgm_; }
    __host__ __device__ bool next(int i, Unit& u) const {
        const long L = (long)i * G + c; if (L >= nwg) return false;
        int wgid = (int)L; { const int q = nwg / NXCD, r = nwg % NXCD, xcd = wgid % NXCD, off = wgid / NXCD; wgid = (xcd < r ? xcd * (q + 1) : r * (q + 1) + (xcd - r) * q) + off; }
        const int nig = wgm * nN, gid = wgid / nig, fm = gid * wgm, gsz = (nM - fm) < wgm ? (nM - fm) : wgm;
        u.pm = fm + ((wgid % nig) % gsz); u.pn = (wgid % nig) / gsz; u.kind = 0; return true;
    }
    __device__ __forceinline__ void a_ready(const Unit&) const {}
    __device__ __forceinline__ void done(const Unit&) const {}
};
struct PairOrder {
    StaticOrder S;
    __host__ __device__ bool next(int i, Unit& u) const { if (!S.next(i >> 1, u)) return false; u.kind = i & 1; return true; }
    __device__ __forceinline__ void a_ready(const Unit&) const {}
    __device__ __forceinline__ void done(const Unit&) const {}
};

typedef float f32x2_t __attribute__((ext_vector_type(2))); typedef __bf16 bf16x2_t __attribute__((ext_vector_type(2)));
__device__ __forceinline__ unsigned cvt_pk_bf16(float lo, float hi) { f32x2_t v = {lo, hi}; bf16x2_t b = __builtin_convertvector(v, bf16x2_t); return __builtin_bit_cast(unsigned, b); }
__device__ __forceinline__ f32x4 bf_lo4(unsigned a, unsigned b) { return (f32x4){__uint_as_float(a << 16), __uint_as_float(a & 0xffff0000u), __uint_as_float(b << 16), __uint_as_float(b & 0xffff0000u)}; }
__device__ __forceinline__ u32x4 pack8(f32x4 v0, f32x4 v1) { u32x4 w; w.x = cvt_pk_bf16(v0[0], v0[1]); w.y = cvt_pk_bf16(v0[2], v0[3]); w.z = cvt_pk_bf16(v1[0], v1[1]); w.w = cvt_pk_bf16(v1[2], v1[3]); return w; }

template <int ACT  , bool NT = false> struct EpiSimple {
    static constexpr bool PERM = true, AFTER_DRAIN = false, CHAIN = false;
    __device__ __forceinline__ bool keep_acc(const Unit&) const { return false; }
    bf16_t* O; int ldc;
    __device__ __forceinline__ void operator()(const f32x4 (&acc)[2][2][4][2], const Unit& u, int wr, int wc, int fr, int fq) const {
        const int row0 = u.pm * BM + wr * 64 + fr, col0 = u.pn * BM + wc * 32 + 8 * fq;
#pragma unroll
        for (int ai = 0; ai < 2; ++ai)
#pragma unroll
            for (int m = 0; m < 4; ++m) { bf16_t* rowp = O + (size_t)(row0 + ai * HALF + m * 16) * ldc + col0;
#pragma unroll
                for (int bj = 0; bj < 2; ++bj) { f32x4 v0 = acc[ai][bj][m][0], v1 = acc[ai][bj][m][1];
                    if (ACT == 1) {
#pragma unroll
                        for (int j = 0; j < 4; ++j) { const float a = fmaxf(v0[j], 0.f), b = fmaxf(v1[j], 0.f); v0[j] = a * a; v1[j] = b * b; } }
                    if (NT) __builtin_nontemporal_store(pack8(v0, v1), (u32x4*)(rowp + bj * HALF)); else *(u32x4*)(rowp + bj * HALF) = pack8(v0, v1); } }
    }
};

struct EpiProj {
    static constexpr bool PERM = true, AFTER_DRAIN = false, CHAIN = false;
    __device__ __forceinline__ bool keep_acc(const Unit&) const { return false; }
    bf16_t *KA, *VA, *VB; const float* cosT; const float* sinT;
    __device__ __forceinline__ void operator()(const f32x4 (&acc)[2][2][4][2], const Unit& u, int wr, int wc, int fr, int fq) const {
        const int pn = u.pn, row0 = u.pm * BM + wr * 64 + fr, cl = wc * 32 + 8 * fq;
        bf16_t* base; int ld, colt; bool rope = false;
        if (pn < 2)       { base = KA; ld = 512;  colt = pn * 256; rope = true; }
        else if (pn < 4)  { base = VA; ld = 512;  colt = (pn - 2) * 256; }
        else              { base = VB; ld = 2048; colt = (pn - 4) * 256; }
        if (rope) {
#pragma unroll
            for (int ai = 0; ai < 2; ++ai)
#pragma unroll
                for (int m = 0; m < 4; ++m) { const int row = row0 + ai * HALF + m * 16; const int pos = row & 4095;
                    const f32x4 c4 = *(const f32x4*)(cosT + pos * 64 + (cl >> 1)), s4 = *(const f32x4*)(sinT + pos * 64 + (cl >> 1));
                    bf16_t* rowp = base + (size_t)row * ld + colt + cl;
#pragma unroll
                    for (int bj = 0; bj < 2; ++bj) { const f32x4 x1 = acc[ai][bj][m][0], x2 = acc[ai][bj][m][1];
                        *(u32x4*)(rowp + bj * HALF) = pack8(x1 * c4 - x2 * s4, x2 * c4 + x1 * s4); } }
        } else {
#pragma unroll
            for (int ai = 0; ai < 2; ++ai)
#pragma unroll
                for (int m = 0; m < 4; ++m) { bf16_t* rowp = base + (size_t)(row0 + ai * HALF + m * 16) * ld + colt + cl;
#pragma unroll
                    for (int bj = 0; bj < 2; ++bj) *(u32x4*)(rowp + bj * HALF) = pack8(acc[ai][bj][m][0], acc[ai][bj][m][1]); }
        }
    }
};

__device__ __forceinline__ f32x4 i2f4(f32x4 a) { const v4i_t i = __builtin_bit_cast(v4i_t, a); return (f32x4){(float)i[0], (float)i[1], (float)i[2], (float)i[3]}; }
struct EpiI8Proj {
    static constexpr bool PERM = true, AFTER_DRAIN = false, CHAIN = false;
    __device__ __forceinline__ bool keep_acc(const Unit&) const { return false; }
    bf16_t *QA, *QB, *KB, *GT; const float* cosT; const float* sinT; const float* gbias; const float* sa; const float* sb; float qscale;
    __device__ __forceinline__ void operator()(const f32x4 (&acc)[2][2][4][2], const Unit& u, int wr, int wc, int fr, int fq) const {
        const int pn = u.pn, row0 = u.pm * BM + wr * 64 + fr, cl = wc * 32 + 8 * fq;
        f32x4 sv[2][2];
#pragma unroll
        for (int bj = 0; bj < 2; ++bj)
#pragma unroll
            for (int n = 0; n < 2; ++n) sv[bj][n] = *(const f32x4*)(sb + pn * 256 + bj * HALF + cl + 4 * n);
        if (pn < 8) {
            const int colt = pn * 256;
#pragma unroll
            for (int ai = 0; ai < 2; ++ai)
#pragma unroll
                for (int m = 0; m < 4; ++m) { const int row = row0 + ai * HALF + m * 16; const int pos = row & 4095; const float sr = sa[row] * qscale;
                    const f32x4 c4 = *(const f32x4*)(cosT + pos * 64 + (cl >> 1)), s4 = *(const f32x4*)(sinT + pos * 64 + (cl >> 1));
                    bf16_t* rowp = QA + (size_t)row * 2048 + colt + cl;
#pragma unroll
                    for (int bj = 0; bj < 2; ++bj) { const f32x4 x1 = i2f4(acc[ai][bj][m][0]) * (sv[bj][0] * sr), x2 = i2f4(acc[ai][bj][m][1]) * (sv[bj][1] * sr);
                        *(u32x4*)(rowp + bj * HALF) = pack8(x1 * c4 - x2 * s4, x2 * c4 + x1 * s4); } }
        } else if (pn < 24) {
            const bool isq = pn < 16; const int colt = (isq ? pn - 8 : pn - 16) * 256; bf16_t* basep = isq ? QB : KB; const float qs = isq ? qscale : 1.f;
#pragma unroll
            for (int ai = 0; ai < 2; ++ai)
#pragma unroll
                for (int m = 0; m < 4; ++m) { const int row = row0 + ai * HALF + m * 16; const float sr = sa[row] * qs; bf16_t* rowp = basep + (size_t)row * 2048 + colt + cl;
#pragma unroll
                    for (int bj = 0; bj < 2; ++bj) *(u32x4*)(rowp + bj * HALF) = pack8(i2f4(acc[ai][bj][m][0]) * (sv[bj][0] * sr), i2f4(acc[ai][bj][m][1]) * (sv[bj][1] * sr)); }
        } else {
            const int colt = (pn - 24) * 256;
            f32x4 bv[2][2];
#pragma unroll
            for (int bj = 0; bj < 2; ++bj)
#pragma unroll
                for (int n = 0; n < 2; ++n) { bv[bj][n] = *(const f32x4*)(gbias + colt + bj * HALF + cl + 4 * n) * -1.44269504089f; sv[bj][n] = sv[bj][n] * -1.44269504089f; }
            unsigned char* tp = (unsigned char*)GT + ((size_t)(u.pm * 32 + (pn - 24)) << 16) + (wr * 4 + wc) * 8192 + (fr + 16 * fq) * 16;
#pragma unroll
            for (int ai = 0; ai < 2; ++ai)
#pragma unroll
                for (int m = 0; m < 4; ++m) { const int row = row0 + ai * HALF + m * 16; const float sr = sa[row]; u32x4 w4;
#pragma unroll
                    for (int bj = 0; bj < 2; ++bj) { f32x4 v0 = i2f4(acc[ai][bj][m][0]) * (sv[bj][0] * sr) + bv[bj][0], v1 = i2f4(acc[ai][bj][m][1]) * (sv[bj][1] * sr) + bv[bj][1];
#pragma unroll
                        for (int j = 0; j < 4; ++j) { v0[j] = __builtin_rintf(255.f * __builtin_amdgcn_rcpf(1.f + __builtin_amdgcn_exp2f(v0[j]))); v1[j] = __builtin_rintf(255.f * __builtin_amdgcn_rcpf(1.f + __builtin_amdgcn_exp2f(v1[j]))); }
                        const unsigned wx = (unsigned)v0[0] | ((unsigned)v0[1] << 8) | ((unsigned)v0[2] << 16) | ((unsigned)v0[3] << 24), wy = (unsigned)v1[0] | ((unsigned)v1[1] << 8) | ((unsigned)v1[2] << 16) | ((unsigned)v1[3] << 24);
                        if (bj == 0) { w4.x = wx; w4.y = wy; } else { w4.z = wx; w4.w = wy; } }
                    *(u32x4*)(tp + (ai * 4 + m) * 1024) = w4; }
        }
    }
};
struct EpiFfOutI8 {
    static constexpr bool PERM = true, AFTER_DRAIN = false, CHAIN = false;
    __device__ __forceinline__ bool keep_acc(const Unit&) const { return false; }
    bf16_t* O; int ldc; const float* sa; const float* sb; const int* cs;
    __device__ __forceinline__ void operator()(const f32x4 (&acc)[2][2][4][2], const Unit& u, int wr, int wc, int fr, int fq) const {
        const int row0 = u.pm * BM + wr * 64 + fr, col0 = u.pn * BM + wc * 32 + 8 * fq;
        f32x4 sv[2][2]; v4i_t cv[2][2];
#pragma unroll
        for (int bj = 0; bj < 2; ++bj)
#pragma unroll
            for (int n = 0; n < 2; ++n) { sv[bj][n] = *(const f32x4*)(sb + col0 + bj * HALF + 4 * n); cv[bj][n] = *(const v4i_t*)(cs + col0 + bj * HALF + 4 * n) * 128; }
#pragma unroll
        for (int ai = 0; ai < 2; ++ai)
#pragma unroll
            for (int m = 0; m < 4; ++m) { const int row = row0 + ai * HALF + m * 16; const float sr = sa[row]; bf16_t* rowp = O + (size_t)row * ldc + col0;
#pragma unroll
                for (int bj = 0; bj < 2; ++bj) { const v4i_t i0 = __builtin_bit_cast(v4i_t, acc[ai][bj][m][0]) + cv[bj][0], i1 = __builtin_bit_cast(v4i_t, acc[ai][bj][m][1]) + cv[bj][1];
                    *(u32x4*)(rowp + bj * HALF) = pack8((f32x4){(float)i0[0], (float)i0[1], (float)i0[2], (float)i0[3]} * (sv[bj][0] * sr), (f32x4){(float)i1[0], (float)i1[1], (float)i1[2], (float)i1[3]} * (sv[bj][1] * sr)); } }
    }
};
struct EpiRelu2I8 {
    static constexpr bool PERM = true, AFTER_DRAIN = false, CHAIN = false;
    __device__ __forceinline__ bool keep_acc(const Unit&) const { return false; }
    bf16_t* O; int ldc; const float* sa; const float* sb;
    __device__ __forceinline__ void operator()(const f32x4 (&acc)[2][2][4][2], const Unit& u, int wr, int wc, int fr, int fq) const {
        const int row0 = u.pm * BM + wr * 64 + fr, col0 = u.pn * BM + wc * 32 + 8 * fq;
        f32x4 sv[2][2];
#pragma unroll
        for (int bj = 0; bj < 2; ++bj)
#pragma unroll
            for (int n = 0; n < 2; ++n) sv[bj][n] = *(const f32x4*)(sb + col0 + bj * HALF + 4 * n);
#pragma unroll
        for (int ai = 0; ai < 2; ++ai)
#pragma unroll
            for (int m = 0; m < 4; ++m) { const int row = row0 + ai * HALF + m * 16; const float sr = sa[row]; bf16_t* rowp = O + (size_t)row * ldc + col0;
#pragma unroll
                for (int bj = 0; bj < 2; ++bj) { f32x4 v0 = i2f4(acc[ai][bj][m][0]) * (sv[bj][0] * sr), v1 = i2f4(acc[ai][bj][m][1]) * (sv[bj][1] * sr);
#pragma unroll
                    for (int j = 0; j < 4; ++j) { const float p = fmaxf(v0[j], 0.f), q = fmaxf(v1[j], 0.f); v0[j] = p * p; v1[j] = q * q; }
                    *(u32x4*)(rowp + bj * HALF) = pack8(v0, v1); } }
    }
};

struct EpiMix {
    static constexpr bool PERM = true, AFTER_DRAIN = false, CHAIN = true;
    bf16_t* O; const unsigned char* G;
    static __device__ __forceinline__ f32x4 ub4(unsigned w) { return (f32x4){(float)(w & 255u), (float)((w >> 8) & 255u), (float)((w >> 16) & 255u), (float)(w >> 24)}; }
    __device__ __forceinline__ void operator()(f32x4 (&acc)[2][2][4][2], const Unit& u, int wr, int wc, int fr, int fq) const {
        const int row0 = u.pm * BM + wr * 64 + fr, col0 = u.pn * BM + wc * 32 + 8 * fq; const int kind = u.kind;
        const unsigned char* ta = G + ((size_t)(u.pm * 32 + u.pn) << 16) + (wr * 4 + wc) * 8192 + (fr + 16 * fq) * 16;
        const unsigned char* tb = ta + ((size_t)16 << 16);
        if (kind == 0) {
#pragma unroll
            for (int ai = 0; ai < 2; ++ai)
#pragma unroll
                for (int m = 0; m < 4; ++m) { const u32x4 ga4 = *(const u32x4*)(ta + (ai * 4 + m) * 1024), gb4 = *(const u32x4*)(tb + (ai * 4 + m) * 1024);
#pragma unroll
                    for (int bj = 0; bj < 2; ++bj) { const unsigned gax = bj ? ga4.z : ga4.x, gay = bj ? ga4.w : ga4.y, gbx = bj ? gb4.z : gb4.x, gby = bj ? gb4.w : gb4.y;
                        f32x4 b0 = ub4(gbx), b1 = ub4(gby);
#pragma unroll
                        for (int j = 0; j < 4; ++j) { b0[j] = __builtin_amdgcn_rcpf(fmaxf(b0[j], 2.3191e-10f)); b1[j] = __builtin_amdgcn_rcpf(fmaxf(b1[j], 2.3191e-10f)); }
                        acc[ai][bj][m][0] *= ub4(gax) * b0; acc[ai][bj][m][1] *= ub4(gay) * b1; } }
        } else {
#pragma unroll
            for (int ai = 0; ai < 2; ++ai)
#pragma unroll
                for (int m = 0; m < 4; ++m) { const size_t row = (size_t)(row0 + ai * HALF + m * 16); const u32x4 gb4 = *(const u32x4*)(tb + (ai * 4 + m) * 1024);
#pragma unroll
                    for (int bj = 0; bj < 2; ++bj) { const int col = col0 + bj * HALF; const unsigned gbx = bj ? gb4.z : gb4.x, gby = bj ? gb4.w : gb4.y;
                        f32x4 b0 = ub4(gbx), b1 = ub4(gby);
#pragma unroll
                        for (int j = 0; j < 4; ++j) { b0[j] = fmaxf(b0[j], 2.3191e-10f) * (1.f / 255.f); b1[j] = fmaxf(b1[j], 2.3191e-10f) * (1.f / 255.f); }
                        *(u32x4*)(O + row * 4096 + col) = pack8(acc[ai][bj][m][0] * b0, acc[ai][bj][m][1] * b1); } }
        }
    }
    __device__ __forceinline__ bool keep_acc(const Unit& u) const { return u.kind == 0; }
};

template <class Epi, class Sched, bool ALIGN_EPI = false, bool SP2 = false, bool I8 = false>
__device__ __forceinline__ void gemm_phase(PG8_LAS unsigned char* lds, const Gemm g, const Sched& S, const Epi& E) {
    int tid_ = threadIdx.x; asm volatile("" : "+v"(tid_));
    const int tid = tid_, wid = __builtin_amdgcn_readfirstlane(tid >> 6), lane = tid & 63, wr = wid >> 2, wc = wid & 3, fr = lane & 15, fq = lane >> 4;
    const int K = g.K, nt = K / BK;
    unsigned voffA[2], voffB[2];
#pragma unroll
    for (int i = 0; i < 2; ++i) { int R, C; stage_rc(tid * 16 + i * 8192, R, C); const int Rb = Epi::PERM ? ((R & ~31) + perm32(R & 31)) : R;
        voffA[i] = (unsigned)(R * K + C) * 2u; voffB[i] = (unsigned)(Rb * K + C) * 2u; }
    const size_t kstep = (size_t)(BK * 2);
    const size_t hstep = (size_t)HALF * K * 2;
    const size_t tstep = 2 * hstep;
    const unsigned ldsw = (unsigned)wid * 1024u;
    const int aoff = lds_byte(wr * 64 + fr, fq * 8), boff = lds_byte(wc * 32 + fr, fq * 8);
#define PG8_SA(b, h) (((b) * 2 + (h)) * HTB)
#define PG8_SB(b, h) ((4 + (b) * 2 + (h)) * HTB)
#define PG8_STAGE(bufoff, gbase, voff) do { _Pragma("unroll") for (int _i = 0; _i < 2; ++_i) \
        __builtin_amdgcn_global_load_lds((const unsigned*)((const char*)(gbase) + (voff)[_i]), (PG8_LAS unsigned*)(lds + (bufoff) + ldsw + _i * 8192), 16, 0, 0); } while (0)
#define PG8_LDA(dst, b, h) do { _Pragma("unroll") for (int m = 0; m < 4; ++m) _Pragma("unroll") for (int k = 0; k < 2; ++k) dst[m][k] = *(const PG8_LAS bf16x8*)(lds + PG8_SA(b, h) + aoff + m * 2048 + k * 1024); } while (0)
#define PG8_LDB(dst, b, h) do { _Pragma("unroll") for (int n = 0; n < 2; ++n) _Pragma("unroll") for (int k = 0; k < 2; ++k) dst[n][k] = *(const PG8_LAS bf16x8*)(lds + PG8_SB(b, h) + boff + n * 2048 + k * 1024); } while (0)
#define PG8_MMA(ai, bj, At, Bt) do { __builtin_amdgcn_s_setprio(1); _Pragma("unroll") for (int m = 0; m < 4; ++m) _Pragma("unroll") for (int n = 0; n < 2; ++n) _Pragma("unroll") for (int k = 0; k < 2; ++k) { \
        if constexpr (I8) acc[ai][bj][m][n] = __builtin_bit_cast(f32x4, __builtin_amdgcn_mfma_i32_16x16x64_i8(__builtin_bit_cast(v4i_t, Bt[n][k]), __builtin_bit_cast(v4i_t, At[m][k]), __builtin_bit_cast(v4i_t, acc[ai][bj][m][n]), 0, 0, 0)); \
        else acc[ai][bj][m][n] = __builtin_amdgcn_mfma_f32_16x16x32_bf16(Bt[n][k], At[m][k], acc[ai][bj][m][n], 0, 0, 0); } __builtin_amdgcn_s_setprio(0); } while (0)
#define PG8_WAIT_V(n) asm volatile("s_waitcnt vmcnt(" #n ")" ::: "memory")
#define PG8_WAIT_L(n) asm volatile("s_waitcnt lgkmcnt(" #n ")" ::: "memory")
#define PG8_BAR __builtin_amdgcn_s_barrier()
#define PG8_SCHED __builtin_amdgcn_sched_barrier(0)
    Unit cur, nxt; int ui = 0;
    if (!S.next(0, cur)) return;
    f32x4 acc[2][2][4][2];
#pragma unroll
    for (int a = 0; a < 2; ++a)
#pragma unroll
        for (int b = 0; b < 2; ++b)
#pragma unroll
            for (int m = 0; m < 4; ++m)
#pragma unroll
                for (int n = 0; n < 2; ++n) acc[a][b][m][n] = (f32x4){0.f, 0.f, 0.f, 0.f};
    bf16x8 At[4][2], B0[2][2], B1[2][2];
    const char* cA = (const char*)(cur.kind ? g.A1 : g.A0) + (size_t)cur.pm * tstep; const char* cB = (const char*)(cur.kind ? g.B1 : g.B0) + (size_t)cur.pn * tstep;
    S.a_ready(cur);
    if constexpr (SP2) {
        PG8_STAGE(PG8_SB(0, 0), cB, voffB); PG8_STAGE(PG8_SB(0, 1), cB + hstep, voffB); PG8_STAGE(PG8_SA(0, 0), cA, voffA); PG8_STAGE(PG8_SA(0, 1), cA + hstep, voffA);
        if (wr == 1) PG8_BAR;
        PG8_WAIT_V(2); PG8_BAR;
        PG8_STAGE(PG8_SB(1, 0), cB + kstep, voffB); PG8_STAGE(PG8_SA(1, 0), cA + kstep, voffA); PG8_STAGE(PG8_SB(1, 1), cB + hstep + kstep, voffB);
        PG8_WAIT_V(6); PG8_BAR;
    } else {
        PG8_STAGE(PG8_SB(0, 0), cB, voffB); PG8_STAGE(PG8_SA(0, 0), cA, voffA); PG8_STAGE(PG8_SB(0, 1), cB + hstep, voffB); PG8_STAGE(PG8_SA(0, 1), cA + hstep, voffA);
        if (wr == 1) PG8_BAR;
        PG8_WAIT_V(4); PG8_BAR;
        PG8_STAGE(PG8_SB(1, 0), cB + kstep, voffB); PG8_STAGE(PG8_SA(1, 0), cA + kstep, voffA); PG8_STAGE(PG8_SB(1, 1), cB + hstep + kstep, voffB);
        PG8_WAIT_V(6); PG8_BAR;
    }
    for (;;) {
        const bool has_next = S.next(ui + 1, nxt);
        const char* nA = has_next ? (const char*)(nxt.kind ? g.A1 : g.A0) + (size_t)nxt.pm * tstep : cA; const char* nB = has_next ? (const char*)(nxt.kind ? g.B1 : g.B0) + (size_t)nxt.pn * tstep : cB;
        for (int t = 0; t < nt; t += 2) {
            const bool last = (t == nt - 2);
            const char* a1 = cA + (size_t)(t + 1) * kstep;
            const char* a2 = last ? nA : cA + (size_t)(t + 2) * kstep; const char* b2 = last ? nB : cB + (size_t)(t + 2) * kstep;
            const char* a3 = a2 + kstep; const char* b3 = b2 + kstep;
            if (last && has_next) S.a_ready(nxt);
            if constexpr (SP2) {
            PG8_LDB(B0, 0, 0); PG8_LDB(B1, 0, 1); PG8_SCHED; PG8_LDA(At, 0, 0); PG8_STAGE(PG8_SA(1, 1), a1 + hstep, voffA);
            PG8_WAIT_V(8); PG8_WAIT_L(0); PG8_BAR; PG8_MMA(0, 0, At, B0); PG8_MMA(0, 1, At, B1); PG8_BAR; PG8_SCHED;
            PG8_LDA(At, 0, 1); PG8_STAGE(PG8_SB(0, 0), b2, voffB); PG8_STAGE(PG8_SB(0, 1), b2 + hstep, voffB); PG8_STAGE(PG8_SA(0, 0), a2, voffA);
            PG8_WAIT_V(8); PG8_WAIT_L(0); PG8_BAR; PG8_MMA(1, 0, At, B0); PG8_MMA(1, 1, At, B1); PG8_BAR; PG8_SCHED;
            PG8_LDB(B0, 1, 0); PG8_LDB(B1, 1, 1); PG8_SCHED; PG8_LDA(At, 1, 0); PG8_STAGE(PG8_SA(0, 1), a2 + hstep, voffA);
            PG8_WAIT_V(8); PG8_WAIT_L(0); PG8_BAR; PG8_MMA(0, 0, At, B0); PG8_MMA(0, 1, At, B1); PG8_BAR; PG8_SCHED;
            PG8_LDA(At, 1, 1); PG8_STAGE(PG8_SB(1, 0), b3, voffB); PG8_STAGE(PG8_SB(1, 1), b3 + hstep, voffB); PG8_STAGE(PG8_SA(1, 0), a3, voffA);
            PG8_WAIT_V(8); PG8_WAIT_L(0); PG8_BAR; PG8_MMA(1, 0, At, B0); PG8_MMA(1, 1, At, B1); PG8_BAR; PG8_SCHED;
            } else {
            PG8_LDB(B0, 0, 0); PG8_SCHED; PG8_LDA(At, 0, 0); PG8_STAGE(PG8_SA(1, 1), a1 + hstep, voffA);
            PG8_WAIT_L(8); PG8_BAR; PG8_WAIT_L(0); PG8_MMA(0, 0, At, B0); PG8_BAR; PG8_SCHED;
            PG8_LDB(B1, 0, 1); PG8_STAGE(PG8_SB(0, 0), b2, voffB);
            PG8_BAR; PG8_WAIT_L(0); PG8_MMA(0, 1, At, B1); PG8_BAR;
            PG8_LDA(At, 0, 1); PG8_STAGE(PG8_SA(0, 0), a2, voffA);
            PG8_BAR; PG8_WAIT_L(0); PG8_MMA(1, 0, At, B0); PG8_BAR; PG8_SCHED;
            PG8_STAGE(PG8_SB(0, 1), b2 + hstep, voffB);
            PG8_WAIT_V(6); PG8_BAR; PG8_MMA(1, 1, At, B1); PG8_BAR;
            PG8_LDB(B0, 1, 0); PG8_SCHED; PG8_LDA(At, 1, 0); PG8_STAGE(PG8_SA(0, 1), a2 + hstep, voffA);
            PG8_WAIT_L(8); PG8_BAR; PG8_WAIT_L(0); PG8_MMA(0, 0, At, B0); PG8_BAR; PG8_SCHED;
            PG8_LDB(B1, 1, 1); PG8_STAGE(PG8_SB(1, 0), b3, voffB);
            PG8_BAR; PG8_WAIT_L(0); PG8_MMA(0, 1, At, B1); PG8_BAR;
            PG8_LDA(At, 1, 1); PG8_STAGE(PG8_SA(1, 0), a3, voffA);
            PG8_BAR; PG8_WAIT_L(0); PG8_MMA(1, 0, At, B0); PG8_BAR; PG8_SCHED;
            PG8_STAGE(PG8_SB(1, 1), b3 + hstep, voffB);
            PG8_WAIT_V(6); PG8_BAR; PG8_MMA(1, 1, At, B1); PG8_BAR;
            }
        }
        if constexpr (ALIGN_EPI) { if (wr == 0) PG8_BAR; }
        if constexpr (!Epi::AFTER_DRAIN) { E(acc, cur, wr, wc, fr, fq); S.done(cur); }
        if (!has_next) break;
        if (!(Epi::CHAIN && E.keep_acc(cur))) {
#pragma unroll
        for (int a = 0; a < 2; ++a)
#pragma unroll
            for (int b = 0; b < 2; ++b)
#pragma unroll
                for (int m = 0; m < 4; ++m)
#pragma unroll
                    for (int n = 0; n < 2; ++n) acc[a][b][m][n] = (f32x4){0.f, 0.f, 0.f, 0.f};
        }
        cur = nxt; cA = nA; cB = nB; ++ui;
        if constexpr (ALIGN_EPI) { if (wr == 1) PG8_BAR; }
    }
    PG8_WAIT_V(0);
    if constexpr (!ALIGN_EPI) { if (wr == 0) PG8_BAR; }
    PG8_BAR;
#undef PG8_SA
#undef PG8_SB
#undef PG8_STAGE
#undef PG8_LDA
#undef PG8_LDB
#undef PG8_MMA
#undef PG8_WAIT_V
#undef PG8_WAIT_L
#undef PG8_BAR
#undef PG8_SCHED
}
}


namespace att {
#define ATT_LAS __attribute__((address_space(3)))
typedef unsigned short bf16;
typedef short bf16x8 __attribute__((ext_vector_type(8)));
typedef short s16x4 __attribute__((ext_vector_type(4)));
typedef float f32x16 __attribute__((ext_vector_type(16)));
typedef float f32x2_t __attribute__((ext_vector_type(2)));
typedef __bf16 bf16x2_t __attribute__((ext_vector_type(2)));
typedef unsigned u32x4 __attribute__((ext_vector_type(4)));
typedef unsigned u32x2 __attribute__((ext_vector_type(2)));
constexpr int TILE_BYTES = 64 * 256, BUF_BYTES = 2 * TILE_BYTES, FLAG_OFF = 2 * BUF_BYTES, LDS_BYTES = FLAG_OFF + 256;
__device__ __forceinline__ unsigned cvtpk(float lo, float hi) { f32x2_t v = {lo, hi}; bf16x2_t b = __builtin_convertvector(v, bf16x2_t); return __builtin_bit_cast(unsigned, b); }
__device__ __forceinline__ int crow(int i, int h) { return (i & 3) + 8 * (i >> 2) + 4 * h; }
__device__ __forceinline__ unsigned off_b(unsigned row, unsigned ch) { return 256u * row + 16u * (ch ^ (((row & 3) << 2) | ((row >> 2) & 3))); }
__device__ __forceinline__ s16x4 trread(const ATT_LAS unsigned char* p) { return __builtin_bit_cast(s16x4, __builtin_amdgcn_ds_read_tr16_b64_v4i16((ATT_LAS s16x4*)p)); }
#define ATT_MFMA(a, b, c) __builtin_amdgcn_mfma_f32_32x32x16_bf16((a), (b), (c), 0, 0, 0)

struct AUnit { const bf16* Q; const bf16* K; const bf16* V; bf16* O; int pq, pk, po, b, qb; float sink2; int gqa; const float* sk; };
__device__ __forceinline__ void attn_prefetch(const AUnit& u, bf16x8 (&qf)[8], u32x4& kr0, u32x4& kr1, u32x4& vr0, u32x4& vr1, int tid, int wid, int lane) {
    int ln_ = lane, td_ = tid; asm volatile("" : "+v"(ln_), "+v"(td_));
    const int r32 = ln_ & 31, h = ln_ >> 5, tq = (u.gqa ? 64 * u.qb + 32 * (wid & 1) : 256 * u.qb + 32 * wid) + r32; const size_t rowbase = (size_t)u.b * 4096;
    { const char* qb_ = (const char*)(u.Q + rowbase * u.pq + (u.gqa ? (wid >> 1) * 128 : 0)); const unsigned qo = (unsigned)(tq * u.pq + 8 * h) * 2u;
#pragma unroll
      for (int s = 0; s < 8; ++s) qf[s] = *(const bf16x8*)(qb_ + qo + 32 * s); }
    const int lrow = td_ >> 4, lch = td_ & 15; const unsigned kvo = (unsigned)(lrow * u.pk + 8 * lch) * 2u;
    const size_t o = ((size_t)rowbase + (size_t)(64 * (u.gqa ? u.qb : 4 * u.qb + 3))) * u.pk * 2; const char* k = (const char*)u.K + o; const char* v = (const char*)u.V + o;
    kr0 = *(const u32x4*)(k + kvo); kr1 = *(const u32x4*)(k + (size_t)64 * u.pk + kvo); vr0 = *(const u32x4*)(v + kvo); vr1 = *(const u32x4*)(v + (size_t)64 * u.pk + kvo);
}
template <int MODE, bool EARLY>
__device__ __forceinline__ void attn_unit(ATT_LAS unsigned char* lds, const AUnit& U, bool has_next, const AUnit& N, bf16x8 (&qf)[8], u32x4& kr0, u32x4& kr1, u32x4& vr0, u32x4& vr1, int tid, int wid, int lane) {
    const bf16* __restrict__ Kh = U.K; const bf16* __restrict__ Vh = U.V; bf16* __restrict__ Oh = U.O + (MODE == 0 ? (wid >> 1) * 128 : 0); const int pk = U.pk, po = U.po, b = U.b, qb = U.qb;
    const float sink2 = (MODE == 0) ? U.sk[wid >> 1] * 1.44269504089f : 0.f;
    int ln_ = lane, td_ = tid; asm volatile("" : "+v"(ln_), "+v"(td_));
    const int r32 = ln_ & 31, h = ln_ >> 5;
    const int t0 = (MODE == 0) ? 64 * qb + 32 * (wid & 1) : 256 * qb + 32 * wid, tq = t0 + r32;
    const size_t rowbase = (size_t)b * 4096;
    f32x16 oacc[4];
#pragma unroll
    for (int c = 0; c < 4; ++c)
#pragma unroll
        for (int i = 0; i < 16; ++i) oacc[c][i] = 0.f;
    float carry = 0.f, mrun = sink2, lrun = (h == 0) ? 1.f : 0.f;
    const int kt_hi = (MODE == 0) ? qb : 4 * qb + 3, kt_lo = (MODE == 0) ? ((qb - 2) > 0 ? (qb - 2) : 0) : 0;
    const int lrow = td_ >> 4, lch = td_ & 15;
    const unsigned lw = off_b((unsigned)lrow, (unsigned)lch);
    const unsigned kvo = (unsigned)(lrow * pk + 8 * lch) * 2u;
    const char* kgb = (const char*)(Kh + rowbase * pk); const char* vgb = (const char*)(Vh + rowbase * pk);
    const unsigned xk = (unsigned)(((r32 & 3) << 2) | ((r32 >> 2) & 3));
    const int q4 = (ln_ & 15) >> 2, p4 = ln_ & 3, blk = (ln_ >> 4) & 1;
    unsigned vaddr[4][2];
#pragma unroll
    for (int c = 0; c < 4; ++c)
#pragma unroll
        for (int t = 0; t < 2; ++t) { const unsigned row = (unsigned)(8 * t + 4 * h + q4), x = (unsigned)((q4 << 2) | ((2 * t + h) & 3)), ch = (unsigned)(4 * c + 2 * blk + (p4 >> 1));
            vaddr[c][t] = 256u * row + 16u * (ch ^ x) + 8u * (unsigned)(p4 & 1); }
#define ATT_GLOAD(kt) do { const size_t _o = (size_t)(64 * (kt)) * pk * 2; const char* _k = kgb + _o; const char* _v = vgb + _o; kr0 = *(const u32x4*)(_k + kvo); kr1 = *(const u32x4*)(_k + (size_t)64 * pk + kvo); vr0 = *(const u32x4*)(_v + kvo); vr1 = *(const u32x4*)(_v + (size_t)64 * pk + kvo); } while (0)
#define ATT_LSTORE(bf) do { ATT_LAS unsigned char* _b = lds + (bf) * BUF_BYTES + lw; *(ATT_LAS u32x4*)_b = kr0; *(ATT_LAS u32x4*)(_b + 8192) = kr1; *(ATT_LAS u32x4*)(_b + TILE_BYTES) = vr0; *(ATT_LAS u32x4*)(_b + TILE_BYTES + 8192) = vr1; } while (0)
    int buf = 0;
    ATT_LSTORE(0); __syncthreads();
    for (int kt = kt_hi; kt >= kt_lo; --kt) {
        const bool more = kt > kt_lo;
        if (more) ATT_GLOAD(kt - 1);
        const int kbase = 64 * kt;
        bool relevant, masked;
        if (MODE == 1) { relevant = kbase <= t0 + 30; masked = kbase + 63 >= t0; }
        else { relevant = (kbase <= t0 + 31) && (kbase + 63 >= t0 - 127); masked = !((kbase + 63 <= t0) && (kbase >= t0 - 96)); }
        if (relevant) {
            const ATT_LAS unsigned char* Kb = lds + buf * BUF_BYTES; const ATT_LAS unsigned char* Vb = Kb + TILE_BYTES;
            f32x16 sacc[2];
#pragma unroll
            for (int kb = 0; kb < 2; ++kb) {
#pragma unroll
                for (int i = 0; i < 16; ++i) sacc[kb][i] = 0.f;
#pragma unroll
                for (int s = 0; s < 8; ++s) { const bf16x8 kf = *(const ATT_LAS bf16x8*)(Kb + kb * 8192 + 256 * r32 + 16 * (((unsigned)(2 * s + h)) ^ xk)); sacc[kb] = ATT_MFMA(kf, qf[s], sacc[kb]); }
            }
            bf16x8 pf[2][2];
            if (MODE == 1) {
#pragma unroll
                for (int kk = 0; kk < 2; ++kk) { const int kb = 1 - kk; const int sb0 = kbase + 32 * kb;
                    float sp[16], A[16];
#pragma unroll
                    for (int i = 0; i < 16; ++i) { const float z = sacc[kb][i]; const float e = __builtin_amdgcn_exp2f(-__builtin_fabsf(z)); sp[i] = fmaxf(z, 0.f) + __builtin_amdgcn_logf(1.f + e); }
                    if (masked) {
#pragma unroll
                        for (int i = 0; i < 16; ++i) sp[i] = (sb0 + crow(i, h) < tq) ? sp[i] : 0.f; }
                    float G[4], Gp[4], T[4];
#pragma unroll
                    for (int g = 0; g < 4; ++g) { G[g] = (sp[4 * g] + sp[4 * g + 1]) + (sp[4 * g + 2] + sp[4 * g + 3]); Gp[g] = __shfl_xor(G[g], 32); T[g] = G[g] + Gp[g]; }
                    float R[4]; R[3] = carry; R[2] = R[3] + T[3]; R[1] = R[2] + T[2]; R[0] = R[1] + T[1]; carry = R[0] + T[0];
#pragma unroll
                    for (int g = 0; g < 4; ++g) { const float S3 = R[g] + (h == 0 ? Gp[g] : 0.f), S2 = S3 + sp[4 * g + 3], S1 = S2 + sp[4 * g + 2], S0 = S1 + sp[4 * g + 1];
                        A[4 * g + 3] = __builtin_amdgcn_exp2f(sacc[kb][4 * g + 3] - sp[4 * g + 3] - S3); A[4 * g + 2] = __builtin_amdgcn_exp2f(sacc[kb][4 * g + 2] - sp[4 * g + 2] - S2);
                        A[4 * g + 1] = __builtin_amdgcn_exp2f(sacc[kb][4 * g + 1] - sp[4 * g + 1] - S1); A[4 * g + 0] = __builtin_amdgcn_exp2f(sacc[kb][4 * g + 0] - sp[4 * g + 0] - S0); }
                    if (masked) {
#pragma unroll
                        for (int i = 0; i < 16; ++i) A[i] = (sb0 + crow(i, h) < tq) ? A[i] : 0.f; }
#pragma unroll
                    for (int s2 = 0; s2 < 2; ++s2) { u32x4 w; w.x = cvtpk(A[8 * s2], A[8 * s2 + 1]); w.y = cvtpk(A[8 * s2 + 2], A[8 * s2 + 3]); w.z = cvtpk(A[8 * s2 + 4], A[8 * s2 + 5]); w.w = cvtpk(A[8 * s2 + 6], A[8 * s2 + 7]); pf[kb][s2] = __builtin_bit_cast(bf16x8, w); }
                }
            } else {
                if (masked) {
#pragma unroll
                    for (int kb = 0; kb < 2; ++kb)
#pragma unroll
                        for (int i = 0; i < 16; ++i) { const int key = kbase + 32 * kb + crow(i, h); const bool valid = (key <= tq) && (key + 127 >= tq); sacc[kb][i] = valid ? sacc[kb][i] : -__builtin_inff(); } }
                float tmax = sacc[0][0];
#pragma unroll
                for (int kb = 0; kb < 2; ++kb)
#pragma unroll
                    for (int i = 0; i < 16; ++i) tmax = fmaxf(tmax, sacc[kb][i]);
                tmax = fmaxf(tmax, __shfl_xor(tmax, 32));
                const float mnew = fmaxf(mrun, tmax), alpha = __builtin_amdgcn_exp2f(mrun - mnew); mrun = mnew;
                float psum = 0.f;
#pragma unroll
                for (int kb = 0; kb < 2; ++kb) { float P[16];
#pragma unroll
                    for (int i = 0; i < 16; ++i) { P[i] = __builtin_amdgcn_exp2f(sacc[kb][i] - mnew); psum += P[i]; }
#pragma unroll
                    for (int s2 = 0; s2 < 2; ++s2) { u32x4 w; w.x = cvtpk(P[8 * s2], P[8 * s2 + 1]); w.y = cvtpk(P[8 * s2 + 2], P[8 * s2 + 3]); w.z = cvtpk(P[8 * s2 + 4], P[8 * s2 + 5]); w.w = cvtpk(P[8 * s2 + 6], P[8 * s2 + 7]); pf[kb][s2] = __builtin_bit_cast(bf16x8, w); } }
                lrun = lrun * alpha + psum;
#pragma unroll
                for (int c = 0; c < 4; ++c)
#pragma unroll
                    for (int i = 0; i < 16; ++i) oacc[c][i] *= alpha;
            }
#pragma unroll
            for (int kb = 0; kb < 2; ++kb)
#pragma unroll
                for (int s2 = 0; s2 < 2; ++s2)
#pragma unroll
                    for (int c = 0; c < 4; ++c) { const s16x4 lo = trread(Vb + vaddr[c][0] + 4096 * (2 * kb + s2)), hi = trread(Vb + vaddr[c][1] + 4096 * (2 * kb + s2));
                        const bf16x8 vf = __builtin_shufflevector(lo, hi, 0, 1, 2, 3, 4, 5, 6, 7); oacc[c] = ATT_MFMA(vf, pf[kb][s2], oacc[c]); }
        }
        if (more) ATT_LSTORE(buf ^ 1);
        if (EARLY && MODE == 1) {
            volatile ATT_LAS unsigned* fl = (volatile ATT_LAS unsigned*)(lds + FLAG_OFF) + (kt & 1) * 8;
            const bool done = __all(carry > 160.f);
            if (lane == 0) fl[wid] = done ? 1u : 0u;
            __syncthreads();
            unsigned alld = 1u;
#pragma unroll
            for (int w = 0; w < 8; ++w) alld &= fl[w];
            buf ^= 1;
            if (alld) break;
        } else { __syncthreads(); buf ^= 1; }
    }
#undef ATT_GLOAD
#undef ATT_LSTORE
    if (MODE == 0) { const float lt = lrun + __shfl_xor(lrun, 32); const float inv = 1.f / lt;
#pragma unroll
        for (int c = 0; c < 4; ++c)
#pragma unroll
            for (int i = 0; i < 16; ++i) oacc[c][i] *= inv; }
    if (has_next) attn_prefetch(N, qf, kr0, kr1, vr0, vr1, tid, wid, lane);
    { int l2 = lane; asm volatile("" : "+v"(l2)); const int r2 = l2 & 31, h2 = l2 >> 5;
      char* ob = (char*)(Oh + rowbase * po); const unsigned oo = (unsigned)((t0 + r2) * po) * 2u + 16u * (unsigned)h2;
#pragma unroll
      for (int c = 0; c < 4; ++c)
#pragma unroll
        for (int gp = 0; gp < 2; ++gp) { const int g0 = 2 * gp;
            const unsigned x0 = cvtpk(oacc[c][4 * g0], oacc[c][4 * g0 + 1]), x1 = cvtpk(oacc[c][4 * g0 + 2], oacc[c][4 * g0 + 3]);
            const unsigned y0 = cvtpk(oacc[c][4 * g0 + 4], oacc[c][4 * g0 + 5]), y1 = cvtpk(oacc[c][4 * g0 + 6], oacc[c][4 * g0 + 7]);
            const auto s0 = __builtin_amdgcn_permlane32_swap(x0, y0, false, false); const auto s1 = __builtin_amdgcn_permlane32_swap(x1, y1, false, false);
            u32x4 w; w.x = s0[0]; w.y = s1[0]; w.z = s0[1]; w.w = s1[1];
            *(u32x4*)(ob + oo + 64 * c + 32 * gp) = w; } }
    if (EARLY && MODE == 1) __syncthreads();
}
}


constexpr int NWAVES = 8;
constexpr int BATCH = 4, SEQ = 4096, D = 4096, M = BATCH * SEQ, HD = 128, FF = 4 * D;
constexpr int D_IN = 9216, NG = 8192, N1 = D_IN + NG, NMOD = 6 * D;
constexpr float NORM_EPS = 1e-6f;
constexpr size_t MiB = 1u << 20;
constexpr size_t WS_CTL = 0, CTL_ZERO_BYTES = 49152;
constexpr size_t WS_CMX = 16384;
constexpr size_t WS_MOD = 1 * MiB, WS_COS = 2 * MiB, WS_SIN = 3 * MiB;
constexpr size_t WS_W1 = 4 * MiB;
constexpr size_t WS_WPS = 140 * MiB, WS_WPB = 156 * MiB;
constexpr size_t WS_WO = 172 * MiB;
constexpr size_t WS_WF1 = 204 * MiB;
constexpr size_t WS_WF2 = 332 * MiB;
constexpr size_t WS_A = 460 * MiB;
constexpr size_t WS_B = 588 * MiB;
constexpr size_t WS_C = 716 * MiB;
constexpr size_t WS_H8 = WS_C + 544 * MiB;
constexpr size_t WS_W8G = WS_H8 + 64 * MiB;
constexpr size_t WS_W8F = WS_W8G + 56 * MiB;
constexpr size_t WS_W8O = WS_W8F + 64 * MiB;
constexpr size_t WS_END = WS_W8O + 64 * MiB;
constexpr size_t WS_U8 = WS_W1;
constexpr size_t WS_SU = 320 * 1024, WS_SO = 384 * 1024, WS_CO = 32768;
constexpr int NB16 = 3072, NI8 = 14336;
constexpr size_t WS_SH = 64 * 1024, WS_S2 = 128 * 1024, WS_SG = 192 * 1024, WS_SF = 256 * 1024;
constexpr int CW_BAR = 0, CW_KS = 3520;
constexpr int RING_OFF = 0, RING_BYTES = 131072, LDSCTL_OFF = 139264, MISC_OFF = LDSCTL_OFF + 320, LDS_BYTES = 147456;

#define GAS __attribute__((address_space(1)))
#define LAS __attribute__((address_space(3)))
typedef unsigned short bf16;
typedef unsigned v4u __attribute__((ext_vector_type(4)));
typedef unsigned v2u __attribute__((ext_vector_type(2)));
typedef float f32x4 __attribute__((ext_vector_type(4)));
#define LDS_WAIT() asm volatile("s_waitcnt lgkmcnt(0)" ::: "memory")
__device__ __forceinline__ unsigned f2bf(float f) { unsigned u = __builtin_bit_cast(unsigned, f); return (u + 0x7fffu + ((u >> 16) & 1u)) >> 16; }
__device__ __forceinline__ unsigned pk2(float lo, float hi) { return f2bf(lo) | (f2bf(hi) << 16); }

#define XB_TMO      128
#define XB_XCNT(j)  (256  + 64 * (j))
#define XB_XSUB(j)  (1280 + 64 * (j))
#define XB_XGEN(j)  (2304 + 64 * (j))
#define XB_TOP      3328
#define XB_TOPGEN   3392
#define XCD_BAR_WORDS 3456
#define XB_SPIN_CAP (1u << 18)
__device__ __forceinline__ unsigned xb_ld(unsigned* p)              { return __hip_atomic_load(p, __ATOMIC_RELAXED, __HIP_MEMORY_SCOPE_AGENT); }
__device__ __forceinline__ unsigned xb_add(unsigned* p, unsigned v) { return __hip_atomic_fetch_add(p, v, __ATOMIC_RELAXED, __HIP_MEMORY_SCOPE_AGENT); }
__device__ __forceinline__ unsigned xb_xcc_id() { return (unsigned)__builtin_amdgcn_s_getreg((3 << 11) | 20) & 0xFu; }
#define XB_SPIN(cond, bar) do { unsigned _sp = 0; while (cond) { __builtin_amdgcn_s_sleep(1); \
    if ((++_sp & 255u) == 0u) { if (xb_ld(&(bar)[XB_TMO])) break; if (_sp > XB_SPIN_CAP) { atomicAdd(&(bar)[XB_TMO], 1u); break; } } } } while (0)
struct XcdBarrier { unsigned* bar; unsigned x; volatile LAS unsigned* st; };
__device__ __forceinline__ XcdBarrier xcd_barrier_post(unsigned* bar, volatile LAS unsigned* st) {
    XcdBarrier b; b.bar = bar; b.x = xb_xcc_id(); b.st = st;
    if (threadIdx.x == 0) (void)xb_add(&bar[XB_XCNT(b.x)], 1u);
    return b;
}
__device__ __forceinline__ void xcd_barrier_complete(unsigned* bar, unsigned x, unsigned& nloc, unsigned& nx) {
    const unsigned G = gridDim.x * gridDim.y * gridDim.z;
    unsigned sum, cnt, mine, sp = 0u;
    for (;;) {
        sum = 0u; cnt = 0u; mine = 0u;
#pragma unroll
        for (unsigned j = 0; j < 16; ++j) { const unsigned c = xb_ld(&bar[XB_XCNT(j)]); sum += c; cnt += (c > 0u) ? 1u : 0u; mine = (j == x) ? c : mine; }
        if (sum == G) break;
        __builtin_amdgcn_s_sleep(1);
        if ((++sp & 255u) == 0u) { if (xb_ld(&bar[XB_TMO])) break; if (sp > XB_SPIN_CAP) { atomicAdd(&bar[XB_TMO], 1u); break; } }
    }
    nloc = mine > 0u ? mine : 1u; nx = cnt > 0u ? cnt : 1u;
}
__device__ __forceinline__ void xcd_barrier(const XcdBarrier& b) {
    asm volatile("s_waitcnt vmcnt(0)" ::: "memory");
    __syncthreads();
    if (threadIdx.x == 0) {
        unsigned* bar = b.bar;
        __builtin_amdgcn_s_waitcnt(0);
        unsigned nloc = b.st[0], nx = b.st[1];
        if (nloc == 0u) { xcd_barrier_complete(bar, b.x, nloc, nx); b.st[0] = nloc; b.st[1] = nx; }
        const unsigned old = xb_add(&bar[XB_XSUB(b.x)], 1u);
        const unsigned gen = old / nloc;
        if (old + 1u == (gen + 1u) * nloc) {
            __builtin_amdgcn_fence(__ATOMIC_RELEASE, "agent");
            asm volatile("s_waitcnt vmcnt(0)" ::: "memory");
            const unsigned og = xb_add(&bar[XB_TOP], 1u);
            const unsigned tg = og / nx;
            if (og + 1u == (tg + 1u) * nx) xb_add(&bar[XB_TOPGEN], 1u);
            else XB_SPIN(xb_ld(&bar[XB_TOPGEN]) == tg, bar);
            __builtin_amdgcn_fence(__ATOMIC_ACQUIRE, "agent");
            xb_add(&bar[XB_XGEN(b.x)], 1u);
            asm volatile("s_waitcnt vmcnt(0)" ::: "memory");
        } else {
            XB_SPIN(xb_ld(&bar[XB_XGEN(b.x)]) == gen, bar);
            __builtin_amdgcn_fence(__ATOMIC_ACQUIRE, "agent");
            asm volatile("s_waitcnt vmcnt(0)" ::: "memory");
        }
    }
    __syncthreads();
}

struct Frame {
    LAS unsigned char* lds;
    int tid, lane, wave, vcu, G;
};
struct Args {
    const float *x, *c, *w_ada, *b_ada, *g_pre_mix, *g_post_mix, *g_pre_mlp, *g_post_mlp, *w_in, *sinks, *w_bg, *b_bg, *w_ps, *w_pb, *w_out, *w_f1, *w_f2;
    float* out; unsigned char* ws; int ph_lo, ph_hi;
};

__device__ __forceinline__ float wave_sum(float v) {
#pragma unroll
    for (int o = 1; o < 64; o <<= 1) v += __shfl_xor(v, o);
    return v;
}
__device__ const double ROPE_INVF[64] = {1.0, 0.8659643233600653, 0.7498942093324559, 0.6493816315762113, 0.5623413251903491, 0.4869675251658631, 0.4216965034285822, 0.3651741272548377, 0.31622776601683794, 0.27384196342643613, 0.23713737056616552, 0.2053525026457146, 0.1778279410038923, 0.1539926526059492, 0.1333521432163324, 0.11547819846894582, 0.1, 0.08659643233600653, 0.07498942093324558, 0.06493816315762113, 0.05623413251903491, 0.04869675251658631, 0.042169650342858224, 0.03651741272548377, 0.03162277660168379, 0.027384196342643614, 0.023713737056616554, 0.02053525026457146, 0.01778279410038923, 0.01539926526059492, 0.01333521432163324, 0.011547819846894581, 0.01, 0.008659643233600654, 0.007498942093324558, 0.006493816315762113, 0.005623413251903491, 0.004869675251658631, 0.004216965034285823, 0.003651741272548377, 0.0031622776601683794, 0.0027384196342643613, 0.0023713737056616554, 0.002053525026457146, 0.0017782794100389228, 0.001539926526059492, 0.001333521432163324, 0.0011547819846894581, 0.001, 0.0008659643233600654, 0.0007498942093324559, 0.0006493816315762113, 0.0005623413251903491, 0.0004869675251658631, 0.00042169650342858224, 0.0003651741272548377, 0.00031622776601683794, 0.0002738419634264361, 0.00023713737056616554, 0.0002053525026457146, 0.00017782794100389227, 0.0001539926526059492, 0.0001333521432163324, 0.00011547819846894582};

struct TDesc { const float* W; bf16* WT; int K, N, row_off, rope_lim, item, fp8; };
__device__ __forceinline__ void p0_tr_load(const TDesc& t, f32x4 (&v)[16], int lane) {
    const int nblk = t.N / 64, kb = t.item / nblk, nb = t.item % nblk, k0 = 64 * kb, n0 = 64 * nb;
    const int kq = lane >> 4, nn = 4 * (lane & 15);
#pragma unroll
    for (int i = 0; i < 16; ++i) v[i] = *(const f32x4*)(t.W + (size_t)(k0 + 4 * i + kq) * t.N + n0 + nn);
}
__device__ __forceinline__ void p0_tr_store(const TDesc& t, const f32x4 (&v)[16], LAS float* scr, int lane) {
    const int nblk = t.N / 64, kb = t.item / nblk, nb = t.item % nblk, k0 = 64 * kb, n0 = 64 * nb;
    const int kq = lane >> 4, nn = 4 * (lane & 15);
#pragma unroll
    for (int i = 0; i < 16; ++i) { LAS float* s = scr + (4 * i + kq) * 65 + nn; s[0] = v[i].x; s[1] = v[i].y; s[2] = v[i].z; s[3] = v[i].w; }
    LDS_WAIT(); asm volatile("" ::: "memory");
    const int c = lane & 7;
#pragma unroll
    for (int j = 0; j < 8; ++j) { const int n = (lane >> 3) + 8 * j; const LAS float* s = scr + (8 * c) * 65 + n;
        v4u o; o.x = pk2(s[0 * 65], s[1 * 65]); o.y = pk2(s[2 * 65], s[3 * 65]); o.z = pk2(s[4 * 65], s[5 * 65]); o.w = pk2(s[6 * 65], s[7 * 65]);
        int nd = n0 + n;
        if (t.rope_lim) {
            int sb_, sd_; bool rp_ = false;
            if (nd < 2048) { sb_ = 0; sd_ = 3072; rp_ = true; } else if (nd < 2560) { sb_ = 2048; sd_ = 0; rp_ = true; } else if (nd < 3072) { sb_ = 2560; sd_ = 512; }
            else if (nd < 5120) { sb_ = 3072; sd_ = 5120; } else if (nd < 7168) { sb_ = 5120; sd_ = 7168; } else { sb_ = 7168; sd_ = 1024; }
            int loc = nd - sb_; if (rp_) { const int d = loc & 127; loc = (loc & ~127) + (d < 64 ? 8 * (d >> 2) + (d & 3) : 8 * ((d - 64) >> 2) + 4 + (d & 3)); }
            nd = sd_ + loc; }
        *(v4u*)(t.WT + (size_t)(t.row_off + nd) * t.K + k0 + 8 * c) = o; }
    LDS_WAIT(); asm volatile("" ::: "memory");
}
__device__ __forceinline__ void p0_gemv(Frame& F, const Args& a, float* mod) {
    LAS f32x4* cact = (LAS f32x4*)F.lds;
    LAS float* red = (LAS float*)(F.lds + 65536);
    for (int k = F.tid; k < D; k += NWAVES * 64) { f32x4 v;
#pragma unroll
        for (int b = 0; b < 4; ++b) { const float xx = a.c[b * D + k]; v[b] = xx / (1.f + expf(-xx)); }
        cact[k] = v; }
    __syncthreads();
    const int half = F.lane >> 5, l32 = F.lane & 31; const bool act = l32 < 24;
    for (int cg = F.vcu; cg < NMOD / 96; cg += F.G) {
        f32x4 acc[4];
#pragma unroll
        for (int b = 0; b < 4; ++b) acc[b] = (f32x4){0.f, 0.f, 0.f, 0.f};
        const int kbase = 512 * F.wave + half;
        const float* wp = a.w_ada + (size_t)kbase * NMOD + 96 * cg + 4 * (act ? l32 : 0);
#define GV_LOAD(w, kk) _Pragma("unroll") for (int u = 0; u < 16; ++u) w[u] = *(const f32x4*)(wp + (size_t)(2 * ((kk) + u)) * NMOD)
#define GV_FMA(w, kk) _Pragma("unroll") for (int u = 0; u < 16; ++u) { const f32x4 ca = cact[kbase + 2 * ((kk) + u)]; _Pragma("unroll") for (int b = 0; b < 4; ++b) acc[b] += w[u] * ca[b]; }
        f32x4 wA[16], wB[16];
        GV_LOAD(wA, 0);
#pragma unroll 1
        for (int kk = 0; kk < 224; kk += 32) {
            GV_LOAD(wB, kk + 16); asm volatile("" ::: "memory");
            GV_FMA(wA, kk);
            GV_LOAD(wA, kk + 32); asm volatile("" ::: "memory");
            GV_FMA(wB, kk + 16);
        }
        GV_LOAD(wB, 240); asm volatile("" ::: "memory");
        GV_FMA(wA, 224);
        GV_FMA(wB, 240);
#undef GV_LOAD
#undef GV_FMA
#pragma unroll
        for (int b = 0; b < 4; ++b)
#pragma unroll
            for (int j = 0; j < 4; ++j) acc[b][j] += __shfl_xor(acc[b][j], 32);
        if (half == 0 && act) {
#pragma unroll
            for (int b = 0; b < 4; ++b) *(LAS f32x4*)(red + (F.wave * 4 + b) * 96 + 4 * l32) = acc[b]; }
        __syncthreads();
        if (F.tid < 384) { const int b = F.tid / 96, j = F.tid % 96; float s = 0.f;
#pragma unroll
            for (int w = 0; w < 8; ++w) s += red[(w * 4 + b) * 96 + j];
            mod[b * NMOD + 96 * cg + j] = s + a.b_ada[96 * cg + j]; }
        __syncthreads();
    }
}
__device__ __forceinline__ void p0_rope_table(Frame& F, float* cosT, float* sinT) {
    const double TWO_PI_HI = 6.283185307179586232, TWO_PI_LO = 2.4492935982947064e-16, INV_2PI = 0.15915494309189533577;
    for (int idx = F.vcu * (NWAVES * 64) + F.tid; idx < SEQ * 64; idx += F.G * NWAVES * 64) {
        const int pos = idx >> 6, i = idx & 63;
        const double ang = (double)pos * ROPE_INVF[i];
        const double n = __builtin_rint(ang * INV_2PI);
        double r = __builtin_fma(-n, TWO_PI_HI, ang); r = __builtin_fma(-n, TWO_PI_LO, r);
        const double r2 = r * r; double tc = 1.0, ts = r, sc = 1.0, ss = r;
#pragma unroll 1
        for (int k = 1; k <= 15; ++k) { tc *= -r2 / (double)((2 * k - 1) * (2 * k)); ts *= -r2 / (double)((2 * k) * (2 * k + 1)); sc += tc; ss += ts; }
        cosT[idx] = (float)sc; sinT[idx] = (float)ss;
    }
}

__device__ __forceinline__ f32x4 ld_bf4(const bf16* p) { const v2u w = *(const v2u*)p; return (f32x4){__uint_as_float(w.x << 16), __uint_as_float(w.x & 0xffff0000u), __uint_as_float(w.y << 16), __uint_as_float(w.y & 0xffff0000u)}; }
__device__ __forceinline__ void st_bf4(bf16* p, f32x4 v) { v2u w; w.x = pk2(v.x, v.y); w.y = pk2(v.z, v.w); *(v2u*)p = w; }
__device__ __forceinline__ float sumsq4(f32x4 v) { return (v.x * v.x + v.y * v.y) + (v.z * v.z + v.w * v.w); }

#define LAUNDER_PTR(p) asm volatile("" : "+s"(p))
__device__ __forceinline__ float wave_max(float v) {
#pragma unroll
    for (int o = 1; o < 64; o <<= 1) v = fmaxf(v, __shfl_xor(v, o));
    return v;
}
__device__ __forceinline__ float amax4(f32x4 v) { return fmaxf(fmaxf(__builtin_fabsf(v.x), __builtin_fabsf(v.y)), fmaxf(__builtin_fabsf(v.z), __builtin_fabsf(v.w))); }
__device__ __forceinline__ unsigned q4_i8(f32x4 v, float inv) {
    const int a = (int)__builtin_rintf(v.x * inv), b = (int)__builtin_rintf(v.y * inv), c = (int)__builtin_rintf(v.z * inv), d = (int)__builtin_rintf(v.w * inv);
    return (unsigned)(a & 255) | ((unsigned)(b & 255) << 8) | ((unsigned)(c & 255) << 16) | ((unsigned)d << 24); }
constexpr int SLAB_PITCH = 8192 + 16;
struct SDesc { const float* W; unsigned char* dst; float* sc; int N, c0, r0, rope; };
template <int H> __device__ __forceinline__ void slab_load(const SDesc& s, f32x4 (&va)[8], f32x4 (&vb)[8], int tid) {
    const float* p = s.W + (size_t)(2 * (tid >> 2) + 2048 * H) * s.N + s.c0 + 4 * (tid & 3);
#pragma unroll
    for (int i = 0; i < 8; ++i) { const float* q = p + (size_t)(256 * i) * s.N; va[i] = *(const f32x4*)q; vb[i] = *(const f32x4*)(q + s.N); }
}
template <int H> __device__ __forceinline__ void slab_stage(LAS unsigned char* lds, const f32x4 (&va)[8], const f32x4 (&vb)[8], int tid) {
    LAS unsigned char* t = lds + (4 * (tid & 3)) * SLAB_PITCH + 4 * (tid >> 2) + 4096 * H;
#pragma unroll
    for (int i = 0; i < 8; ++i)
#pragma unroll
        for (int j = 0; j < 4; ++j) *(LAS unsigned*)(t + j * SLAB_PITCH + 512 * i) = pg8::cvt_pk_bf16(va[i][j], vb[i][j]);
}
__device__ __forceinline__ void slab_quant(const SDesc& s, const LAS unsigned char* lds, int wave, int lane) {
#pragma unroll 1
    for (int rr = 0; rr < 2; ++rr) { const int n = 2 * wave + rr;
        v4u w[8]; float am = 0.f;
#pragma unroll
        for (int j = 0; j < 8; ++j) w[j] = *(const LAS v4u*)(lds + n * SLAB_PITCH + 16 * (lane + 64 * j));
#pragma unroll
        for (int j = 0; j < 8; ++j)
#pragma unroll
            for (int e = 0; e < 4; ++e) { const unsigned x = w[j][e]; am = fmaxf(am, fmaxf(__builtin_fabsf(__uint_as_float(x << 16)), __builtin_fabsf(__uint_as_float(x & 0xffff0000u)))); }
        am = wave_max(am); const float inv = am > 0.f ? 127.f / am : 0.f;
        int loc = s.c0 + n; if (s.rope) { const int d = loc & 127; loc = (loc & ~127) + (d < 64 ? 8 * (d >> 2) + (d & 3) : 8 * ((d - 64) >> 2) + 4 + (d & 3)); }
        const int drow = s.r0 + loc;
        if (lane == 0) s.sc[drow] = am * (1.f / 127.f);
#pragma unroll
        for (int j = 0; j < 8; ++j) { v2u o;
            o.x = q4_i8((f32x4){__uint_as_float(w[j].x << 16), __uint_as_float(w[j].x & 0xffff0000u), __uint_as_float(w[j].y << 16), __uint_as_float(w[j].y & 0xffff0000u)}, inv);
            o.y = q4_i8((f32x4){__uint_as_float(w[j].z << 16), __uint_as_float(w[j].z & 0xffff0000u), __uint_as_float(w[j].w << 16), __uint_as_float(w[j].w & 0xffff0000u)}, inv);
            *(v2u*)(s.dst + (size_t)drow * D + 8 * (lane + 64 * j)) = o; }
    }
}
__device__ __forceinline__ void ks_quant(const LAS unsigned char* lds, unsigned char* dst, float* sc, int* csum, int cs, int q, unsigned mb0, unsigned mb1, int wave, int lane) {
#pragma unroll 1
    for (int rr = 0; rr < 2; ++rr) { const int n = 2 * wave + rr, col = 16 * cs + n;
        v4u w[8];
#pragma unroll
        for (int j = 0; j < 8; ++j) w[j] = *(const LAS v4u*)(lds + n * SLAB_PITCH + 16 * (lane + 64 * j));
        const float am = __uint_as_float(rr ? mb1 : mb0), inv = am > 0.f ? 127.f / am : 0.f;
        if (lane == 0 && q == 0) sc[col] = am * (1.f / 127.f);
        float qs = 0.f;
#pragma unroll
        for (int j = 0; j < 8; ++j) { v2u o; float t[8];
#pragma unroll
            for (int e = 0; e < 4; ++e) { const unsigned x = w[j][e]; t[2 * e] = __builtin_rintf(__uint_as_float(x << 16) * inv); t[2 * e + 1] = __builtin_rintf(__uint_as_float(x & 0xffff0000u) * inv); }
#pragma unroll
            for (int e = 0; e < 8; ++e) qs += t[e];
            o.x = ((unsigned)(int)t[0] & 255u) | (((unsigned)(int)t[1] & 255u) << 8) | (((unsigned)(int)t[2] & 255u) << 16) | ((unsigned)(int)t[3] << 24);
            o.y = ((unsigned)(int)t[4] & 255u) | (((unsigned)(int)t[5] & 255u) << 8) | (((unsigned)(int)t[6] & 255u) << 16) | ((unsigned)(int)t[7] << 24);
            *(v2u*)(dst + (size_t)col * FF + 4096 * q + 8 * (lane + 64 * j)) = o; }
        qs = wave_sum(qs);
        if (lane == 0) atomicAdd(csum + col, (int)qs);
    }
}
__device__ __forceinline__ void p1_rows(Frame& F, const Args& a, const float* mod, bf16* H, unsigned char* H8, float* SH) {
    int lane_ = F.lane; asm volatile("" : "+v"(lane_)); const int LN = lane_;
    const int gw = F.vcu * NWAVES + F.wave, NGW = F.G * NWAVES;
    for (int r0 = gw * 8; r0 < M; r0 += NGW * 8) {
        const int b = r0 >> 12;
#pragma unroll 1
        for (int r = 0; r < 8; ++r) { const size_t row = (size_t)(r0 + r);
            const float* mb = mod + b * NMOD; const float* gp = a.g_pre_mix; LAUNDER_PTR(mb); LAUNDER_PTR(gp);
            f32x4 v[16]; float ss = 0.f;
#pragma unroll
            for (int j = 0; j < 16; ++j) { v[j] = *(const f32x4*)(a.x + row * D + 4 * LN + 256 * j); ss += sumsq4(v[j]); }
            const float rstd = 1.f / sqrtf(wave_sum(ss) * (1.f / D) + NORM_EPS);
            float am = 0.f;
#pragma unroll
            for (int j = 0; j < 16; ++j) { const int col = 4 * LN + 256 * j; if ((j & 3) == 0) asm volatile("" ::: "memory");
                const f32x4 av = *(const GAS f32x4*)(gp + col) * (*(const GAS f32x4*)(mb + D + col) + 1.f);
                v[j] = v[j] * rstd * av + *(const GAS f32x4*)(mb + col);
                st_bf4(H + row * D + col, v[j]); am = fmaxf(am, amax4(v[j])); }
            am = wave_max(am); const float inv = am > 0.f ? 127.f / am : 0.f;
            if (LN == 0) SH[row] = am * (1.f / 127.f);
#pragma unroll
            for (int j = 0; j < 16; ++j) *(unsigned*)(H8 + row * D + 4 * LN + 256 * j) = q4_i8(v[j], inv);
        }
    }
}
__device__ __forceinline__ void quant_rows(Frame& F, const bf16* __restrict__ src, unsigned char* __restrict__ dst, float* __restrict__ sc, int nrows) {
    int lane_ = F.lane; asm volatile("" : "+v"(lane_)); const int LN = lane_;
    const int gw = F.vcu * NWAVES + F.wave, NGW = F.G * NWAVES;
#pragma unroll 1
    for (int n = gw; n < nrows; n += NGW) {
        v4u w[8]; float am = 0.f;
#pragma unroll
        for (int j = 0; j < 8; ++j) w[j] = *(const v4u*)(src + (size_t)n * D + 8 * (LN + 64 * j));
#pragma unroll
        for (int j = 0; j < 8; ++j) {
#pragma unroll
            for (int e = 0; e < 4; ++e) { const unsigned x = w[j][e]; am = fmaxf(am, fmaxf(__builtin_fabsf(__uint_as_float(x << 16)), __builtin_fabsf(__uint_as_float(x & 0xffff0000u)))); } }
        am = wave_max(am); const float inv = am > 0.f ? 127.f / am : 0.f;
        if (LN == 0) sc[n] = am * (1.f / 127.f);
#pragma unroll
        for (int j = 0; j < 8; ++j) { v2u o;
            o.x = q4_i8((f32x4){__uint_as_float(w[j].x << 16), __uint_as_float(w[j].x & 0xffff0000u), __uint_as_float(w[j].y << 16), __uint_as_float(w[j].y & 0xffff0000u)}, inv);
            o.y = q4_i8((f32x4){__uint_as_float(w[j].z << 16), __uint_as_float(w[j].z & 0xffff0000u), __uint_as_float(w[j].w << 16), __uint_as_float(w[j].w & 0xffff0000u)}, inv);
            *(v2u*)(dst + (size_t)n * D + 8 * (LN + 64 * j)) = o; }
    }
}
__device__ __forceinline__ void quant_rows_long(Frame& F, const bf16* __restrict__ src, unsigned char* __restrict__ dst, float* __restrict__ sc, int* __restrict__ csum, int nrows) {
    int lane_ = F.lane; asm volatile("" : "+v"(lane_)); const int LN = lane_;
    const int gw = F.vcu * NWAVES + F.wave, NGW = F.G * NWAVES;
#pragma unroll 1
    for (int n = gw; n < nrows; n += NGW) {
        float am = 0.f;
#pragma unroll 1
        for (int c = 0; c < 4; ++c) { v4u w[8];
#pragma unroll
            for (int j = 0; j < 8; ++j) w[j] = *(const v4u*)(src + (size_t)n * FF + c * 4096 + 8 * (LN + 64 * j));
#pragma unroll
            for (int j = 0; j < 8; ++j)
#pragma unroll
                for (int e = 0; e < 4; ++e) { const unsigned x = w[j][e]; am = fmaxf(am, fmaxf(__builtin_fabsf(__uint_as_float(x << 16)), __builtin_fabsf(__uint_as_float(x & 0xffff0000u)))); } }
        am = wave_max(am); const float inv = am > 0.f ? 127.f / am : 0.f;
        float qs = 0.f;
#pragma unroll 1
        for (int c = 0; c < 4; ++c) { v4u w[8];
#pragma unroll
            for (int j = 0; j < 8; ++j) w[j] = *(const v4u*)(src + (size_t)n * FF + c * 4096 + 8 * (LN + 64 * j));
#pragma unroll
            for (int j = 0; j < 8; ++j) { v2u o; float t[8];
#pragma unroll
                for (int e = 0; e < 4; ++e) { const unsigned x = w[j][e]; t[2 * e] = __builtin_rintf(__uint_as_float(x << 16) * inv); t[2 * e + 1] = __builtin_rintf(__uint_as_float(x & 0xffff0000u) * inv); }
#pragma unroll
                for (int e = 0; e < 8; ++e) qs += t[e];
                o.x = ((unsigned)(int)t[0] & 255u) | (((unsigned)(int)t[1] & 255u) << 8) | (((unsigned)(int)t[2] & 255u) << 16) | ((unsigned)(int)t[3] << 24);
                o.y = ((unsigned)(int)t[4] & 255u) | (((unsigned)(int)t[5] & 255u) << 8) | (((unsigned)(int)t[6] & 255u) << 16) | ((unsigned)(int)t[7] << 24);
                *(v2u*)(dst + (size_t)n * FF + c * 4096 + 8 * (LN + 64 * j)) = o; } }
        qs = wave_sum(qs);
        if (LN == 0) { sc[n] = am * (1.f / 127.f); csum[n] = (int)qs; }
    }
}
__device__ __forceinline__ void requant_u(Frame& F, const bf16* __restrict__ U, unsigned char* __restrict__ U8, float* __restrict__ su) {
    int lane_ = F.lane; asm volatile("" : "+v"(lane_)); const int LN = lane_;
    LAS float* red = (LAS float*)(F.lds + RING_OFF);
    const int q = F.wave & 3, half = F.wave >> 2;
    const size_t coff = (size_t)q * 4096 + 8 * LN;
#define RQ_LOAD(w, r) _Pragma("unroll") for (int j = 0; j < 8; ++j) w[j] = *(const v4u*)(U + (size_t)(r) * FF + coff + 512 * j)
    v4u wc[8], wn[8];
    if (F.vcu < M / 2) RQ_LOAD(wc, 2 * F.vcu + half);
#pragma unroll 1
    for (int pi = F.vcu, p = 0; pi < M / 2; pi += F.G, ++p) { const int r = 2 * pi + half, rn = 2 * (pi + F.G < M / 2 ? pi + F.G : pi) + half;
        float am = 0.f;
#pragma unroll
        for (int j = 0; j < 8; ++j)
#pragma unroll
            for (int e = 0; e < 4; ++e) { const unsigned x = wc[j][e]; am = fmaxf(am, fmaxf(__uint_as_float(x << 16), __uint_as_float(x & 0xffff0000u))); }
        am = wave_max(am);
        if (LN == 0) red[(p & 1) * 8 + F.wave] = am;
        RQ_LOAD(wn, rn);
        __syncthreads();
        { const LAS float* rp = red + (p & 1) * 8 + 4 * half; am = fmaxf(fmaxf(rp[0], rp[1]), fmaxf(rp[2], rp[3])); }
        const float inv = am > 0.f ? 255.f / am : 0.f;
        if (LN == 0 && q == 0) su[r] = am * (1.f / 255.f);
#pragma unroll
        for (int j = 0; j < 8; ++j) { v2u o; int t[8];
#pragma unroll
            for (int e = 0; e < 4; ++e) { const unsigned x = wc[j][e]; t[2 * e] = (int)__builtin_rintf(__uint_as_float(x << 16) * inv) - 128; t[2 * e + 1] = (int)__builtin_rintf(__uint_as_float(x & 0xffff0000u) * inv) - 128; }
            o.x = ((unsigned)t[0] & 255u) | (((unsigned)t[1] & 255u) << 8) | (((unsigned)t[2] & 255u) << 16) | ((unsigned)t[3] << 24);
            o.y = ((unsigned)t[4] & 255u) | (((unsigned)t[5] & 255u) << 8) | (((unsigned)t[6] & 255u) << 16) | ((unsigned)t[7] << 24);
            *(v2u*)(U8 + (size_t)r * FF + coff + 512 * j) = o; }
#pragma unroll
        for (int j = 0; j < 8; ++j) wc[j] = wn[j];
    }
#undef RQ_LOAD
    __syncthreads();
}
__device__ __forceinline__ f32x4 unpk4(v2u w) { return (f32x4){__uint_as_float(w.x << 16), __uint_as_float(w.x & 0xffff0000u), __uint_as_float(w.y << 16), __uint_as_float(w.y & 0xffff0000u)}; }
__device__ __forceinline__ void p6_rows(Frame& F, const Args& a, const float* mod, const bf16* MX, unsigned char* H2, float* S2) {
    int lane_ = F.lane; asm volatile("" : "+v"(lane_)); const int LN = lane_;
    const int gw = F.vcu * NWAVES + F.wave, NGW = F.G * NWAVES;
    for (int r0 = gw * 8; r0 < M; r0 += NGW * 8) {
        const int b = r0 >> 12;
#pragma unroll 1
        for (int r = 0; r < 8; ++r) { const size_t row = (size_t)(r0 + r);
            const float* mb = mod + b * NMOD; LAUNDER_PTR(mb);
            v2u mp[16]; f32x4 xr[16]; float ss = 0.f;
#pragma unroll
            for (int j = 0; j < 16; ++j) mp[j] = *(const v2u*)(MX + row * D + 4 * LN + 256 * j);
#pragma unroll
            for (int j = 0; j < 16; ++j) xr[j] = *(const f32x4*)(a.x + row * D + 4 * LN + 256 * j);
#pragma unroll
            for (int j = 0; j < 16; ++j) ss += sumsq4(unpk4(mp[j]));
            const float rstd = 1.f / sqrtf(wave_sum(ss) * (1.f / D) + NORM_EPS);
            float ss2 = 0.f;
#pragma unroll
            for (int j = 0; j < 16; ++j) { const int col = 4 * LN + 256 * j; if ((j & 3) == 0) asm volatile("" ::: "memory");
                const f32x4 g1 = *(const GAS f32x4*)(mb + 2 * D + col) * *(const f32x4*)(a.g_post_mix + col);
                xr[j] = xr[j] + g1 * (unpk4(mp[j]) * rstd);
                *(f32x4*)(a.out + row * D + col) = xr[j]; ss2 += sumsq4(xr[j]); }
            const float rstd2 = 1.f / sqrtf(wave_sum(ss2) * (1.f / D) + NORM_EPS);
            float am = 0.f;
#pragma unroll
            for (int j = 0; j < 16; ++j) { const int col = 4 * LN + 256 * j; if ((j & 3) == 0) asm volatile("" ::: "memory");
                const f32x4 a2 = *(const f32x4*)(a.g_pre_mlp + col) * (*(const GAS f32x4*)(mb + 4 * D + col) + 1.f);
                xr[j] = xr[j] * rstd2 * a2 + *(const GAS f32x4*)(mb + 3 * D + col); am = fmaxf(am, amax4(xr[j])); }
            am = wave_max(am); const float inv = am > 0.f ? 127.f / am : 0.f;
            if (LN == 0) S2[row] = am * (1.f / 127.f);
#pragma unroll
            for (int j = 0; j < 16; ++j) *(unsigned*)(H2 + row * D + 4 * LN + 256 * j) = q4_i8(xr[j], inv);
        }
    }
}
__device__ __forceinline__ void p9_rows(Frame& F, const Args& a, const float* mod, const bf16* FB) {
    int lane_ = F.lane; asm volatile("" : "+v"(lane_)); const int LN = lane_;
    const int gw = F.vcu * NWAVES + F.wave, NGW = F.G * NWAVES;
    for (int r0 = gw * 8; r0 < M; r0 += NGW * 8) {
        const int b = r0 >> 12;
#pragma unroll 1
        for (int r = 0; r < 8; ++r) { const size_t row = (size_t)(r0 + r);
            const float* mb = mod + b * NMOD; LAUNDER_PTR(mb);
            v2u mp[16]; f32x4 xr[16]; float ss = 0.f;
#pragma unroll
            for (int j = 0; j < 16; ++j) mp[j] = *(const v2u*)(FB + row * D + 4 * LN + 256 * j);
#pragma unroll
            for (int j = 0; j < 16; ++j) xr[j] = *(const f32x4*)(a.out + row * D + 4 * LN + 256 * j);
#pragma unroll
            for (int j = 0; j < 16; ++j) ss += sumsq4(unpk4(mp[j]));
            const float rstd = 1.f / sqrtf(wave_sum(ss) * (1.f / D) + NORM_EPS);
#pragma unroll
            for (int j = 0; j < 16; ++j) { const int col = 4 * LN + 256 * j; if ((j & 3) == 0) asm volatile("" ::: "memory");
                const f32x4 g2 = *(const GAS f32x4*)(mb + 5 * D + col) * *(const f32x4*)(a.g_post_mlp + col);
                *(f32x4*)(a.out + row * D + col) = xr[j] + g2 * (unpk4(mp[j]) * rstd); }
        }
    }
}

#ifndef P7_NT
#define P7_NT false
#endif
#ifndef P8_WGM
#define P8_WGM 8
#endif
#ifndef SB_EARLY
#define SB_EARLY 1
#endif
__global__ void __launch_bounds__(NWAVES * 64, 2) fwd_kernel(Args args) {
    extern __shared__ __attribute__((aligned(16))) unsigned char lds[];
    Frame F;
    F.lds = (LAS unsigned char*)lds;
    F.tid = threadIdx.x; F.lane = F.tid & 63; F.wave = __builtin_amdgcn_readfirstlane(F.tid >> 6);
    F.G = gridDim.x; { const int bx = blockIdx.x; F.vcu = (F.G % 8 == 0) ? (bx % 8) * (F.G / 8) + bx / 8 : bx; }
    unsigned char* ws = args.ws;
    unsigned* ctl = (unsigned*)(ws + WS_CTL);
    float* mod = (float*)(ws + WS_MOD); float* cosT = (float*)(ws + WS_COS); float* sinT = (float*)(ws + WS_SIN);
    bf16* W1 = (bf16*)(ws + WS_W1); bf16* WPS = (bf16*)(ws + WS_WPS); bf16* WPB = (bf16*)(ws + WS_WPB); bf16* WO = (bf16*)(ws + WS_WO); bf16* WF1 = (bf16*)(ws + WS_WF1); bf16* WF2 = (bf16*)(ws + WS_WF2);
    bf16* BA = (bf16*)(ws + WS_A); bf16* BB = (bf16*)(ws + WS_B); unsigned char* H8 = ws + WS_H8; unsigned char* W8G = ws + WS_W8G; unsigned char* W8F = ws + WS_W8F;
    float* SH = (float*)(ws + WS_SH); float* S2 = (float*)(ws + WS_S2); float* SG = (float*)(ws + WS_SG); float* SF = (float*)(ws + WS_SF);
    unsigned char* W8O = ws + WS_W8O; unsigned char* U8 = ws + WS_U8; float* SU = (float*)(ws + WS_SU); float* SO = (float*)(ws + WS_SO); int* CO = (int*)(ws + WS_CO);
    bf16* QA = (bf16*)(ws + WS_C); bf16* KA = (bf16*)(ws + WS_C + 64 * MiB); bf16* VA = (bf16*)(ws + WS_C + 80 * MiB); bf16* QB = (bf16*)(ws + WS_C + 96 * MiB);
    bf16* KB = (bf16*)(ws + WS_C + 160 * MiB); bf16* VB = (bf16*)(ws + WS_C + 224 * MiB); bf16* GT = (bf16*)(ws + WS_C + 288 * MiB); bf16* UB = (bf16*)(ws + WS_C);
    bf16* ATT_SWA = BB; bf16* ATT_SB = BB + (size_t)M * 2048;
    for (int u = F.tid; u < (LDS_BYTES - LDSCTL_OFF) / 4; u += NWAVES * 64) ((LAS unsigned*)(F.lds + LDSCTL_OFF))[u] = 0u;
    __syncthreads();
    XcdBarrier bar = xcd_barrier_post(ctl + CW_BAR, (volatile LAS unsigned*)(F.lds + MISC_OFF) + 8);

    const int lo = args.ph_lo, hi = args.ph_hi;
#define IN(k) (lo <= (k) && (k) < hi)
#define BOTH(k) (IN(k) && IN((k) + 1))
    for (int rep_ = 0; rep_ < ((DUP_PHASE == 0) ? 2 : 1); ++rep_) if (IN(0)) {
        if (rep_) xcd_barrier(bar);
    {
        for (int sr_ = 0; sr_ < ((DUP_SUB == 3) ? 2 : 1); ++sr_) p0_gemv(F, args, mod);
        p0_rope_table(F, cosT, sinT);
        {
            constexpr int NSLAB = 1920;
#define SLAB_DECODE(sd, s_) do { int q_ = (s_); \
                if (q_ < 128) { sd = SDesc{args.w_in, W8G, SG, D_IN, 16 * q_, 0, 1}; break; } q_ -= 128; \
                if (q_ < 256) { sd = SDesc{args.w_in, W8G, SG, D_IN, 3072 + 16 * q_, 2048 - 3072, 0}; break; } q_ -= 256; \
                if (q_ < 512) { sd = SDesc{args.w_bg, W8G, SG, NG, 16 * q_, 6144, 0}; break; } q_ -= 512; \
                sd = SDesc{args.w_f1, W8F, SF, FF, 16 * q_, 0, 0}; } while (0)
            int stid = F.tid; asm volatile("" : "+v"(stid)); const int slane = stid & 63, swave = __builtin_amdgcn_readfirstlane(stid >> 6);
            const int nmine = 7 + ((F.G == 256 && F.vcu >= 128) ? 1 : 0);
            auto slab_of = [&](int i) -> int { if (F.G == 256) return i < 7 ? 256 * i + F.vcu : 1792 + F.vcu - 128; return F.vcu + i * F.G; };
            auto have = [&](int i) -> bool { if (F.G == 256) return i < nmine; return F.vcu + i * F.G < NSLAB; };
            for (int sr_ = 0; sr_ < ((DUP_SUB == 1) ? 2 : 1); ++sr_) if (have(0)) {
                SDesc sc_; SLAB_DECODE(sc_, slab_of(0)); f32x4 va0[8], vb0[8], va1[8], vb1[8]; slab_load<0>(sc_, va0, vb0, stid); slab_load<1>(sc_, va1, vb1, stid);
                for (int i = 0;; ++i) {
                    const bool more = have(i + 1); SDesc sn_ = sc_; if (more) SLAB_DECODE(sn_, slab_of(i + 1));
                    slab_stage<0>(F.lds, va0, vb0, stid); asm volatile("" ::: "memory");
                    if (more) slab_load<0>(sn_, va0, vb0, stid);
                    asm volatile("" ::: "memory");
                    slab_stage<1>(F.lds, va1, vb1, stid); asm volatile("" ::: "memory");
                    if (more) slab_load<1>(sn_, va1, vb1, stid);
                    __syncthreads();
                    slab_quant(sc_, F.lds, swave, slane);
                    __syncthreads();
                    if (!more) break;
                    sc_ = sn_;
                }
            }
#undef SLAB_DECODE
            {
                unsigned* kcnt = ctl + CW_KS; unsigned* cmx = (unsigned*)(ws + WS_CMX);
                int it = F.vcu;
                if (it < 1024) {
                    SDesc sc_{args.w_f2 + (size_t)(it & 3) * 4096 * D, W8O, SO, D, 16 * (it >> 2), 0, 0};
                    f32x4 va0[8], vb0[8], va1[8], vb1[8]; slab_load<0>(sc_, va0, vb0, stid); slab_load<1>(sc_, va1, vb1, stid);
                    for (;;) {
                        const int cs = it >> 2, q = it & 3, itn = it + F.G; const bool more = itn < 1024;
                        slab_stage<0>(F.lds, va0, vb0, stid); slab_stage<1>(F.lds, va1, vb1, stid);
                        __syncthreads();
                        {
                            unsigned got = 0u;
#pragma unroll 1
                            for (int rr = 0; rr < 2; ++rr) { const int n = 2 * swave + rr; float am = 0.f;
#pragma unroll
                                for (int j = 0; j < 8; ++j) { const v4u w = *(const LAS v4u*)(F.lds + n * SLAB_PITCH + 16 * (slane + 64 * j));
#pragma unroll
                                    for (int e = 0; e < 4; ++e) { const unsigned x = w[e]; am = fmaxf(am, fmaxf(__builtin_fabsf(__uint_as_float(x << 16)), __builtin_fabsf(__uint_as_float(x & 0xffff0000u)))); } }
                                am = wave_max(am);
                                if (slane == 0) got |= atomicMax(cmx + 16 * cs + n, __float_as_uint(am)); }
                            asm volatile("" :: "v"(got));
                        }
                        asm volatile("s_waitcnt vmcnt(0)" ::: "memory");
                        __syncthreads();
                        if (stid == 0) { (void)xb_add(&kcnt[cs], 1u); XB_SPIN(xb_ld(&kcnt[cs]) < 4u, ctl + CW_BAR); }
                        __syncthreads();
                        const unsigned mb0 = xb_ld(cmx + 16 * cs + 2 * swave), mb1 = xb_ld(cmx + 16 * cs + 2 * swave + 1);
                        SDesc sn_ = sc_;
                        if (more) { sn_ = SDesc{args.w_f2 + (size_t)(itn & 3) * 4096 * D, W8O, SO, D, 16 * (itn >> 2), 0, 0}; slab_load<0>(sn_, va0, vb0, stid); slab_load<1>(sn_, va1, vb1, stid); }
                        ks_quant(F.lds, W8O, SO, CO, cs, q, mb0, mb1, swave, slane);
                        __syncthreads();
                        if (!more) break;
                        it = itn; sc_ = sn_;
                    }
                }
            }
        }
        LAS float* scr = (LAS float*)(F.lds + F.wave * 16640);
        const int gw = F.vcu * NWAVES + F.wave, NGW = F.G * NWAVES;
        constexpr int I_IN = (D / 64) * 48, I_PS = (2048 / 64) * (D / 64), I_O = (D / 64) * (D / 64);
        constexpr int NITEMS = I_IN + 2 * I_PS + I_O;
#define P0_DECODE(t, it) do { int r_ = (it); \
            if (r_ < I_IN) { const int kb_ = r_ / 48, nb_ = r_ % 48; t = TDesc{args.w_in, W1, D, D_IN, 0, 2560, kb_ * (D_IN / 64) + (nb_ < 16 ? 32 + nb_ : 96 + nb_), 0}; break; } r_ -= I_IN; \
            if (r_ < I_PS) { t = TDesc{args.w_ps, WPS, 2048, D, 0, 0, r_, 0}; break; } r_ -= I_PS; \
            if (r_ < I_PS) { t = TDesc{args.w_pb, WPB, 2048, D, 0, 0, r_, 0}; break; } r_ -= I_PS; \
            t = TDesc{args.w_out, WO, D, D, 0, 0, r_, 0}; } while (0)
        for (int sr_ = 0; sr_ < ((DUP_SUB == 2) ? 2 : 1); ++sr_) { int it = gw;
        if (it < NITEMS) {
            TDesc tc; P0_DECODE(tc, it); f32x4 vc[16]; p0_tr_load(tc, vc, F.lane);
            for (;;) {
                const int itn = it + NGW; const bool more = itn < NITEMS;
                TDesc tn = tc; f32x4 vn[16];
                if (more) { P0_DECODE(tn, itn); p0_tr_load(tn, vn, F.lane); }
                p0_tr_store(tc, vc, scr, F.lane);
                if (!more) break;
                tc = tn; it = itn;
#pragma unroll
                for (int i = 0; i < 16; ++i) vc[i] = vn[i];
            }
        } }
#undef P0_DECODE
    }
        if (BOTH(0)) xcd_barrier(bar);
    }
    for (int rep_ = 0; rep_ < ((DUP_PHASE == 1) ? 2 : 1); ++rep_) if (IN(1)) {
        if (rep_) xcd_barrier(bar);
    p1_rows(F, args, mod, BA, H8, SH);
        if (BOTH(1)) xcd_barrier(bar);
    }
    for (int rep_ = 0; rep_ < ((DUP_PHASE == 2) ? 2 : 1); ++rep_) if (IN(2)) {
        if (rep_) xcd_barrier(bar);
    {
        { pg8::Gemm g{BA, W1, BA, W1, M, NB16, D}; pg8::StaticOrder S; S.init(M, NB16, F.G, (int)blockIdx.x);
          pg8::EpiProj E{KA, VA, VB, cosT, sinT};
          pg8::gemm_phase<pg8::EpiProj, pg8::StaticOrder, true, true>(F.lds + RING_OFF, g, S, E); }
        { pg8::Gemm g{(const bf16*)H8, (const bf16*)W8G, (const bf16*)H8, (const bf16*)W8G, M, NI8, D / 2}; pg8::StaticOrder S; S.init(M, NI8, F.G, (int)blockIdx.x);
          pg8::EpiI8Proj E{QA, QB, KB, GT, cosT, sinT, args.b_bg, SH, SG, 0.12751743f  };
          pg8::gemm_phase<pg8::EpiI8Proj, pg8::StaticOrder, true, true, true>(F.lds + RING_OFF, g, S, E); }
    }
        if (BOTH(2)) xcd_barrier(bar);
    }
    for (int rep_ = 0; rep_ < ((DUP_PHASE == 3) ? 2 : 1); ++rep_) if (IN(3)) {
        if (rep_) xcd_barrier(bar);
    {
        int atid = F.tid; asm volatile("" : "+v"(atid)); const int alane = atid & 63, awave = __builtin_amdgcn_readfirstlane(atid >> 6);
        const int nq = (F.vcu < 256) ? (256 - F.vcu + F.G - 1) / F.G : 0, ntot = 8 * nq;
#define P3_GET(idx, u, md) do { const int i_ = (idx); if (i_ < 4 * nq) { const int quad = F.vcu + (i_ >> 2) * F.G, j = i_ & 3, bh = quad >> 2, r = quad & 3, hh = bh & 15; \
            (u) = att::AUnit{QB + hh * HD, KB + hh * HD, VB + hh * HD, ATT_SB + hh * HD, 2048, 2048, 2048, bh >> 4, (j == 0) ? 15 - r : (j == 1) ? 11 - r : (j == 2) ? 4 + r : r, 0.f, 0, args.sinks}; (md) = 1; } \
          else { const int i2_ = i_ - 4 * nq, quad = F.vcu + (i2_ >> 2) * F.G, id = quad * 4 + (i2_ & 3), g_ = (id >> 6) & 3; \
            (u) = att::AUnit{QA + 4 * g_ * HD, KA + g_ * HD, VA + g_ * HD, ATT_SWA + 4 * g_ * HD, 2048, 512, 2048, id >> 8, id & 63, 0.f, 1, args.sinks + 4 * g_}; (md) = 0; } } while (0)
        if (ntot > 0) {
            att::AUnit cur, nxt; int mcur = 0, mnxt = 0; att::bf16x8 qf[8]; att::u32x4 kr0, kr1, vr0, vr1;
            P3_GET(0, cur, mcur); nxt = cur; att::attn_prefetch(cur, qf, kr0, kr1, vr0, vr1, atid, awave, alane);
            for (int idx = 0; idx < ntot; ++idx) { const bool hn = idx + 1 < ntot; if (hn) P3_GET(idx + 1, nxt, mnxt);
                if (mcur) att::attn_unit<1, (SB_EARLY != 0)>(F.lds, cur, hn, nxt, qf, kr0, kr1, vr0, vr1, atid, awave, alane);
                else      att::attn_unit<0, false>(F.lds, cur, hn, nxt, qf, kr0, kr1, vr0, vr1, atid, awave, alane);
                cur = nxt; mcur = mnxt; }
        }
#undef P3_GET
    }
        if (BOTH(3)) xcd_barrier(bar);
    }
    for (int rep_ = 0; rep_ < ((DUP_PHASE == 4) ? 2 : 1); ++rep_) if (IN(4)) {
        if (rep_) xcd_barrier(bar);
    {
        pg8::Gemm g{ATT_SWA, WPS, ATT_SB, WPB, M, D, 2048}; pg8::PairOrder S; S.S.init(M, D, F.G, (int)blockIdx.x);
        pg8::EpiMix E{BA, (const unsigned char*)GT};
        pg8::gemm_phase<pg8::EpiMix, pg8::PairOrder, true, true>(F.lds + RING_OFF, g, S, E);
    }
        if (BOTH(4)) xcd_barrier(bar);
    }
    for (int rep_ = 0; rep_ < ((DUP_PHASE == 5) ? 2 : 1); ++rep_) if (IN(5)) {
        if (rep_) xcd_barrier(bar);
    {
        pg8::Gemm g{BA, WO, BA, WO, M, D, D}; pg8::StaticOrder S; S.init(M, D, F.G, (int)blockIdx.x);
        pg8::EpiSimple<0> E{BB, D};
        pg8::gemm_phase<pg8::EpiSimple<0>, pg8::StaticOrder, true, true>(F.lds + RING_OFF, g, S, E);
    }
        if (BOTH(5)) xcd_barrier(bar);
    }
    for (int rep_ = 0; rep_ < ((DUP_PHASE == 6) ? 2 : 1); ++rep_) if (IN(6)) {
        if (rep_) xcd_barrier(bar);
    p6_rows(F, args, mod, BB, (unsigned char*)BA, S2);
        if (BOTH(6)) xcd_barrier(bar);
    }
#ifndef IDLE_US
#define IDLE_US 0
#endif
    if (IDLE_US > 0 && IN(7)) { const unsigned long long t0_ = __builtin_amdgcn_s_memrealtime(); while (__builtin_amdgcn_s_memrealtime() - t0_ < (unsigned long long)IDLE_US * 100ull) __builtin_amdgcn_s_sleep(127); }
    for (int rep_ = 0; rep_ < ((DUP_PHASE == 7) ? 2 : 1); ++rep_) if (IN(7)) {
        if (rep_) xcd_barrier(bar);
    {
        pg8::Gemm g{BA, (const bf16*)W8F, BA, (const bf16*)W8F, M, FF, D / 2}; pg8::StaticOrder S; S.init(M, FF, F.G, (int)blockIdx.x);
        pg8::EpiRelu2I8 E{UB, FF, S2, SF};
        pg8::gemm_phase<pg8::EpiRelu2I8, pg8::StaticOrder, true, true, true>(F.lds + RING_OFF, g, S, E);
    }
        if (BOTH(7)) xcd_barrier(bar);
    }
    for (int rep_ = 0; rep_ < ((DUP_PHASE == 8) ? 2 : 1); ++rep_) if (IN(8)) {
        if (rep_) xcd_barrier(bar);
    {
        requant_u(F, UB, U8, SU);
        xcd_barrier(bar);
        pg8::Gemm g{(const bf16*)U8, (const bf16*)W8O, (const bf16*)U8, (const bf16*)W8O, M, D, FF / 2}; pg8::StaticOrder S; S.init(M, D, F.G, (int)blockIdx.x, P8_WGM);
        pg8::EpiFfOutI8 E{BB, D, SU, SO, CO};
        pg8::gemm_phase<pg8::EpiFfOutI8, pg8::StaticOrder, true, true, true>(F.lds + RING_OFF, g, S, E);
    }
        if (BOTH(8)) xcd_barrier(bar);
    }
    for (int rep_ = 0; rep_ < ((DUP_PHASE == 9) ? 2 : 1); ++rep_) if (IN(9)) {
        if (rep_) xcd_barrier(bar);
    p9_rows(F, args, mod, BB);
        if (BOTH(9)) xcd_barrier(bar);
    }
#undef IN
#undef BOTH
}

extern "C" void kernel_launch(void* const* d_in, const int* in_sizes, int n_in, void* d_out, int out_size, void* d_ws, size_t ws_size, hipStream_t stream) {
    static int grid = 0;
    if (grid == 0) {
        if (n_in != 17 || in_sizes[0] != M * D || out_size != M * D || ws_size < WS_END) { fprintf(stderr, "kernel_launch: unexpected shapes / workspace (n_in %d, in0 %d, out %d, ws %zu, need %zu); nothing launched\n", n_in, n_in > 0 ? in_sizes[0] : -1, out_size, ws_size, (size_t)WS_END); grid = -1; return; }
        int dev = 0, cus = 0, per_cu = 0;
        if (hipGetDevice(&dev) != hipSuccess || hipDeviceGetAttribute(&cus, hipDeviceAttributeMultiprocessorCount, dev) != hipSuccess) { fprintf(stderr, "kernel_launch: device query failed\n"); grid = -1; return; }
        if (hipFuncSetAttribute((const void*)fwd_kernel, hipFuncAttributeMaxDynamicSharedMemorySize, LDS_BYTES) != hipSuccess) { fprintf(stderr, "kernel_launch: hipFuncSetAttribute failed\n"); grid = -1; return; }
        if (hipOccupancyMaxActiveBlocksPerMultiprocessor(&per_cu, (const void*)fwd_kernel, NWAVES * 64, LDS_BYTES) != hipSuccess || per_cu < 1) { fprintf(stderr, "kernel_launch: occupancy query says %d blocks per CU\n", per_cu); }
        (void)hipGetLastError();
        grid = cus & ~7;
    }
    if (grid < 0) return;
    if (hipMemsetAsync((char*)d_ws + WS_CTL, 0, CTL_ZERO_BYTES, stream) != hipSuccess) { fprintf(stderr, "kernel_launch: memset failed\n"); return; }
    Args a{};
    a.x = (const float*)d_in[0]; a.c = (const float*)d_in[1]; a.w_ada = (const float*)d_in[2]; a.b_ada = (const float*)d_in[3]; a.g_pre_mix = (const float*)d_in[4]; a.g_post_mix = (const float*)d_in[5];
    a.g_pre_mlp = (const float*)d_in[6]; a.g_post_mlp = (const float*)d_in[7]; a.w_in = (const float*)d_in[8]; a.sinks = (const float*)d_in[9]; a.w_bg = (const float*)d_in[10]; a.b_bg = (const float*)d_in[11];
    a.w_ps = (const float*)d_in[12]; a.w_pb = (const float*)d_in[13]; a.w_out = (const float*)d_in[14]; a.w_f1 = (const float*)d_in[15]; a.w_f2 = (const float*)d_in[16];
    a.out = (float*)d_out; a.ws = (unsigned char*)d_ws;
#ifndef MK_N_LAUNCHES
#define MK_N_LAUNCHES 1
#ifndef DUP_PHASE
#define DUP_PHASE -1
#endif
#endif
    constexpr int NPH = 10;
    for (int li = 0; li < MK_N_LAUNCHES; ++li) {
        a.ph_lo = (MK_N_LAUNCHES == 1) ? 0 : li; a.ph_hi = (MK_N_LAUNCHES == 1) ? NPH : li + 1;
        hipLaunchKernelGGL(fwd_kernel, dim3(grid), dim3(NWAVES * 64), LDS_BYTES, stream, a);
        const hipError_t le = hipPeekAtLastError();
        if (le != hipSuccess) { fprintf(stderr, "kernel_launch: launch failed: %s\n", hipGetErrorName(le)); break; }
    }
}
```

```cpp
#include <hip/hip_runtime.h>
#include <cstdio>
#include <cstdint>
#define MK_N_LAUNCHES 1
#ifndef DUP_PHASE
#define DUP_PHASE -1
#endif
#ifndef DUP_SUB
#define DUP_SUB 0
#endif

namespace pg8 {
#define PG8_LAS __attribute__((address_space(3)))
typedef unsigned short bf16_t;
typedef short bf16x8 __attribute__((ext_vector_type(8)));
typedef float f32x4 __attribute__((ext_vector_type(4)));
typedef unsigned u32x4 __attribute__((ext_vector_type(4)));
typedef int v4i_t __attribute__((ext_vector_type(4)));
typedef unsigned u32x2 __attribute__((ext_vector_type(2)));
constexpr int BM = 256, BK = 64, HALF = 128, HTB = HALF * BK * 2  , STAGE_BYTES = 8 * HTB, NXCD = 8, WGM = 8;

__host__ __device__ __forceinline__ int lds_byte(int r, int c) { const int st = (r >> 4) * 2 + (c >> 5), rr = r & 15, cc = c & 31, ob = rr * 64 + cc * 2; return st * 1024 + (ob ^ (((ob >> 9) & 1) << 5)); }
__host__ __device__ __forceinline__ void stage_rc(int b, int& R, int& C) { const int st = b / 1024, sb = b % 1024, swz = sb ^ (((sb >> 9) & 1) << 5); R = (st >> 1) * 16 + swz / 64; C = (st & 1) * 32 + (swz % 64) / 2; }
__host__ __device__ __forceinline__ int perm32(int rho) { const int n = rho >> 4, i = rho & 15; return 8 * (i >> 2) + 4 * n + (i & 3); }

struct Unit { int pm, pn, kind; };
struct Gemm { const bf16_t* A0; const bf16_t* B0; const bf16_t* A1; const bf16_t* B1; int M, N, K; };

struct StaticOrder {
    int nM, nN, nwg, G, c, wgm;
    __host__ __device__ void init(int M, int N, int G_, int c_, int wgm_ = WGM) { nM = M / BM; nN = N / BM; nwg = nM * nN; G = G_; c = c_; wgm = wgm_; }
    __host__ __device__ bool next(int i, Unit& u) const {
        const long L = (long)i * G + c; if (L >= nwg) return false;
        int wgid = (int)L; { const int q = nwg / NXCD, r = nwg % NXCD, xcd = wgid % NXCD, off = wgid / NXCD; wgid = (xcd < r ? xcd * (q + 1) : r * (q + 1) + (xcd - r) * q) + off; }
        const int nig = wgm * nN, gid = wgid / nig, fm = gid * wgm, gsz = (nM - fm) < wgm ? (nM - fm) : wgm;
        u.pm = fm + ((wgid % nig) % gsz); u.pn = (wgid % nig) / gsz; u.kind = 0; return true;
    }
    __device__ __forceinline__ void a_ready(const Unit&) const {}
    __device__ __forceinline__ void done(const Unit&) const {}
};
struct PairOrder {
    StaticOrder S;
    __host__ __device__ bool next(int i, Unit& u) const { if (!S.next(i >> 1, u)) return false; u.kind = i & 1; return true; }
    __device__ __forceinline__ void a_ready(const Unit&) const {}
    __device__ __forceinline__ void done(const Unit&) const {}
};

typedef float f32x2_t __attribute__((ext_vector_type(2))); typedef __bf16 bf16x2_t __attribute__((ext_vector_type(2)));
__device__ __forceinline__ unsigned cvt_pk_bf16(float lo, float hi) { f32x2_t v = {lo, hi}; bf16x2_t b = __builtin_convertvector(v, bf16x2_t); return __builtin_bit_cast(unsigned, b); }
__device__ __forceinline__ f32x4 bf_lo4(unsigned a, unsigned b) { return (f32x4){__uint_as_float(a << 16), __uint_as_float(a & 0xffff0000u), __uint_as_float(b << 16), __uint_as_float(b & 0xffff0000u)}; }
__device__ __forceinline__ u32x4 pack8(f32x4 v0, f32x4 v1) { u32x4 w; w.x = cvt_pk_bf16(v0[0], v0[1]); w.y = cvt_pk_bf16(v0[2], v0[3]); w.z = cvt_pk_bf16(v1[0], v1[1]); w.w = cvt_pk_bf16(v1[2], v1[3]); return w; }

template <int ACT  , bool NT = false> struct EpiSimple {
    static constexpr bool PERM = true, AFTER_DRAIN = false, CHAIN = false;
    __device__ __forceinline__ bool keep_acc(const Unit&) const { return false; }
    bf16_t* O; int ldc;
    __device__ __forceinline__ void operator()(const f32x4 (&acc)[2][2][4][2], const Unit& u, int wr, int wc, int fr, int fq) const {
        const int row0 = u.pm * BM + wr * 64 + fr, col0 = u.pn * BM + wc * 32 + 8 * fq;
#pragma unroll
        for (int ai = 0; ai < 2; ++ai)
#pragma unroll
            for (int m = 0; m < 4; ++m) { bf16_t* rowp = O + (size_t)(row0 + ai * HALF + m * 16) * ldc + col0;
#pragma unroll
                for (int bj = 0; bj < 2; ++bj) { f32x4 v0 = acc[ai][bj][m][0], v1 = acc[ai][bj][m][1];
                    if (ACT == 1) {
#pragma unroll
                        for (int j = 0; j < 4; ++j) { const float a = fmaxf(v0[j], 0.f), b = fmaxf(v1[j], 0.f); v0[j] = a * a; v1[j] = b * b; } }
                    if (NT) __builtin_nontemporal_store(pack8(v0, v1), (u32x4*)(rowp + bj * HALF)); else *(u32x4*)(rowp + bj * HALF) = pack8(v0, v1); } }
    }
};

struct EpiProj {
    static constexpr bool PERM = true, AFTER_DRAIN = false, CHAIN = false;
    __device__ __forceinline__ bool keep_acc(const Unit&) const { return false; }
    bf16_t *KA, *VA, *VB; const float* cosT; const float* sinT;
    __device__ __forceinline__ void operator()(const f32x4 (&acc)[2][2][4][2], const Unit& u, int wr, int wc, int fr, int fq) const {
        const int pn = u.pn, row0 = u.pm * BM + wr * 64 + fr, cl = wc * 32 + 8 * fq;
        bf16_t* base; int ld, colt; bool rope = false;
        if (pn < 2)       { base = KA; ld = 512;  colt = pn * 256; rope = true; }
        else if (pn < 4)  { base = VA; ld = 512;  colt = (pn - 2) * 256; }
        else              { base = VB; ld = 2048; colt = (pn - 4) * 256; }
        if (rope) {
#pragma unroll
            for (int ai = 0; ai < 2; ++ai)
#pragma unroll
                for (int m = 0; m < 4; ++m) { const int row = row0 + ai * HALF + m * 16; const int pos = row & 4095;
                    const f32x4 c4 = *(const f32x4*)(cosT + pos * 64 + (cl >> 1)), s4 = *(const f32x4*)(sinT + pos * 64 + (cl >> 1));
                    bf16_t* rowp = base + (size_t)row * ld + colt + cl;
#pragma unroll
                    for (int bj = 0; bj < 2; ++bj) { const f32x4 x1 = acc[ai][bj][m][0], x2 = acc[ai][bj][m][1];
                        *(u32x4*)(rowp + bj * HALF) = pack8(x1 * c4 - x2 * s4, x2 * c4 + x1 * s4); } }
        } else {
#pragma unroll
            for (int ai = 0; ai < 2; ++ai)
#pragma unroll
                for (int m = 0; m < 4; ++m) { bf16_t* rowp = base + (size_t)(row0 + ai * HALF + m * 16) * ld + colt + cl;
#pragma unroll
                    for (int bj = 0; bj < 2; ++bj) *(u32x4*)(rowp + bj * HALF) = pack8(acc[ai][bj][m][0], acc[ai][bj][m][1]); }
        }
    }
};

__device__ __forceinline__ f32x4 i2f4(f32x4 a) { const v4i_t i = __builtin_bit_cast(v4i_t, a); return (f32x4){(float)i[0], (float)i[1], (float)i[2], (float)i[3]}; }
struct EpiI8Proj {
    static constexpr bool PERM = true, AFTER_DRAIN = false, CHAIN = false;
    __device__ __forceinline__ bool keep_acc(const Unit&) const { return false; }
    bf16_t *QA, *QB, *KB, *GT; const float* cosT; const float* sinT; const float* gbias; const float* sa; const float* sb; float qscale;
    __device__ __forceinline__ void operator()(const f32x4 (&acc)[2][2][4][2], const Unit& u, int wr, int wc, int fr, int fq) const {
        const int pn = u.pn, row0 = u.pm * BM + wr * 64 + fr, cl = wc * 32 + 8 * fq;
        f32x4 sv[2][2];
#pragma unroll
        for (int bj = 0; bj < 2; ++bj)
#pragma unroll
            for (int n = 0; n < 2; ++n) sv[bj][n] = *(const f32x4*)(sb + pn * 256 + bj * HALF + cl + 4 * n);
        if (pn < 8) {
            const int colt = pn * 256;
#pragma unroll
            for (int ai = 0; ai < 2; ++ai)
#pragma unroll
                for (int m = 0; m < 4; ++m) { const int row = row0 + ai * HALF + m * 16; const int pos = row & 4095; const float sr = sa[row] * qscale;
                    const f32x4 c4 = *(const f32x4*)(cosT + pos * 64 + (cl >> 1)), s4 = *(const f32x4*)(sinT + pos * 64 + (cl >> 1));
                    bf16_t* rowp = QA + (size_t)row * 2048 + colt + cl;
#pragma unroll
                    for (int bj = 0; bj < 2; ++bj) { const f32x4 x1 = i2f4(acc[ai][bj][m][0]) * (sv[bj][0] * sr), x2 = i2f4(acc[ai][bj][m][1]) * (sv[bj][1] * sr);
                        *(u32x4*)(rowp + bj * HALF) = pack8(x1 * c4 - x2 * s4, x2 * c4 + x1 * s4); } }
        } else if (pn < 24) {
            const bool isq = pn < 16; const int colt = (isq ? pn - 8 : pn - 16) * 256; bf16_t* basep = isq ? QB : KB; const float qs = isq ? qscale : 1.f;
#pragma unroll
            for (int ai = 0; ai < 2; ++ai)
#pragma unroll
                for (int m = 0; m < 4; ++m) { const int row = row0 + ai * HALF + m * 16; const float sr = sa[row] * qs; bf16_t* rowp = basep + (size_t)row * 2048 + colt + cl;
#pragma unroll
                    for (int bj = 0; bj < 2; ++bj) *(u32x4*)(rowp + bj * HALF) = pack8(i2f4(acc[ai][bj][m][0]) * (sv[bj][0] * sr), i2f4(acc[ai][bj][m][1]) * (sv[bj][1] * sr)); }
        } else {
            const int colt = (pn - 24) * 256;
            f32x4 bv[2][2];
#pragma unroll
            for (int bj = 0; bj < 2; ++bj)
#pragma unroll
                for (int n = 0; n < 2; ++n) { bv[bj][n] = *(const f32x4*)(gbias + colt + bj * HALF + cl + 4 * n) * -1.44269504089f; sv[bj][n] = sv[bj][n] * -1.44269504089f; }
            unsigned char* tp = (unsigned char*)GT + ((size_t)(u.pm * 32 + (pn - 24)) << 16) + (wr * 4 + wc) * 8192 + (fr + 16 * fq) * 16;
#pragma unroll
            for (int ai = 0; ai < 2; ++ai)
#pragma unroll
                for (int m = 0; m < 4; ++m) { const int row = row0 + ai * HALF + m * 16; const float sr = sa[row]; u32x4 w4;
#pragma unroll
                    for (int bj = 0; bj < 2; ++bj) { f32x4 v0 = i2f4(acc[ai][bj][m][0]) * (sv[bj][0] * sr) + bv[bj][0], v1 = i2f4(acc[ai][bj][m][1]) * (sv[bj][1] * sr) + bv[bj][1];
#pragma unroll
                        for (int j = 0; j < 4; ++j) { v0[j] = __builtin_rintf(255.f * __builtin_amdgcn_rcpf(1.f + __builtin_amdgcn_exp2f(v0[j]))); v1[j] = __builtin_rintf(255.f * __builtin_amdgcn_rcpf(1.f + __builtin_amdgcn_exp2f(v1[j]))); }
                        const unsigned wx = (unsigned)v0[0] | ((unsigned)v0[1] << 8) | ((unsigned)v0[2] << 16) | ((unsigned)v0[3] << 24), wy = (unsigned)v1[0] | ((unsigned)v1[1] << 8) | ((unsigned)v1[2] << 16) | ((unsigned)v1[3] << 24);
                        if (bj == 0) { w4.x = wx; w4.y = wy; } else { w4.z = wx; w4.w = wy; } }
                    *(u32x4*)(tp + (ai * 4 + m) * 1024) = w4; }
        }
    }
};
struct EpiFfOutI8 {
    static constexpr bool PERM = true, AFTER_DRAIN = false, CHAIN = false;
    __device__ __forceinline__ bool keep_acc(const Unit&) const { return false; }
    bf16_t* O; int ldc; const float* sa; const float* sb; const int* cs;
    __device__ __forceinline__ void operator()(const f32x4 (&acc)[2][2][4][2], const Unit& u, int wr, int wc, int fr, int fq) const {
        const int row0 = u.pm * BM + wr * 64 + fr, col0 = u.pn * BM + wc * 32 + 8 * fq;
        f32x4 sv[2][2]; v4i_t cv[2][2];
#pragma unroll
        for (int bj = 0; bj < 2; ++bj)
#pragma unroll
            for (int n = 0; n < 2; ++n) { sv[bj][n] = *(const f32x4*)(sb + col0 + bj * HALF + 4 * n); cv[bj][n] = *(const v4i_t*)(cs + col0 + bj * HALF + 4 * n) * 128; }
#pragma unroll
        for (int ai = 0; ai < 2; ++ai)
#pragma unroll
            for (int m = 0; m < 4; ++m) { const int row = row0 + ai * HALF + m * 16; const float sr = sa[row]; bf16_t* rowp = O + (size_t)row * ldc + col0;
#pragma unroll
                for (int bj = 0; bj < 2; ++bj) { const v4i_t i0 = __builtin_bit_cast(v4i_t, acc[ai][bj][m][0]) + cv[bj][0], i1 = __builtin_bit_cast(v4i_t, acc[ai][bj][m][1]) + cv[bj][1];
                    *(u32x4*)(rowp + bj * HALF) = pack8((f32x4){(float)i0[0], (float)i0[1], (float)i0[2], (float)i0[3]} * (sv[bj][0] * sr), (f32x4){(float)i1[0], (float)i1[1], (float)i1[2], (float)i1[3]} * (sv[bj][1] * sr)); } }
    }
};
struct EpiRelu2I8 {
    static constexpr bool PERM = true, AFTER_DRAIN = false, CHAIN = false;
    __device__ __forceinline__ bool keep_acc(const Unit&) const { return false; }
    bf16_t* O; int ldc; const float* sa; const float* sb;
    __device__ __forceinline__ void operator()(const f32x4 (&acc)[2][2][4][2], const Unit& u, int wr, int wc, int fr, int fq) const {
        const int row0 = u.pm * BM + wr * 64 + fr, col0 = u.pn * BM + wc * 32 + 8 * fq;
        f32x4 sv[2][2];
#pragma unroll
        for (int bj = 0; bj < 2; ++bj)
#pragma unroll
            for (int n = 0; n < 2; ++n) sv[bj][n] = *(const f32x4*)(sb + col0 + bj * HALF + 4 * n);
#pragma unroll
        for (int ai = 0; ai < 2; ++ai)
#pragma unroll
            for (int m = 0; m < 4; ++m) { const int row = row0 + ai * HALF + m * 16; const float sr = sa[row]; bf16_t* rowp = O + (size_t)row * ldc + col0;
#pragma unroll
                for (int bj = 0; bj < 2; ++bj) { f32x4 v0 = i2f4(acc[ai][bj][m][0]) * (sv[bj][0] * sr), v1 = i2f4(acc[ai][bj][m][1]) * (sv[bj][1] * sr);
#pragma unroll
                    for (int j = 0; j < 4; ++j) { const float p = fmaxf(v0[j], 0.f), q = fmaxf(v1[j], 0.f); v0[j] = p * p; v1[j] = q * q; }
                    *(u32x4*)(rowp + bj * HALF) = pack8(v0, v1); } }
    }
};

struct EpiMix {
    static constexpr bool PERM = true, AFTER_DRAIN = false, CHAIN = true;
    mutable u32x4 gbk[4];
    bf16_t* O; const unsigned char* G;
    static __device__ __forceinline__ f32x4 ub4(unsigned w) { return (f32x4){(float)(w & 255u), (float)((w >> 8) & 255u), (float)((w >> 16) & 255u), (float)(w >> 24)}; }
    __device__ __forceinline__ void operator()(f32x4 (&acc)[2][2][4][2], const Unit& u, int wr, int wc, int fr, int fq) const {
        const int row0 = u.pm * BM + wr * 64 + fr, col0 = u.pn * BM + wc * 32 + 8 * fq; const int kind = u.kind;
        const unsigned char* ta = G + ((size_t)(u.pm * 32 + u.pn) << 16) + (wr * 4 + wc) * 8192 + (fr + 16 * fq) * 16;
        const unsigned char* tb = ta + ((size_t)16 << 16);
        if (kind == 0) {
#pragma unroll
            for (int ai = 0; ai < 2; ++ai)
#pragma unroll
                for (int m = 0; m < 4; ++m) { const u32x4 ga4 = *(const u32x4*)(ta + (ai * 4 + m) * 1024), gb4 = *(const u32x4*)(tb + (ai * 4 + m) * 1024); if (ai == 0) gbk[m] = gb4;
#pragma unroll
                    for (int bj = 0; bj < 2; ++bj) { const unsigned gax = bj ? ga4.z : ga4.x, gay = bj ? ga4.w : ga4.y, gbx = bj ? gb4.z : gb4.x, gby = bj ? gb4.w : gb4.y;
                        f32x4 b0 = ub4(gbx), b1 = ub4(gby);
#pragma unroll
                        for (int j = 0; j < 4; ++j) { b0[j] = __builtin_amdgcn_rcpf(fmaxf(b0[j], 2.3191e-10f)); b1[j] = __builtin_amdgcn_rcpf(fmaxf(b1[j], 2.3191e-10f)); }
                        acc[ai][bj][m][0] *= ub4(gax) * b0; acc[ai][bj][m][1] *= ub4(gay) * b1; } }
        } else {
#pragma unroll
            for (int ai = 0; ai < 2; ++ai)
#pragma unroll
                for (int m = 0; m < 4; ++m) { const size_t row = (size_t)(row0 + ai * HALF + m * 16); const u32x4 gb4 = (ai == 0) ? gbk[m] : *(const u32x4*)(tb + (ai * 4 + m) * 1024);
#pragma unroll
                    for (int bj = 0; bj < 2; ++bj) { const int col = col0 + bj * HALF; const unsigned gbx = bj ? gb4.z : gb4.x, gby = bj ? gb4.w : gb4.y;
                        f32x4 b0 = ub4(gbx), b1 = ub4(gby);
#pragma unroll
                        for (int j = 0; j < 4; ++j) { b0[j] = fmaxf(b0[j], 2.3191e-10f) * (1.f / 255.f); b1[j] = fmaxf(b1[j], 2.3191e-10f) * (1.f / 255.f); }
                        *(u32x4*)(O + row * 4096 + col) = pack8(acc[ai][bj][m][0] * b0, acc[ai][bj][m][1] * b1); } }
        }
    }
    __device__ __forceinline__ bool keep_acc(const Unit& u) const { return u.kind == 0; }
};

template <class Epi, class Sched, bool ALIGN_EPI = false, bool SP2 = false, bool I8 = false>
__device__ __forceinline__ void gemm_phase(PG8_LAS unsigned char* lds, const Gemm g, const Sched& S, const Epi& E) {
    int tid_ = threadIdx.x; asm volatile("" : "+v"(tid_));
    const int tid = tid_, wid = __builtin_amdgcn_readfirstlane(tid >> 6), lane = tid & 63, wr = wid >> 2, wc = wid & 3, fr = lane & 15, fq = lane >> 4;
    const int K = g.K, nt = K / BK;
    unsigned voffA[2], voffB[2];
#pragma unroll
    for (int i = 0; i < 2; ++i) { int R, C; stage_rc(tid * 16 + i * 8192, R, C); const int Rb = Epi::PERM ? ((R & ~31) + perm32(R & 31)) : R;
        voffA[i] = (unsigned)(R * K + C) * 2u; voffB[i] = (unsigned)(Rb * K + C) * 2u; }
    const size_t kstep = (size_t)(BK * 2);
    const size_t hstep = (size_t)HALF * K * 2;
    const size_t tstep = 2 * hstep;
    const unsigned ldsw = (unsigned)wid * 1024u;
    const int aoff = lds_byte(wr * 64 + fr, fq * 8), boff = lds_byte(wc * 32 + fr, fq * 8);
#define PG8_SA(b, h) (((b) * 2 + (h)) * HTB)
#define PG8_SB(b, h) ((4 + (b) * 2 + (h)) * HTB)
#define PG8_STAGE(bufoff, gbase, voff) do { _Pragma("unroll") for (int _i = 0; _i < 2; ++_i) \
        __builtin_amdgcn_global_load_lds((const unsigned*)((const char*)(gbase) + (voff)[_i]), (PG8_LAS unsigned*)(lds + (bufoff) + ldsw + _i * 8192), 16, 0, 0); } while (0)
#define PG8_LDA(dst, b, h) do { _Pragma("unroll") for (int m = 0; m < 4; ++m) _Pragma("unroll") for (int k = 0; k < 2; ++k) dst[m][k] = *(const PG8_LAS bf16x8*)(lds + PG8_SA(b, h) + aoff + m * 2048 + k * 1024); } while (0)
#define PG8_LDB(dst, b, h) do { _Pragma("unroll") for (int n = 0; n < 2; ++n) _Pragma("unroll") for (int k = 0; k < 2; ++k) dst[n][k] = *(const PG8_LAS bf16x8*)(lds + PG8_SB(b, h) + boff + n * 2048 + k * 1024); } while (0)
#define PG8_MMA(ai, bj, At, Bt) do { __builtin_amdgcn_s_setprio(1); _Pragma("unroll") for (int m = 0; m < 4; ++m) _Pragma("unroll") for (int n = 0; n < 2; ++n) _Pragma("unroll") for (int k = 0; k < 2; ++k) { \
        if constexpr (I8) acc[ai][bj][m][n] = __builtin_bit_cast(f32x4, __builtin_amdgcn_mfma_i32_16x16x64_i8(__builtin_bit_cast(v4i_t, Bt[n][k]), __builtin_bit_cast(v4i_t, At[m][k]), __builtin_bit_cast(v4i_t, acc[ai][bj][m][n]), 0, 0, 0)); \
        else acc[ai][bj][m][n] = __builtin_amdgcn_mfma_f32_16x16x32_bf16(Bt[n][k], At[m][k], acc[ai][bj][m][n], 0, 0, 0); } __builtin_amdgcn_s_setprio(0); } while (0)
#define PG8_WAIT_V(n) asm volatile("s_waitcnt vmcnt(" #n ")" ::: "memory")
#define PG8_WAIT_L(n) asm volatile("s_waitcnt lgkmcnt(" #n ")" ::: "memory")
#define PG8_BAR __builtin_amdgcn_s_barrier()
#define PG8_SCHED __builtin_amdgcn_sched_barrier(0)
    Unit cur, nxt; int ui = 0;
    if (!S.next(0, cur)) return;
    f32x4 acc[2][2][4][2];
#pragma unroll
    for (int a = 0; a < 2; ++a)
#pragma unroll
        for (int b = 0; b < 2; ++b)
#pragma unroll
            for (int m = 0; m < 4; ++m)
#pragma unroll
                for (int n = 0; n < 2; ++n) acc[a][b][m][n] = (f32x4){0.f, 0.f, 0.f, 0.f};
    bf16x8 At[4][2], B0[2][2], B1[2][2];
    const char* cA = (const char*)(cur.kind ? g.A1 : g.A0) + (size_t)cur.pm * tstep; const char* cB = (const char*)(cur.kind ? g.B1 : g.B0) + (size_t)cur.pn * tstep;
    S.a_ready(cur);
    if constexpr (SP2) {
        PG8_STAGE(PG8_SB(0, 0), cB, voffB); PG8_STAGE(PG8_SB(0, 1), cB + hstep, voffB); PG8_STAGE(PG8_SA(0, 0), cA, voffA); PG8_STAGE(PG8_SA(0, 1), cA + hstep, voffA);
        if (wr == 1) PG8_BAR;
        PG8_WAIT_V(2); PG8_BAR;
        PG8_STAGE(PG8_SB(1, 0), cB + kstep, voffB); PG8_STAGE(PG8_SA(1, 0), cA + kstep, voffA); PG8_STAGE(PG8_SB(1, 1), cB + hstep + kstep, voffB);
        PG8_WAIT_V(6); PG8_BAR;
    } else {
        PG8_STAGE(PG8_SB(0, 0), cB, voffB); PG8_STAGE(PG8_SA(0, 0), cA, voffA); PG8_STAGE(PG8_SB(0, 1), cB + hstep, voffB); PG8_STAGE(PG8_SA(0, 1), cA + hstep, voffA);
        if (wr == 1) PG8_BAR;
        PG8_WAIT_V(4); PG8_BAR;
        PG8_STAGE(PG8_SB(1, 0), cB + kstep, voffB); PG8_STAGE(PG8_SA(1, 0), cA + kstep, voffA); PG8_STAGE(PG8_SB(1, 1), cB + hstep + kstep, voffB);
        PG8_WAIT_V(6); PG8_BAR;
    }
    for (;;) {
        const bool has_next = S.next(ui + 1, nxt);
        const char* nA = has_next ? (const char*)(nxt.kind ? g.A1 : g.A0) + (size_t)nxt.pm * tstep : cA; const char* nB = has_next ? (const char*)(nxt.kind ? g.B1 : g.B0) + (size_t)nxt.pn * tstep : cB;
        for (int t = 0; t < nt; t += 2) {
            const bool last = (t == nt - 2);
            const char* a1 = cA + (size_t)(t + 1) * kstep;
            const char* a2 = last ? nA : cA + (size_t)(t + 2) * kstep; const char* b2 = last ? nB : cB + (size_t)(t + 2) * kstep;
            const char* a3 = a2 + kstep; const char* b3 = b2 + kstep;
            if (last && has_next) S.a_ready(nxt);
            if constexpr (SP2) {
            PG8_LDB(B0, 0, 0); PG8_LDB(B1, 0, 1); PG8_SCHED; PG8_LDA(At, 0, 0); PG8_STAGE(PG8_SA(1, 1), a1 + hstep, voffA);
            PG8_WAIT_V(8); PG8_WAIT_L(0); PG8_BAR; PG8_MMA(0, 0, At, B0); PG8_MMA(0, 1, At, B1); PG8_BAR; PG8_SCHED;
            PG8_LDA(At, 0, 1); PG8_STAGE(PG8_SB(0, 0), b2, voffB); PG8_STAGE(PG8_SB(0, 1), b2 + hstep, voffB); PG8_STAGE(PG8_SA(0, 0), a2, voffA);
            PG8_WAIT_V(8); PG8_WAIT_L(0); PG8_BAR; PG8_MMA(1, 0, At, B0); PG8_MMA(1, 1, At, B1); PG8_BAR; PG8_SCHED;
            PG8_LDB(B0, 1, 0); PG8_LDB(B1, 1, 1); PG8_SCHED; PG8_LDA(At, 1, 0); PG8_STAGE(PG8_SA(0, 1), a2 + hstep, voffA);
            PG8_WAIT_V(8); PG8_WAIT_L(0); PG8_BAR; PG8_MMA(0, 0, At, B0); PG8_MMA(0, 1, At, B1); PG8_BAR; PG8_SCHED;
            PG8_LDA(At, 1, 1); PG8_STAGE(PG8_SB(1, 0), b3, voffB); PG8_STAGE(PG8_SB(1, 1), b3 + hstep, voffB); PG8_STAGE(PG8_SA(1, 0), a3, voffA);
            PG8_WAIT_V(8); PG8_WAIT_L(0); PG8_BAR; PG8_MMA(1, 0, At, B0); PG8_MMA(1, 1, At, B1); PG8_BAR; PG8_SCHED;
            } else {
            PG8_LDB(B0, 0, 0); PG8_SCHED; PG8_LDA(At, 0, 0); PG8_STAGE(PG8_SA(1, 1), a1 + hstep, voffA);
            PG8_WAIT_L(8); PG8_BAR; PG8_WAIT_L(0); PG8_MMA(0, 0, At, B0); PG8_BAR; PG8_SCHED;
            PG8_LDB(B1, 0, 1); PG8_STAGE(PG8_SB(0, 0), b2, voffB);
            PG8_BAR; PG8_WAIT_L(0); PG8_MMA(0, 1, At, B1); PG8_BAR;
            PG8_LDA(At, 0, 1); PG8_STAGE(PG8_SA(0, 0), a2, voffA);
            PG8_BAR; PG8_WAIT_L(0); PG8_MMA(1, 0, At, B0); PG8_BAR; PG8_SCHED;
            PG8_STAGE(PG8_SB(0, 1), b2 + hstep, voffB);
            PG8_WAIT_V(6); PG8_BAR; PG8_MMA(1, 1, At, B1); PG8_BAR;
            PG8_LDB(B0, 1, 0); PG8_SCHED; PG8_LDA(At, 1, 0); PG8_STAGE(PG8_SA(0, 1), a2 + hstep, voffA);
            PG8_WAIT_L(8); PG8_BAR; PG8_WAIT_L(0); PG8_MMA(0, 0, At, B0); PG8_BAR; PG8_SCHED;
            PG8_LDB(B1, 1, 1); PG8_STAGE(PG8_SB(1, 0), b3, voffB);
            PG8_BAR; PG8_WAIT_L(0); PG8_MMA(0, 1, At, B1); PG8_BAR;
            PG8_LDA(At, 1, 1); PG8_STAGE(PG8_SA(1, 0), a3, voffA);
            PG8_BAR; PG8_WAIT_L(0); PG8_MMA(1, 0, At, B0); PG8_BAR; PG8_SCHED;
            PG8_STAGE(PG8_SB(1, 1), b3 + hstep, voffB);
            PG8_WAIT_V(6); PG8_BAR; PG8_MMA(1, 1, At, B1); PG8_BAR;
            }
        }
        if constexpr (ALIGN_EPI) { if (wr == 0) PG8_BAR; }
        if constexpr (!Epi::AFTER_DRAIN) { E(acc, cur, wr, wc, fr, fq); S.done(cur); }
        if (!has_next) break;
        if (!(Epi::CHAIN && E.keep_acc(cur))) {
#pragma unroll
        for (int a = 0; a < 2; ++a)
#pragma unroll
            for (int b = 0; b < 2; ++b)
#pragma unroll
                for (int m = 0; m < 4; ++m)
#pragma unroll
                    for (int n = 0; n < 2; ++n) acc[a][b][m][n] = (f32x4){0.f, 0.f, 0.f, 0.f};
        }
        cur = nxt; cA = nA; cB = nB; ++ui;
        if constexpr (ALIGN_EPI) { if (wr == 1) PG8_BAR; }
    }
    PG8_WAIT_V(0);
    if constexpr (!ALIGN_EPI) { if (wr == 0) PG8_BAR; }
    PG8_BAR;
#undef PG8_SA
#undef PG8_SB
#undef PG8_STAGE
#undef PG8_LDA
#undef PG8_LDB
#undef PG8_MMA
#undef PG8_WAIT_V
#undef PG8_WAIT_L
#undef PG8_BAR
#undef PG8_SCHED
}
}


namespace att {
#define ATT_LAS __attribute__((address_space(3)))
typedef unsigned short bf16;
typedef short bf16x8 __attribute__((ext_vector_type(8)));
typedef short s16x4 __attribute__((ext_vector_type(4)));
typedef float f32x16 __attribute__((ext_vector_type(16)));
typedef float f32x2_t __attribute__((ext_vector_type(2)));
typedef __bf16 bf16x2_t __attribute__((ext_vector_type(2)));
typedef unsigned u32x4 __attribute__((ext_vector_type(4)));
typedef unsigned u32x2 __attribute__((ext_vector_type(2)));
constexpr int TILE_BYTES = 64 * 256, BUF_BYTES = 2 * TILE_BYTES, FLAG_OFF = 2 * BUF_BYTES, LDS_BYTES = FLAG_OFF + 256;
__device__ __forceinline__ unsigned cvtpk(float lo, float hi) { f32x2_t v = {lo, hi}; bf16x2_t b = __builtin_convertvector(v, bf16x2_t); return __builtin_bit_cast(unsigned, b); }
__device__ __forceinline__ int crow(int i, int h) { return (i & 3) + 8 * (i >> 2) + 4 * h; }
__device__ __forceinline__ unsigned off_b(unsigned row, unsigned ch) { return 256u * row + 16u * (ch ^ (((row & 3) << 2) | ((row >> 2) & 3))); }
__device__ __forceinline__ s16x4 trread(const ATT_LAS unsigned char* p) { return __builtin_bit_cast(s16x4, __builtin_amdgcn_ds_read_tr16_b64_v4i16((ATT_LAS s16x4*)p)); }
#define ATT_MFMA(a, b, c) __builtin_amdgcn_mfma_f32_32x32x16_bf16((a), (b), (c), 0, 0, 0)

struct AUnit { const bf16* Q; const bf16* K; const bf16* V; bf16* O; int pq, pk, po, b, qb; float sink2; int gqa; const float* sk; };
__device__ __forceinline__ void attn_prefetch(const AUnit& u, bf16x8 (&qf)[8], u32x4& kr0, u32x4& kr1, u32x4& vr0, u32x4& vr1, int tid, int wid, int lane) {
    int ln_ = lane, td_ = tid; asm volatile("" : "+v"(ln_), "+v"(td_));
    const int r32 = ln_ & 31, h = ln_ >> 5, tq = (u.gqa ? 64 * u.qb + 32 * (wid & 1) : 256 * u.qb + 32 * wid) + r32; const size_t rowbase = (size_t)u.b * 4096;
    { const char* qb_ = (const char*)(u.Q + rowbase * u.pq + (u.gqa ? (wid >> 1) * 128 : 0)); const unsigned qo = (unsigned)(tq * u.pq + 8 * h) * 2u;
#pragma unroll
      for (int s = 0; s < 8; ++s) qf[s] = *(const bf16x8*)(qb_ + qo + 32 * s); }
    const int lrow = td_ >> 4, lch = td_ & 15; const unsigned kvo = (unsigned)(lrow * u.pk + 8 * lch) * 2u;
    const size_t o = ((size_t)rowbase + (size_t)(64 * (u.gqa ? u.qb : 4 * u.qb + 3))) * u.pk * 2; const char* k = (const char*)u.K + o; const char* v = (const char*)u.V + o;
    kr0 = *(const u32x4*)(k + kvo); kr1 = *(const u32x4*)(k + (size_t)64 * u.pk + kvo); vr0 = *(const u32x4*)(v + kvo); vr1 = *(const u32x4*)(v + (size_t)64 * u.pk + kvo);
}
template <int MODE, bool EARLY>
__device__ __forceinline__ void attn_unit(ATT_LAS unsigned char* lds, const AUnit& U, bool has_next, const AUnit& N, bf16x8 (&qf)[8], u32x4& kr0, u32x4& kr1, u32x4& vr0, u32x4& vr1, int tid, int wid, int lane) {
    const bf16* __restrict__ Kh = U.K; const bf16* __restrict__ Vh = U.V; bf16* __restrict__ Oh = U.O + (MODE == 0 ? (wid >> 1) * 128 : 0); const int pk = U.pk, po = U.po, b = U.b, qb = U.qb;
    const float sink2 = (MODE == 0) ? U.sk[wid >> 1] * 1.44269504089f : 0.f;
    int ln_ = lane, td_ = tid; asm volatile("" : "+v"(ln_), "+v"(td_));
    const int r32 = ln_ & 31, h = ln_ >> 5;
    const int t0 = (MODE == 0) ? 64 * qb + 32 * (wid & 1) : 256 * qb + 32 * wid, tq = t0 + r32;
    const size_t rowbase = (size_t)b * 4096;
    f32x16 oacc[4];
#pragma unroll
    for (int c = 0; c < 4; ++c)
#pragma unroll
        for (int i = 0; i < 16; ++i) oacc[c][i] = 0.f;
    float carry = 0.f, mrun = sink2, lrun = (h == 0) ? 1.f : 0.f;
    const int kt_hi = (MODE == 0) ? qb : 4 * qb + 3, kt_lo = (MODE == 0) ? ((qb - 2) > 0 ? (qb - 2) : 0) : 0;
    const int lrow = td_ >> 4, lch = td_ & 15;
    const unsigned lw = off_b((unsigned)lrow, (unsigned)lch);
    const unsigned kvo = (unsigned)(lrow * pk + 8 * lch) * 2u;
    const char* kgb = (const char*)(Kh + rowbase * pk); const char* vgb = (const char*)(Vh + rowbase * pk);
    const unsigned xk = (unsigned)(((r32 & 3) << 2) | ((r32 >> 2) & 3));
    const int q4 = (ln_ & 15) >> 2, p4 = ln_ & 3, blk = (ln_ >> 4) & 1;
    unsigned vaddr[4][2];
#pragma unroll
    for (int c = 0; c < 4; ++c)
#pragma unroll
        for (int t = 0; t < 2; ++t) { const unsigned row = (unsigned)(8 * t + 4 * h + q4), x = (unsigned)((q4 << 2) | ((2 * t + h) & 3)), ch = (unsigned)(4 * c + 2 * blk + (p4 >> 1));
            vaddr[c][t] = 256u * row + 16u * (ch ^ x) + 8u * (unsigned)(p4 & 1); }
#define ATT_GLOAD(kt) do { const size_t _o = (size_t)(64 * (kt)) * pk * 2; const char* _k = kgb + _o; const char* _v = vgb + _o; kr0 = *(const u32x4*)(_k + kvo); kr1 = *(const u32x4*)(_k + (size_t)64 * pk + kvo); vr0 = *(const u32x4*)(_v + kvo); vr1 = *(const u32x4*)(_v + (size_t)64 * pk + kvo); } while (0)
#define ATT_LSTORE(bf) do { ATT_LAS unsigned char* _b = lds + (bf) * BUF_BYTES + lw; *(ATT_LAS u32x4*)_b = kr0; *(ATT_LAS u32x4*)(_b + 8192) = kr1; *(ATT_LAS u32x4*)(_b + TILE_BYTES) = vr0; *(ATT_LAS u32x4*)(_b + TILE_BYTES + 8192) = vr1; } while (0)
    int buf = 0;
    ATT_LSTORE(0); __syncthreads();
    for (int kt = kt_hi; kt >= kt_lo; --kt) {
        const bool more = kt > kt_lo;
        if (more) ATT_GLOAD(kt - 1);
        const int kbase = 64 * kt;
        bool relevant, masked;
        if (MODE == 1) { relevant = kbase <= t0 + 30; masked = kbase + 63 >= t0; }
        else { relevant = (kbase <= t0 + 31) && (kbase + 63 >= t0 - 127); masked = !((kbase + 63 <= t0) && (kbase >= t0 - 96)); }
        if (relevant) {
            const ATT_LAS unsigned char* Kb = lds + buf * BUF_BYTES; const ATT_LAS unsigned char* Vb = Kb + TILE_BYTES;
            f32x16 sacc[2];
#pragma unroll
            for (int kb = 0; kb < 2; ++kb) {
#pragma unroll
                for (int i = 0; i < 16; ++i) sacc[kb][i] = 0.f;
#pragma unroll
                for (int s = 0; s < 8; ++s) { const bf16x8 kf = *(const ATT_LAS bf16x8*)(Kb + kb * 8192 + 256 * r32 + 16 * (((unsigned)(2 * s + h)) ^ xk)); sacc[kb] = ATT_MFMA(kf, qf[s], sacc[kb]); }
            }
            bf16x8 pf[2][2];
            if (MODE == 1) {
#pragma unroll
                for (int kk = 0; kk < 2; ++kk) { const int kb = 1 - kk; const int sb0 = kbase + 32 * kb;
                    float sp[16], A[16];
#pragma unroll
                    for (int i = 0; i < 16; ++i) { const float z = sacc[kb][i]; const float e = __builtin_amdgcn_exp2f(-__builtin_fabsf(z)); sp[i] = fmaxf(z, 0.f) + __builtin_amdgcn_logf(1.f + e); }
                    if (masked) {
#pragma unroll
                        for (int i = 0; i < 16; ++i) sp[i] = (sb0 + crow(i, h) < tq) ? sp[i] : 0.f; }
                    float G[4], Gp[4], T[4];
#pragma unroll
                    for (int g = 0; g < 4; ++g) { G[g] = (sp[4 * g] + sp[4 * g + 1]) + (sp[4 * g + 2] + sp[4 * g + 3]); Gp[g] = __shfl_xor(G[g], 32); T[g] = G[g] + Gp[g]; }
                    float R[4]; R[3] = carry; R[2] = R[3] + T[3]; R[1] = R[2] + T[2]; R[0] = R[1] + T[1]; carry = R[0] + T[0];
#pragma unroll
                    for (int g = 0; g < 4; ++g) { const float S3 = R[g] + (h == 0 ? Gp[g] : 0.f), S2 = S3 + sp[4 * g + 3], S1 = S2 + sp[4 * g + 2], S0 = S1 + sp[4 * g + 1];
                        A[4 * g + 3] = __builtin_amdgcn_exp2f(sacc[kb][4 * g + 3] - sp[4 * g + 3] - S3); A[4 * g + 2] = __builtin_amdgcn_exp2f(sacc[kb][4 * g + 2] - sp[4 * g + 2] - S2);
                        A[4 * g + 1] = __builtin_amdgcn_exp2f(sacc[kb][4 * g + 1] - sp[4 * g + 1] - S1); A[4 * g + 0] = __builtin_amdgcn_exp2f(sacc[kb][4 * g + 0] - sp[4 * g + 0] - S0); }
                    if (masked) {
#pragma unroll
                        for (int i = 0; i < 16; ++i) A[i] = (sb0 + crow(i, h) < tq) ? A[i] : 0.f; }
#pragma unroll
                    for (int s2 = 0; s2 < 2; ++s2) { u32x4 w; w.x = cvtpk(A[8 * s2], A[8 * s2 + 1]); w.y = cvtpk(A[8 * s2 + 2], A[8 * s2 + 3]); w.z = cvtpk(A[8 * s2 + 4], A[8 * s2 + 5]); w.w = cvtpk(A[8 * s2 + 6], A[8 * s2 + 7]); pf[kb][s2] = __builtin_bit_cast(bf16x8, w); }
                }
            } else {
                if (masked) {
#pragma unroll
                    for (int kb = 0; kb < 2; ++kb)
#pragma unroll
                        for (int i = 0; i < 16; ++i) { const int key = kbase + 32 * kb + crow(i, h); const bool valid = (key <= tq) && (key + 127 >= tq); sacc[kb][i] = valid ? sacc[kb][i] : -__builtin_inff(); } }
                float tmax = sacc[0][0];
#pragma unroll
                for (int kb = 0; kb < 2; ++kb)
#pragma unroll
                    for (int i = 0; i < 16; ++i) tmax = fmaxf(tmax, sacc[kb][i]);
                tmax = fmaxf(tmax, __shfl_xor(tmax, 32));
                const float mnew = fmaxf(mrun, tmax), alpha = __builtin_amdgcn_exp2f(mrun - mnew); mrun = mnew;
                float psum = 0.f;
#pragma unroll
                for (int kb = 0; kb < 2; ++kb) { float P[16];
#pragma unroll
                    for (int i = 0; i < 16; ++i) { P[i] = __builtin_amdgcn_exp2f(sacc[kb][i] - mnew); psum += P[i]; }
#pragma unroll
                    for (int s2 = 0; s2 < 2; ++s2) { u32x4 w; w.x = cvtpk(P[8 * s2], P[8 * s2 + 1]); w.y = cvtpk(P[8 * s2 + 2], P[8 * s2 + 3]); w.z = cvtpk(P[8 * s2 + 4], P[8 * s2 + 5]); w.w = cvtpk(P[8 * s2 + 6], P[8 * s2 + 7]); pf[kb][s2] = __builtin_bit_cast(bf16x8, w); } }
                lrun = lrun * alpha + psum;
#pragma unroll
                for (int c = 0; c < 4; ++c)
#pragma unroll
                    for (int i = 0; i < 16; ++i) oacc[c][i] *= alpha;
            }
#pragma unroll
            for (int kb = 0; kb < 2; ++kb)
#pragma unroll
                for (int s2 = 0; s2 < 2; ++s2)
#pragma unroll
                    for (int c = 0; c < 4; ++c) { const s16x4 lo = trread(Vb + vaddr[c][0] + 4096 * (2 * kb + s2)), hi = trread(Vb + vaddr[c][1] + 4096 * (2 * kb + s2));
                        const bf16x8 vf = __builtin_shufflevector(lo, hi, 0, 1, 2, 3, 4, 5, 6, 7); oacc[c] = ATT_MFMA(vf, pf[kb][s2], oacc[c]); }
        }
        if (more) ATT_LSTORE(buf ^ 1);
        if (EARLY && MODE == 1) {
            volatile ATT_LAS unsigned* fl = (volatile ATT_LAS unsigned*)(lds + FLAG_OFF) + (kt & 1) * 8;
            const bool done = __all(carry > 160.f);
            if (lane == 0) fl[wid] = done ? 1u : 0u;
            __syncthreads();
            unsigned alld = 1u;
#pragma unroll
            for (int w = 0; w < 8; ++w) alld &= fl[w];
            buf ^= 1;
            if (alld) break;
        } else { __syncthreads(); buf ^= 1; }
    }
#undef ATT_GLOAD
#undef ATT_LSTORE
    if (MODE == 0) { const float lt = lrun + __shfl_xor(lrun, 32); const float inv = 1.f / lt;
#pragma unroll
        for (int c = 0; c < 4; ++c)
#pragma unroll
            for (int i = 0; i < 16; ++i) oacc[c][i] *= inv; }
    if (has_next) attn_prefetch(N, qf, kr0, kr1, vr0, vr1, tid, wid, lane);
    { int l2 = lane; asm volatile("" : "+v"(l2)); const int r2 = l2 & 31, h2 = l2 >> 5;
      char* ob = (char*)(Oh + rowbase * po); const unsigned oo = (unsigned)((t0 + r2) * po) * 2u + 16u * (unsigned)h2;
#pragma unroll
      for (int c = 0; c < 4; ++c)
#pragma unroll
        for (int gp = 0; gp < 2; ++gp) { const int g0 = 2 * gp;
            const unsigned x0 = cvtpk(oacc[c][4 * g0], oacc[c][4 * g0 + 1]), x1 = cvtpk(oacc[c][4 * g0 + 2], oacc[c][4 * g0 + 3]);
            const unsigned y0 = cvtpk(oacc[c][4 * g0 + 4], oacc[c][4 * g0 + 5]), y1 = cvtpk(oacc[c][4 * g0 + 6], oacc[c][4 * g0 + 7]);
            const auto s0 = __builtin_amdgcn_permlane32_swap(x0, y0, false, false); const auto s1 = __builtin_amdgcn_permlane32_swap(x1, y1, false, false);
            u32x4 w; w.x = s0[0]; w.y = s1[0]; w.z = s0[1]; w.w = s1[1];
            *(u32x4*)(ob + oo + 64 * c + 32 * gp) = w; } }
    if (EARLY && MODE == 1) __syncthreads();
}
}


constexpr int NWAVES = 8;
constexpr int BATCH = 4, SEQ = 4096, D = 4096, M = BATCH * SEQ, HD = 128, FF = 4 * D;
constexpr int D_IN = 9216, NG = 8192, N1 = D_IN + NG, NMOD = 6 * D;
constexpr float NORM_EPS = 1e-6f;
constexpr size_t MiB = 1u << 20;
constexpr size_t WS_CTL = 0, CTL_ZERO_BYTES = 49152;
constexpr size_t WS_CMX = 16384;
constexpr size_t WS_MOD = 1 * MiB, WS_COS = 2 * MiB, WS_SIN = 3 * MiB;
constexpr size_t WS_W1 = 4 * MiB;
constexpr size_t WS_WPS = 140 * MiB, WS_WPB = 156 * MiB;
constexpr size_t WS_WO = 172 * MiB;
constexpr size_t WS_WF1 = 204 * MiB;
constexpr size_t WS_WF2 = 332 * MiB;
constexpr size_t WS_A = 460 * MiB;
constexpr size_t WS_B = 588 * MiB;
constexpr size_t WS_C = 716 * MiB;
constexpr size_t WS_H8 = WS_C + 544 * MiB;
constexpr size_t WS_W8G = WS_H8 + 64 * MiB;
constexpr size_t WS_W8F = WS_W8G + 56 * MiB;
constexpr size_t WS_W8O = WS_W8F + 64 * MiB;
constexpr size_t WS_END = WS_W8O + 64 * MiB;
constexpr size_t WS_U8 = WS_W1;
constexpr size_t WS_SU = 320 * 1024, WS_SO = 384 * 1024, WS_CO = 32768;
constexpr int NB16 = 3072, NI8 = 14336;
constexpr size_t WS_SH = 64 * 1024, WS_S2 = 128 * 1024, WS_SG = 192 * 1024, WS_SF = 256 * 1024;
constexpr int CW_BAR = 0, CW_KS = 3520;
constexpr int RING_OFF = 0, RING_BYTES = 131072, LDSCTL_OFF = 139264, MISC_OFF = LDSCTL_OFF + 320, LDS_BYTES = 147456;

#define GAS __attribute__((address_space(1)))
#define LAS __attribute__((address_space(3)))
typedef unsigned short bf16;
typedef unsigned v4u __attribute__((ext_vector_type(4)));
typedef unsigned v2u __attribute__((ext_vector_type(2)));
typedef float f32x4 __attribute__((ext_vector_type(4)));
#define LDS_WAIT() asm volatile("s_waitcnt lgkmcnt(0)" ::: "memory")
__device__ __forceinline__ unsigned f2bf(float f) { unsigned u = __builtin_bit_cast(unsigned, f); return (u + 0x7fffu + ((u >> 16) & 1u)) >> 16; }
__device__ __forceinline__ unsigned pk2(float lo, float hi) { return f2bf(lo) | (f2bf(hi) << 16); }

#define XB_TMO      128
#define XB_XCNT(j)  (256  + 64 * (j))
#define XB_XSUB(j)  (1280 + 64 * (j))
#define XB_XGEN(j)  (2304 + 64 * (j))
#define XB_TOP      3328
#define XB_TOPGEN   3392
#define XCD_BAR_WORDS 3456
#define XB_SPIN_CAP (1u << 18)
__device__ __forceinline__ unsigned xb_ld(unsigned* p)              { return __hip_atomic_load(p, __ATOMIC_RELAXED, __HIP_MEMORY_SCOPE_AGENT); }
__device__ __forceinline__ unsigned xb_add(unsigned* p, unsigned v) { return __hip_atomic_fetch_add(p, v, __ATOMIC_RELAXED, __HIP_MEMORY_SCOPE_AGENT); }
__device__ __forceinline__ unsigned xb_xcc_id() { return (unsigned)__builtin_amdgcn_s_getreg((3 << 11) | 20) & 0xFu; }
#define XB_SPIN(cond, bar) do { unsigned _sp = 0; while (cond) { __builtin_amdgcn_s_sleep(1); \
    if ((++_sp & 255u) == 0u) { if (xb_ld(&(bar)[XB_TMO])) break; if (_sp > XB_SPIN_CAP) { atomicAdd(&(bar)[XB_TMO], 1u); break; } } } } while (0)
struct XcdBarrier { unsigned* bar; unsigned x; volatile LAS unsigned* st; };
__device__ __forceinline__ XcdBarrier xcd_barrier_post(unsigned* bar, volatile LAS unsigned* st) {
    XcdBarrier b; b.bar = bar; b.x = xb_xcc_id(); b.st = st;
    if (threadIdx.x == 0) (void)xb_add(&bar[XB_XCNT(b.x)], 1u);
    return b;
}
__device__ __forceinline__ void xcd_barrier_complete(unsigned* bar, unsigned x, unsigned& nloc, unsigned& nx) {
    const unsigned G = gridDim.x * gridDim.y * gridDim.z;
    unsigned sum, cnt, mine, sp = 0u;
    for (;;) {
        sum = 0u; cnt = 0u; mine = 0u;
#pragma unroll
        for (unsigned j = 0; j < 16; ++j) { const unsigned c = xb_ld(&bar[XB_XCNT(j)]); sum += c; cnt += (c > 0u) ? 1u : 0u; mine = (j == x) ? c : mine; }
        if (sum == G) break;
        __builtin_amdgcn_s_sleep(1);
        if ((++sp & 255u) == 0u) { if (xb_ld(&bar[XB_TMO])) break; if (sp > XB_SPIN_CAP) { atomicAdd(&bar[XB_TMO], 1u); break; } }
    }
    nloc = mine > 0u ? mine : 1u; nx = cnt > 0u ? cnt : 1u;
}
__device__ __forceinline__ void xcd_barrier(const XcdBarrier& b) {
    asm volatile("s_waitcnt vmcnt(0)" ::: "memory");
    __syncthreads();
    if (threadIdx.x == 0) {
        unsigned* bar = b.bar;
        __builtin_amdgcn_s_waitcnt(0);
        unsigned nloc = b.st[0], nx = b.st[1];
        if (nloc == 0u) { xcd_barrier_complete(bar, b.x, nloc, nx); b.st[0] = nloc; b.st[1] = nx; }
        const unsigned old = xb_add(&bar[XB_XSUB(b.x)], 1u);
        const unsigned gen = old / nloc;
        if (old + 1u == (gen + 1u) * nloc) {
            __builtin_amdgcn_fence(__ATOMIC_RELEASE, "agent");
            asm volatile("s_waitcnt vmcnt(0)" ::: "memory");
            const unsigned og = xb_add(&bar[XB_TOP], 1u);
            const unsigned tg = og / nx;
            if (og + 1u == (tg + 1u) * nx) xb_add(&bar[XB_TOPGEN], 1u);
            else XB_SPIN(xb_ld(&bar[XB_TOPGEN]) == tg, bar);
            __builtin_amdgcn_fence(__ATOMIC_ACQUIRE, "agent");
            xb_add(&bar[XB_XGEN(b.x)], 1u);
            asm volatile("s_waitcnt vmcnt(0)" ::: "memory");
        } else {
            XB_SPIN(xb_ld(&bar[XB_XGEN(b.x)]) == gen, bar);
            __builtin_amdgcn_fence(__ATOMIC_ACQUIRE, "agent");
            asm volatile("s_waitcnt vmcnt(0)" ::: "memory");
        }
    }
    __syncthreads();
}

struct Frame {
    LAS unsigned char* lds;
    int tid, lane, wave, vcu, G;
};
struct Args {
    const float *x, *c, *w_ada, *b_ada, *g_pre_mix, *g_post_mix, *g_pre_mlp, *g_post_mlp, *w_in, *sinks, *w_bg, *b_bg, *w_ps, *w_pb, *w_out, *w_f1, *w_f2;
    float* out; unsigned char* ws; int ph_lo, ph_hi;
};

__device__ __forceinline__ float wave_sum(float v) {
#pragma unroll
    for (int o = 1; o < 64; o <<= 1) v += __shfl_xor(v, o);
    return v;
}
__device__ const double ROPE_INVF[64] = {1.0, 0.8659643233600653, 0.7498942093324559, 0.6493816315762113, 0.5623413251903491, 0.4869675251658631, 0.4216965034285822, 0.3651741272548377, 0.31622776601683794, 0.27384196342643613, 0.23713737056616552, 0.2053525026457146, 0.1778279410038923, 0.1539926526059492, 0.1333521432163324, 0.11547819846894582, 0.1, 0.08659643233600653, 0.07498942093324558, 0.06493816315762113, 0.05623413251903491, 0.04869675251658631, 0.042169650342858224, 0.03651741272548377, 0.03162277660168379, 0.027384196342643614, 0.023713737056616554, 0.02053525026457146, 0.01778279410038923, 0.01539926526059492, 0.01333521432163324, 0.011547819846894581, 0.01, 0.008659643233600654, 0.007498942093324558, 0.006493816315762113, 0.005623413251903491, 0.004869675251658631, 0.004216965034285823, 0.003651741272548377, 0.0031622776601683794, 0.0027384196342643613, 0.0023713737056616554, 0.002053525026457146, 0.0017782794100389228, 0.001539926526059492, 0.001333521432163324, 0.0011547819846894581, 0.001, 0.0008659643233600654, 0.0007498942093324559, 0.0006493816315762113, 0.0005623413251903491, 0.0004869675251658631, 0.00042169650342858224, 0.0003651741272548377, 0.00031622776601683794, 0.0002738419634264361, 0.00023713737056616554, 0.0002053525026457146, 0.00017782794100389227, 0.0001539926526059492, 0.0001333521432163324, 0.00011547819846894582};

struct TDesc { const float* W; bf16* WT; int K, N, row_off, rope_lim, item, fp8; };
__device__ __forceinline__ void p0_tr_load(const TDesc& t, f32x4 (&v)[16], int lane) {
    const int nblk = t.N / 64, kb = t.item / nblk, nb = t.item % nblk, k0 = 64 * kb, n0 = 64 * nb;
    const int kq = lane >> 4, nn = 4 * (lane & 15);
#pragma unroll
    for (int i = 0; i < 16; ++i) v[i] = *(const f32x4*)(t.W + (size_t)(k0 + 4 * i + kq) * t.N + n0 + nn);
}
__device__ __forceinline__ void p0_tr_store(const TDesc& t, const f32x4 (&v)[16], LAS float* scr, int lane) {
    const int nblk = t.N / 64, kb = t.item / nblk, nb = t.item % nblk, k0 = 64 * kb, n0 = 64 * nb;
    const int kq = lane >> 4, nn = 4 * (lane & 15);
#pragma unroll
    for (int i = 0; i < 16; ++i) { LAS float* s = scr + (4 * i + kq) * 65 + nn; s[0] = v[i].x; s[1] = v[i].y; s[2] = v[i].z; s[3] = v[i].w; }
    LDS_WAIT(); asm volatile("" ::: "memory");
    const int c = lane & 7;
#pragma unroll
    for (int j = 0; j < 8; ++j) { const int n = (lane >> 3) + 8 * j; const LAS float* s = scr + (8 * c) * 65 + n;
        v4u o; o.x = pk2(s[0 * 65], s[1 * 65]); o.y = pk2(s[2 * 65], s[3 * 65]); o.z = pk2(s[4 * 65], s[5 * 65]); o.w = pk2(s[6 * 65], s[7 * 65]);
        int nd = n0 + n;
        if (t.rope_lim) {
            int sb_, sd_; bool rp_ = false;
            if (nd < 2048) { sb_ = 0; sd_ = 3072; rp_ = true; } else if (nd < 2560) { sb_ = 2048; sd_ = 0; rp_ = true; } else if (nd < 3072) { sb_ = 2560; sd_ = 512; }
            else if (nd < 5120) { sb_ = 3072; sd_ = 5120; } else if (nd < 7168) { sb_ = 5120; sd_ = 7168; } else { sb_ = 7168; sd_ = 1024; }
            int loc = nd - sb_; if (rp_) { const int d = loc & 127; loc = (loc & ~127) + (d < 64 ? 8 * (d >> 2) + (d & 3) : 8 * ((d - 64) >> 2) + 4 + (d & 3)); }
            nd = sd_ + loc; }
        *(v4u*)(t.WT + (size_t)(t.row_off + nd) * t.K + k0 + 8 * c) = o; }
    LDS_WAIT(); asm volatile("" ::: "memory");
}
__device__ __forceinline__ void p0_gemv(Frame& F, const Args& a, float* mod) {
    LAS f32x4* cact = (LAS f32x4*)F.lds;
    LAS float* red = (LAS float*)(F.lds + 65536);
    for (int k = F.tid; k < D; k += NWAVES * 64) { f32x4 v;
#pragma unroll
        for (int b = 0; b < 4; ++b) { const float xx = a.c[b * D + k]; v[b] = xx / (1.f + expf(-xx)); }
        cact[k] = v; }
    __syncthreads();
    const int half = F.lane >> 5, l32 = F.lane & 31; const bool act = l32 < 24;
    for (int cg = F.vcu; cg < NMOD / 96; cg += F.G) {
        f32x4 acc[4];
#pragma unroll
        for (int b = 0; b < 4; ++b) acc[b] = (f32x4){0.f, 0.f, 0.f, 0.f};
        const int kbase = 512 * F.wave + half;
        const float* wp = a.w_ada + (size_t)kbase * NMOD + 96 * cg + 4 * (act ? l32 : 0);
#define GV_LOAD(w, kk) _Pragma("unroll") for (int u = 0; u < 16; ++u) w[u] = *(const f32x4*)(wp + (size_t)(2 * ((kk) + u)) * NMOD)
#define GV_FMA(w, kk) _Pragma("unroll") for (int u = 0; u < 16; ++u) { const f32x4 ca = cact[kbase + 2 * ((kk) + u)]; _Pragma("unroll") for (int b = 0; b < 4; ++b) acc[b] += w[u] * ca[b]; }
        f32x4 wA[16], wB[16];
        GV_LOAD(wA, 0);
#pragma unroll 1
        for (int kk = 0; kk < 224; kk += 32) {
            GV_LOAD(wB, kk + 16); asm volatile("" ::: "memory");
            GV_FMA(wA, kk);
            GV_LOAD(wA, kk + 32); asm volatile("" ::: "memory");
            GV_FMA(wB, kk + 16);
        }
        GV_LOAD(wB, 240); asm volatile("" ::: "memory");
        GV_FMA(wA, 224);
        GV_FMA(wB, 240);
#undef GV_LOAD
#undef GV_FMA
#pragma unroll
        for (int b = 0; b < 4; ++b)
#pragma unroll
            for (int j = 0; j < 4; ++j) acc[b][j] += __shfl_xor(acc[b][j], 32);
        if (half == 0 && act) {
#pragma unroll
            for (int b = 0; b < 4; ++b) *(LAS f32x4*)(red + (F.wave * 4 + b) * 96 + 4 * l32) = acc[b]; }
        __syncthreads();
        if (F.tid < 384) { const int b = F.tid / 96, j = F.tid % 96; float s = 0.f;
#pragma unroll
            for (int w = 0; w < 8; ++w) s += red[(w * 4 + b) * 96 + j];
            mod[b * NMOD + 96 * cg + j] = s + a.b_ada[96 * cg + j]; }
        __syncthreads();
    }
}
__device__ __forceinline__ void p0_rope_table(Frame& F, float* cosT, float* sinT) {
    const double TWO_PI_HI = 6.283185307179586232, TWO_PI_LO = 2.4492935982947064e-16, INV_2PI = 0.15915494309189533577;
    for (int idx = F.vcu * (NWAVES * 64) + F.tid; idx < SEQ * 64; idx += F.G * NWAVES * 64) {
        const int pos = idx >> 6, i = idx & 63;
        const double ang = (double)pos * ROPE_INVF[i];
        const double n = __builtin_rint(ang * INV_2PI);
        double r = __builtin_fma(-n, TWO_PI_HI, ang); r = __builtin_fma(-n, TWO_PI_LO, r);
        const double r2 = r * r; double tc = 1.0, ts = r, sc = 1.0, ss = r;
#pragma unroll 1
        for (int k = 1; k <= 15; ++k) { tc *= -r2 / (double)((2 * k - 1) * (2 * k)); ts *= -r2 / (double)((2 * k) * (2 * k + 1)); sc += tc; ss += ts; }
        cosT[idx] = (float)sc; sinT[idx] = (float)ss;
    }
}

__device__ __forceinline__ f32x4 ld_bf4(const bf16* p) { const v2u w = *(const v2u*)p; return (f32x4){__uint_as_float(w.x << 16), __uint_as_float(w.x & 0xffff0000u), __uint_as_float(w.y << 16), __uint_as_float(w.y & 0xffff0000u)}; }
__device__ __forceinline__ void st_bf4(bf16* p, f32x4 v) { v2u w; w.x = pk2(v.x, v.y); w.y = pk2(v.z, v.w); *(v2u*)p = w; }
__device__ __forceinline__ float sumsq4(f32x4 v) { return (v.x * v.x + v.y * v.y) + (v.z * v.z + v.w * v.w); }

#define LAUNDER_PTR(p) asm volatile("" : "+s"(p))
__device__ __forceinline__ float wave_max(float v) {
#pragma unroll
    for (int o = 1; o < 64; o <<= 1) v = fmaxf(v, __shfl_xor(v, o));
    return v;
}
__device__ __forceinline__ float amax4(f32x4 v) { return fmaxf(fmaxf(__builtin_fabsf(v.x), __builtin_fabsf(v.y)), fmaxf(__builtin_fabsf(v.z), __builtin_fabsf(v.w))); }
__device__ __forceinline__ unsigned q4_i8(f32x4 v, float inv) {
    const int a = (int)__builtin_rintf(v.x * inv), b = (int)__builtin_rintf(v.y * inv), c = (int)__builtin_rintf(v.z * inv), d = (int)__builtin_rintf(v.w * inv);
    return (unsigned)(a & 255) | ((unsigned)(b & 255) << 8) | ((unsigned)(c & 255) << 16) | ((unsigned)d << 24); }
constexpr int SLAB_PITCH = 8192 + 16;
struct SDesc { const float* W; unsigned char* dst; float* sc; int N, c0, r0, rope; };
template <int H> __device__ __forceinline__ void slab_load(const SDesc& s, f32x4 (&va)[8], f32x4 (&vb)[8], int tid) {
    const float* p = s.W + (size_t)(2 * (tid >> 2) + 2048 * H) * s.N + s.c0 + 4 * (tid & 3);
#pragma unroll
    for (int i = 0; i < 8; ++i) { const float* q = p + (size_t)(256 * i) * s.N; va[i] = *(const f32x4*)q; vb[i] = *(const f32x4*)(q + s.N); }
}
template <int H> __device__ __forceinline__ void slab_stage(LAS unsigned char* lds, const f32x4 (&va)[8], const f32x4 (&vb)[8], int tid) {
    LAS unsigned char* t = lds + (4 * (tid & 3)) * SLAB_PITCH + 4 * (tid >> 2) + 4096 * H;
#pragma unroll
    for (int i = 0; i < 8; ++i)
#pragma unroll
        for (int j = 0; j < 4; ++j) *(LAS unsigned*)(t + j * SLAB_PITCH + 512 * i) = pg8::cvt_pk_bf16(va[i][j], vb[i][j]);
}
__device__ __forceinline__ void slab_quant(const SDesc& s, const LAS unsigned char* lds, int wave, int lane) {
#pragma unroll 1
    for (int rr = 0; rr < 2; ++rr) { const int n = 2 * wave + rr;
        v4u w[8]; float am = 0.f;
#pragma unroll
        for (int j = 0; j < 8; ++j) w[j] = *(const LAS v4u*)(lds + n * SLAB_PITCH + 16 * (lane + 64 * j));
#pragma unroll
        for (int j = 0; j < 8; ++j)
#pragma unroll
            for (int e = 0; e < 4; ++e) { const unsigned x = w[j][e]; am = fmaxf(am, fmaxf(__builtin_fabsf(__uint_as_float(x << 16)), __builtin_fabsf(__uint_as_float(x & 0xffff0000u)))); }
        am = wave_max(am); const float inv = am > 0.f ? 127.f / am : 0.f;
        int loc = s.c0 + n; if (s.rope) { const int d = loc & 127; loc = (loc & ~127) + (d < 64 ? 8 * (d >> 2) + (d & 3) : 8 * ((d - 64) >> 2) + 4 + (d & 3)); }
        const int drow = s.r0 + loc;
        if (lane == 0) s.sc[drow] = am * (1.f / 127.f);
#pragma unroll
        for (int j = 0; j < 8; ++j) { v2u o;
            o.x = q4_i8((f32x4){__uint_as_float(w[j].x << 16), __uint_as_float(w[j].x & 0xffff0000u), __uint_as_float(w[j].y << 16), __uint_as_float(w[j].y & 0xffff0000u)}, inv);
            o.y = q4_i8((f32x4){__uint_as_float(w[j].z << 16), __uint_as_float(w[j].z & 0xffff0000u), __uint_as_float(w[j].w << 16), __uint_as_float(w[j].w & 0xffff0000u)}, inv);
            *(v2u*)(s.dst + (size_t)drow * D + 8 * (lane + 64 * j)) = o; }
    }
}
__device__ __forceinline__ void ks_quant(const LAS unsigned char* lds, unsigned char* dst, float* sc, int* csum, int cs, int q, unsigned mb0, unsigned mb1, int wave, int lane) {
#pragma unroll 1
    for (int rr = 0; rr < 2; ++rr) { const int n = 2 * wave + rr, col = 16 * cs + n;
        v4u w[8];
#pragma unroll
        for (int j = 0; j < 8; ++j) w[j] = *(const LAS v4u*)(lds + n * SLAB_PITCH + 16 * (lane + 64 * j));
        const float am = __uint_as_float(rr ? mb1 : mb0), inv = am > 0.f ? 127.f / am : 0.f;
        if (lane == 0 && q == 0) sc[col] = am * (1.f / 127.f);
        float qs = 0.f;
#pragma unroll
        for (int j = 0; j < 8; ++j) { v2u o; float t[8];
#pragma unroll
            for (int e = 0; e < 4; ++e) { const unsigned x = w[j][e]; t[2 * e] = __builtin_rintf(__uint_as_float(x << 16) * inv); t[2 * e + 1] = __builtin_rintf(__uint_as_float(x & 0xffff0000u) * inv); }
#pragma unroll
            for (int e = 0; e < 8; ++e) qs += t[e];
            o.x = ((unsigned)(int)t[0] & 255u) | (((unsigned)(int)t[1] & 255u) << 8) | (((unsigned)(int)t[2] & 255u) << 16) | ((unsigned)(int)t[3] << 24);
            o.y = ((unsigned)(int)t[4] & 255u) | (((unsigned)(int)t[5] & 255u) << 8) | (((unsigned)(int)t[6] & 255u) << 16) | ((unsigned)(int)t[7] << 24);
            *(v2u*)(dst + (size_t)col * FF + 4096 * q + 8 * (lane + 64 * j)) = o; }
        qs = wave_sum(qs);
        if (lane == 0) atomicAdd(csum + col, (int)qs);
    }
}
__device__ __forceinline__ void p1_rows(Frame& F, const Args& a, const float* mod, bf16* H, unsigned char* H8, float* SH) {
    int lane_ = F.lane; asm volatile("" : "+v"(lane_)); const int LN = lane_;
    const int gw = F.vcu * NWAVES + F.wave, NGW = F.G * NWAVES;
    for (int r0 = gw * 8; r0 < M; r0 += NGW * 8) {
        const int b = r0 >> 12;
#pragma unroll 1
        for (int r = 0; r < 8; ++r) { const size_t row = (size_t)(r0 + r);
            const float* mb = mod + b * NMOD; const float* gp = a.g_pre_mix; LAUNDER_PTR(mb); LAUNDER_PTR(gp);
            f32x4 v[16]; float ss = 0.f;
#pragma unroll
            for (int j = 0; j < 16; ++j) { v[j] = *(const f32x4*)(a.x + row * D + 4 * LN + 256 * j); ss += sumsq4(v[j]); }
            const float rstd = 1.f / sqrtf(wave_sum(ss) * (1.f / D) + NORM_EPS);
            float am = 0.f;
#pragma unroll
            for (int j = 0; j < 16; ++j) { const int col = 4 * LN + 256 * j; if ((j & 3) == 0) asm volatile("" ::: "memory");
                const f32x4 av = *(const GAS f32x4*)(gp + col) * (*(const GAS f32x4*)(mb + D + col) + 1.f);
                v[j] = v[j] * rstd * av + *(const GAS f32x4*)(mb + col);
                st_bf4(H + row * D + col, v[j]); am = fmaxf(am, amax4(v[j])); }
            am = wave_max(am); const float inv = am > 0.f ? 127.f / am : 0.f;
            if (LN == 0) SH[row] = am * (1.f / 127.f);
#pragma unroll
            for (int j = 0; j < 16; ++j) *(unsigned*)(H8 + row * D + 4 * LN + 256 * j) = q4_i8(v[j], inv);
        }
    }
}
__device__ __forceinline__ void quant_rows(Frame& F, const bf16* __restrict__ src, unsigned char* __restrict__ dst, float* __restrict__ sc, int nrows) {
    int lane_ = F.lane; asm volatile("" : "+v"(lane_)); const int LN = lane_;
    const int gw = F.vcu * NWAVES + F.wave, NGW = F.G * NWAVES;
#pragma unroll 1
    for (int n = gw; n < nrows; n += NGW) {
        v4u w[8]; float am = 0.f;
#pragma unroll
        for (int j = 0; j < 8; ++j) w[j] = *(const v4u*)(src + (size_t)n * D + 8 * (LN + 64 * j));
#pragma unroll
        for (int j = 0; j < 8; ++j) {
#pragma unroll
            for (int e = 0; e < 4; ++e) { const unsigned x = w[j][e]; am = fmaxf(am, fmaxf(__builtin_fabsf(__uint_as_float(x << 16)), __builtin_fabsf(__uint_as_float(x & 0xffff0000u)))); } }
        am = wave_max(am); const float inv = am > 0.f ? 127.f / am : 0.f;
        if (LN == 0) sc[n] = am * (1.f / 127.f);
#pragma unroll
        for (int j = 0; j < 8; ++j) { v2u o;
            o.x = q4_i8((f32x4){__uint_as_float(w[j].x << 16), __uint_as_float(w[j].x & 0xffff0000u), __uint_as_float(w[j].y << 16), __uint_as_float(w[j].y & 0xffff0000u)}, inv);
            o.y = q4_i8((f32x4){__uint_as_float(w[j].z << 16), __uint_as_float(w[j].z & 0xffff0000u), __uint_as_float(w[j].w << 16), __uint_as_float(w[j].w & 0xffff0000u)}, inv);
            *(v2u*)(dst + (size_t)n * D + 8 * (LN + 64 * j)) = o; }
    }
}
__device__ __forceinline__ void quant_rows_long(Frame& F, const bf16* __restrict__ src, unsigned char* __restrict__ dst, float* __restrict__ sc, int* __restrict__ csum, int nrows) {
    int lane_ = F.lane; asm volatile("" : "+v"(lane_)); const int LN = lane_;
    const int gw = F.vcu * NWAVES + F.wave, NGW = F.G * NWAVES;
#pragma unroll 1
    for (int n = gw; n < nrows; n += NGW) {
        float am = 0.f;
#pragma unroll 1
        for (int c = 0; c < 4; ++c) { v4u w[8];
#pragma unroll
            for (int j = 0; j < 8; ++j) w[j] = *(const v4u*)(src + (size_t)n * FF + c * 4096 + 8 * (LN + 64 * j));
#pragma unroll
            for (int j = 0; j < 8; ++j)
#pragma unroll
                for (int e = 0; e < 4; ++e) { const unsigned x = w[j][e]; am = fmaxf(am, fmaxf(__builtin_fabsf(__uint_as_float(x << 16)), __builtin_fabsf(__uint_as_float(x & 0xffff0000u)))); } }
        am = wave_max(am); const float inv = am > 0.f ? 127.f / am : 0.f;
        float qs = 0.f;
#pragma unroll 1
        for (int c = 0; c < 4; ++c) { v4u w[8];
#pragma unroll
            for (int j = 0; j < 8; ++j) w[j] = *(const v4u*)(src + (size_t)n * FF + c * 4096 + 8 * (LN + 64 * j));
#pragma unroll
            for (int j = 0; j < 8; ++j) { v2u o; float t[8];
#pragma unroll
                for (int e = 0; e < 4; ++e) { const unsigned x = w[j][e]; t[2 * e] = __builtin_rintf(__uint_as_float(x << 16) * inv); t[2 * e + 1] = __builtin_rintf(__uint_as_float(x & 0xffff0000u) * inv); }
#pragma unroll
                for (int e = 0; e < 8; ++e) qs += t[e];
                o.x = ((unsigned)(int)t[0] & 255u) | (((unsigned)(int)t[1] & 255u) << 8) | (((unsigned)(int)t[2] & 255u) << 16) | ((unsigned)(int)t[3] << 24);
                o.y = ((unsigned)(int)t[4] & 255u) | (((unsigned)(int)t[5] & 255u) << 8) | (((unsigned)(int)t[6] & 255u) << 16) | ((unsigned)(int)t[7] << 24);
                *(v2u*)(dst + (size_t)n * FF + c * 4096 + 8 * (LN + 64 * j)) = o; } }
        qs = wave_sum(qs);
        if (LN == 0) { sc[n] = am * (1.f / 127.f); csum[n] = (int)qs; }
    }
}
__device__ __forceinline__ void requant_u(Frame& F, const bf16* __restrict__ U, unsigned char* __restrict__ U8, float* __restrict__ su) {
    int lane_ = F.lane; asm volatile("" : "+v"(lane_)); const int LN = lane_;
    LAS float* red = (LAS float*)(F.lds + RING_OFF);
    const int q = F.wave & 3, half = F.wave >> 2;
    const size_t coff = (size_t)q * 4096 + 8 * LN;
#define RQ_LOAD(w, r) _Pragma("unroll") for (int j = 0; j < 8; ++j) w[j] = *(const v4u*)(U + (size_t)(r) * FF + coff + 512 * j)
    v4u wc[8], wn[8];
    if (F.vcu < M / 2) RQ_LOAD(wc, 2 * F.vcu + half);
#pragma unroll 1
    for (int pi = F.vcu, p = 0; pi < M / 2; pi += F.G, ++p) { const int r = 2 * pi + half, rn = 2 * (pi + F.G < M / 2 ? pi + F.G : pi) + half;
        float am = 0.f;
#pragma unroll
        for (int j = 0; j < 8; ++j)
#pragma unroll
            for (int e = 0; e < 4; ++e) { const unsigned x = wc[j][e]; am = fmaxf(am, fmaxf(__uint_as_float(x << 16), __uint_as_float(x & 0xffff0000u))); }
        am = wave_max(am);
        if (LN == 0) red[(p & 1) * 8 + F.wave] = am;
        RQ_LOAD(wn, rn);
        __syncthreads();
        { const LAS float* rp = red + (p & 1) * 8 + 4 * half; am = fmaxf(fmaxf(rp[0], rp[1]), fmaxf(rp[2], rp[3])); }
        const float inv = am > 0.f ? 255.f / am : 0.f;
        if (LN == 0 && q == 0) su[r] = am * (1.f / 255.f);
#pragma unroll
        for (int j = 0; j < 8; ++j) { v2u o; int t[8];
#pragma unroll
            for (int e = 0; e < 4; ++e) { const unsigned x = wc[j][e]; t[2 * e] = (int)__builtin_rintf(__uint_as_float(x << 16) * inv) - 128; t[2 * e + 1] = (int)__builtin_rintf(__uint_as_float(x & 0xffff0000u) * inv) - 128; }
            o.x = ((unsigned)t[0] & 255u) | (((unsigned)t[1] & 255u) << 8) | (((unsigned)t[2] & 255u) << 16) | ((unsigned)t[3] << 24);
            o.y = ((unsigned)t[4] & 255u) | (((unsigned)t[5] & 255u) << 8) | (((unsigned)t[6] & 255u) << 16) | ((unsigned)t[7] << 24);
            *(v2u*)(U8 + (size_t)r * FF + coff + 512 * j) = o; }
#pragma unroll
        for (int j = 0; j < 8; ++j) wc[j] = wn[j];
    }
#undef RQ_LOAD
    __syncthreads();
}
__device__ __forceinline__ f32x4 unpk4(v2u w) { return (f32x4){__uint_as_float(w.x << 16), __uint_as_float(w.x & 0xffff0000u), __uint_as_float(w.y << 16), __uint_as_float(w.y & 0xffff0000u)}; }
__device__ __forceinline__ void p6_rows(Frame& F, const Args& a, const float* mod, const bf16* MX, unsigned char* H2, float* S2) {
    int lane_ = F.lane; asm volatile("" : "+v"(lane_)); const int LN = lane_;
    const int gw = F.vcu * NWAVES + F.wave, NGW = F.G * NWAVES;
    for (int r0 = gw * 8; r0 < M; r0 += NGW * 8) {
        const int b = r0 >> 12;
#pragma unroll 1
        for (int r = 0; r < 8; ++r) { const size_t row = (size_t)(r0 + r);
            const float* mb = mod + b * NMOD; LAUNDER_PTR(mb);
            v2u mp[16]; f32x4 xr[16]; float ss = 0.f;
#pragma unroll
            for (int j = 0; j < 16; ++j) mp[j] = *(const v2u*)(MX + row * D + 4 * LN + 256 * j);
#pragma unroll
            for (int j = 0; j < 16; ++j) xr[j] = *(const f32x4*)(a.x + row * D + 4 * LN + 256 * j);
#pragma unroll
            for (int j = 0; j < 16; ++j) ss += sumsq4(unpk4(mp[j]));
            const float rstd = 1.f / sqrtf(wave_sum(ss) * (1.f / D) + NORM_EPS);
            float ss2 = 0.f;
#pragma unroll
            for (int j = 0; j < 16; ++j) { const int col = 4 * LN + 256 * j; if ((j & 3) == 0) asm volatile("" ::: "memory");
                const f32x4 g1 = *(const GAS f32x4*)(mb + 2 * D + col) * *(const f32x4*)(a.g_post_mix + col);
                xr[j] = xr[j] + g1 * (unpk4(mp[j]) * rstd);
                *(f32x4*)(a.out + row * D + col) = xr[j]; ss2 += sumsq4(xr[j]); }
            const float rstd2 = 1.f / sqrtf(wave_sum(ss2) * (1.f / D) + NORM_EPS);
            float am = 0.f;
#pragma unroll
            for (int j = 0; j < 16; ++j) { const int col = 4 * LN + 256 * j; if ((j & 3) == 0) asm volatile("" ::: "memory");
                const f32x4 a2 = *(const f32x4*)(a.g_pre_mlp + col) * (*(const GAS f32x4*)(mb + 4 * D + col) + 1.f);
                xr[j] = xr[j] * rstd2 * a2 + *(const GAS f32x4*)(mb + 3 * D + col); am = fmaxf(am, amax4(xr[j])); }
            am = wave_max(am); const float inv = am > 0.f ? 127.f / am : 0.f;
            if (LN == 0) S2[row] = am * (1.f / 127.f);
#pragma unroll
            for (int j = 0; j < 16; ++j) *(unsigned*)(H2 + row * D + 4 * LN + 256 * j) = q4_i8(xr[j], inv);
        }
    }
}
__device__ __forceinline__ void p9_rows(Frame& F, const Args& a, const float* mod, const bf16* FB) {
    int lane_ = F.lane; asm volatile("" : "+v"(lane_)); const int LN = lane_;
    const int gw = F.vcu * NWAVES + F.wave, NGW = F.G * NWAVES;
    for (int r0 = gw * 8; r0 < M; r0 += NGW * 8) {
        const int b = r0 >> 12;
#pragma unroll 1
        for (int r = 0; r < 8; ++r) { const size_t row = (size_t)(r0 + r);
            const float* mb = mod + b * NMOD; LAUNDER_PTR(mb);
            v2u mp[16]; f32x4 xr[16]; float ss = 0.f;
#pragma unroll
            for (int j = 0; j < 16; ++j) mp[j] = *(const v2u*)(FB + row * D + 4 * LN + 256 * j);
#pragma unroll
            for (int j = 0; j < 16; ++j) xr[j] = *(const f32x4*)(a.out + row * D + 4 * LN + 256 * j);
#pragma unroll
            for (int j = 0; j < 16; ++j) ss += sumsq4(unpk4(mp[j]));
            const float rstd = 1.f / sqrtf(wave_sum(ss) * (1.f / D) + NORM_EPS);
#pragma unroll
            for (int j = 0; j < 16; ++j) { const int col = 4 * LN + 256 * j; if ((j & 3) == 0) asm volatile("" ::: "memory");
                const f32x4 g2 = *(const GAS f32x4*)(mb + 5 * D + col) * *(const f32x4*)(a.g_post_mlp + col);
                *(f32x4*)(a.out + row * D + col) = xr[j] + g2 * (unpk4(mp[j]) * rstd); }
        }
    }
}

#ifndef P7_NT
#define P7_NT false
#endif
#ifndef P8_WGM
#define P8_WGM 8
#endif
#ifndef SB_EARLY
#define SB_EARLY 1
#endif
__global__ void __launch_bounds__(NWAVES * 64, 2) fwd_kernel(Args args) {
    extern __shared__ __attribute__((aligned(16))) unsigned char lds[];
    Frame F;
    F.lds = (LAS unsigned char*)lds;
    F.tid = threadIdx.x; F.lane = F.tid & 63; F.wave = __builtin_amdgcn_readfirstlane(F.tid >> 6);
    F.G = gridDim.x; { const int bx = blockIdx.x; F.vcu = (F.G % 8 == 0) ? (bx % 8) * (F.G / 8) + bx / 8 : bx; }
    unsigned char* ws = args.ws;
    unsigned* ctl = (unsigned*)(ws + WS_CTL);
    float* mod = (float*)(ws + WS_MOD); float* cosT = (float*)(ws + WS_COS); float* sinT = (float*)(ws + WS_SIN);
    bf16* W1 = (bf16*)(ws + WS_W1); bf16* WPS = (bf16*)(ws + WS_WPS); bf16* WPB = (bf16*)(ws + WS_WPB); bf16* WO = (bf16*)(ws + WS_WO); bf16* WF1 = (bf16*)(ws + WS_WF1); bf16* WF2 = (bf16*)(ws + WS_WF2);
    bf16* BA = (bf16*)(ws + WS_A); bf16* BB = (bf16*)(ws + WS_B); unsigned char* H8 = ws + WS_H8; unsigned char* W8G = ws + WS_W8G; unsigned char* W8F = ws + WS_W8F;
    float* SH = (float*)(ws + WS_SH); float* S2 = (float*)(ws + WS_S2); float* SG = (float*)(ws + WS_SG); float* SF = (float*)(ws + WS_SF);
    unsigned char* W8O = ws + WS_W8O; unsigned char* U8 = ws + WS_U8; float* SU = (float*)(ws + WS_SU); float* SO = (float*)(ws + WS_SO); int* CO = (int*)(ws + WS_CO);
    bf16* QA = (bf16*)(ws + WS_C); bf16* KA = (bf16*)(ws + WS_C + 64 * MiB); bf16* VA = (bf16*)(ws + WS_C + 80 * MiB); bf16* QB = (bf16*)(ws + WS_C + 96 * MiB);
    bf16* KB = (bf16*)(ws + WS_C + 160 * MiB); bf16* VB = (bf16*)(ws + WS_C + 224 * MiB); bf16* GT = (bf16*)(ws + WS_C + 288 * MiB); bf16* UB = (bf16*)(ws + WS_C);
    bf16* ATT_SWA = BB; bf16* ATT_SB = BB + (size_t)M * 2048;
    for (int u = F.tid; u < (LDS_BYTES - LDSCTL_OFF) / 4; u += NWAVES * 64) ((LAS unsigned*)(F.lds + LDSCTL_OFF))[u] = 0u;
    __syncthreads();
    XcdBarrier bar = xcd_barrier_post(ctl + CW_BAR, (volatile LAS unsigned*)(F.lds + MISC_OFF) + 8);

    const int lo = args.ph_lo, hi = args.ph_hi;
#define IN(k) (lo <= (k) && (k) < hi)
#define BOTH(k) (IN(k) && IN((k) + 1))
    for (int rep_ = 0; rep_ < ((DUP_PHASE == 0) ? 2 : 1); ++rep_) if (IN(0)) {
        if (rep_) xcd_barrier(bar);
    {
        for (int sr_ = 0; sr_ < ((DUP_SUB == 3) ? 2 : 1); ++sr_) p0_gemv(F, args, mod);
        p0_rope_table(F, cosT, sinT);
        {
            constexpr int NSLAB = 1920;
#define SLAB_DECODE(sd, s_) do { int q_ = (s_); \
                if (q_ < 128) { sd = SDesc{args.w_in, W8G, SG, D_IN, 16 * q_, 0, 1}; break; } q_ -= 128; \
                if (q_ < 256) { sd = SDesc{args.w_in, W8G, SG, D_IN, 3072 + 16 * q_, 2048 - 3072, 0}; break; } q_ -= 256; \
                if (q_ < 512) { sd = SDesc{args.w_bg, W8G, SG, NG, 16 * q_, 6144, 0}; break; } q_ -= 512; \
                sd = SDesc{args.w_f1, W8F, SF, FF, 16 * q_, 0, 0}; } while (0)
            int stid = F.tid; asm volatile("" : "+v"(stid)); const int slane = stid & 63, swave = __builtin_amdgcn_readfirstlane(stid >> 6);
            const int nmine = 7 + ((F.G == 256 && F.vcu >= 128) ? 1 : 0);
            auto slab_of = [&](int i) -> int { if (F.G == 256) return i < 7 ? 256 * i + F.vcu : 1792 + F.vcu - 128; return F.vcu + i * F.G; };
            auto have = [&](int i) -> bool { if (F.G == 256) return i < nmine; return F.vcu + i * F.G < NSLAB; };
            for (int sr_ = 0; sr_ < ((DUP_SUB == 1) ? 2 : 1); ++sr_) if (have(0)) {
                SDesc sc_; SLAB_DECODE(sc_, slab_of(0)); f32x4 va0[8], vb0[8], va1[8], vb1[8]; slab_load<0>(sc_, va0, vb0, stid); slab_load<1>(sc_, va1, vb1, stid);
                for (int i = 0;; ++i) {
                    const bool more = have(i + 1); SDesc sn_ = sc_; if (more) SLAB_DECODE(sn_, slab_of(i + 1));
                    slab_stage<0>(F.lds, va0, vb0, stid); asm volatile("" ::: "memory");
                    if (more) slab_load<0>(sn_, va0, vb0, stid);
                    asm volatile("" ::: "memory");
                    slab_stage<1>(F.lds, va1, vb1, stid); asm volatile("" ::: "memory");
                    if (more) slab_load<1>(sn_, va1, vb1, stid);
                    __syncthreads();
                    slab_quant(sc_, F.lds, swave, slane);
                    __syncthreads();
                    if (!more) break;
                    sc_ = sn_;
                }
            }
#undef SLAB_DECODE
            {
                unsigned* kcnt = ctl + CW_KS; unsigned* cmx = (unsigned*)(ws + WS_CMX);
                int it = F.vcu;
                if (it < 1024) {
                    SDesc sc_{args.w_f2 + (size_t)(it & 3) * 4096 * D, W8O, SO, D, 16 * (it >> 2), 0, 0};
                    f32x4 va0[8], vb0[8], va1[8], vb1[8]; slab_load<0>(sc_, va0, vb0, stid); slab_load<1>(sc_, va1, vb1, stid);
                    for (;;) {
                        const int cs = it >> 2, q = it & 3, itn = it + F.G; const bool more = itn < 1024;
                        slab_stage<0>(F.lds, va0, vb0, stid); slab_stage<1>(F.lds, va1, vb1, stid);
                        __syncthreads();
                        {
                            unsigned got = 0u;
#pragma unroll 1
                            for (int rr = 0; rr < 2; ++rr) { const int n = 2 * swave + rr; float am = 0.f;
#pragma unroll
                                for (int j = 0; j < 8; ++j) { const v4u w = *(const LAS v4u*)(F.lds + n * SLAB_PITCH + 16 * (slane + 64 * j));
#pragma unroll
                                    for (int e = 0; e < 4; ++e) { const unsigned x = w[e]; am = fmaxf(am, fmaxf(__builtin_fabsf(__uint_as_float(x << 16)), __builtin_fabsf(__uint_as_float(x & 0xffff0000u)))); } }
                                am = wave_max(am);
                                if (slane == 0) got |= atomicMax(cmx + 16 * cs + n, __float_as_uint(am)); }
                            asm volatile("" :: "v"(got));
                        }
                        asm volatile("s_waitcnt vmcnt(0)" ::: "memory");
                        __syncthreads();
                        if (stid == 0) { (void)xb_add(&kcnt[cs], 1u); XB_SPIN(xb_ld(&kcnt[cs]) < 4u, ctl + CW_BAR); }
                        __syncthreads();
                        const unsigned mb0 = xb_ld(cmx + 16 * cs + 2 * swave), mb1 = xb_ld(cmx + 16 * cs + 2 * swave + 1);
                        SDesc sn_ = sc_;
                        if (more) { sn_ = SDesc{args.w_f2 + (size_t)(itn & 3) * 4096 * D, W8O, SO, D, 16 * (itn >> 2), 0, 0}; slab_load<0>(sn_, va0, vb0, stid); slab_load<1>(sn_, va1, vb1, stid); }
                        ks_quant(F.lds, W8O, SO, CO, cs, q, mb0, mb1, swave, slane);
                        __syncthreads();
                        if (!more) break;
                        it = itn; sc_ = sn_;
                    }
                }
            }
        }
        LAS float* scr = (LAS float*)(F.lds + F.wave * 16640);
        const int gw = F.vcu * NWAVES + F.wave, NGW = F.G * NWAVES;
        constexpr int I_IN = (D / 64) * 48, I_PS = (2048 / 64) * (D / 64), I_O = (D / 64) * (D / 64);
        constexpr int NITEMS = I_IN + 2 * I_PS + I_O;
#define P0_DECODE(t, it) do { int r_ = (it); \
            if (r_ < I_IN) { const int kb_ = r_ / 48, nb_ = r_ % 48; t = TDesc{args.w_in, W1, D, D_IN, 0, 2560, kb_ * (D_IN / 64) + (nb_ < 16 ? 32 + nb_ : 96 + nb_), 0}; break; } r_ -= I_IN; \
            if (r_ < I_PS) { t = TDesc{args.w_ps, WPS, 2048, D, 0, 0, r_, 0}; break; } r_ -= I_PS; \
            if (r_ < I_PS) { t = TDesc{args.w_pb, WPB, 2048, D, 0, 0, r_, 0}; break; } r_ -= I_PS; \
            t = TDesc{args.w_out, WO, D, D, 0, 0, r_, 0}; } while (0)
        for (int sr_ = 0; sr_ < ((DUP_SUB == 2) ? 2 : 1); ++sr_) { int it = gw;
        if (it < NITEMS) {
            TDesc tc; P0_DECODE(tc, it); f32x4 vc[16]; p0_tr_load(tc, vc, F.lane);
            for (;;) {
                const int itn = it + NGW; const bool more = itn < NITEMS;
                TDesc tn = tc; f32x4 vn[16];
                if (more) { P0_DECODE(tn, itn); p0_tr_load(tn, vn, F.lane); }
                p0_tr_store(tc, vc, scr, F.lane);
                if (!more) break;
                tc = tn; it = itn;
#pragma unroll
                for (int i = 0; i < 16; ++i) vc[i] = vn[i];
            }
        } }
#undef P0_DECODE
    }
        if (BOTH(0)) xcd_barrier(bar);
    }
    for (int rep_ = 0; rep_ < ((DUP_PHASE == 1) ? 2 : 1); ++rep_) if (IN(1)) {
        if (rep_) xcd_barrier(bar);
    p1_rows(F, args, mod, BA, H8, SH);
        if (BOTH(1)) xcd_barrier(bar);
    }
    for (int rep_ = 0; rep_ < ((DUP_PHASE == 2) ? 2 : 1); ++rep_) if (IN(2)) {
        if (rep_) xcd_barrier(bar);
    {
        { pg8::Gemm g{BA, W1, BA, W1, M, NB16, D}; pg8::StaticOrder S; S.init(M, NB16, F.G, (int)blockIdx.x);
          pg8::EpiProj E{KA, VA, VB, cosT, sinT};
          pg8::gemm_phase<pg8::EpiProj, pg8::StaticOrder, true, true>(F.lds + RING_OFF, g, S, E); }
        { pg8::Gemm g{(const bf16*)H8, (const bf16*)W8G, (const bf16*)H8, (const bf16*)W8G, M, NI8, D / 2}; pg8::StaticOrder S; S.init(M, NI8, F.G, (int)blockIdx.x);
          pg8::EpiI8Proj E{QA, QB, KB, GT, cosT, sinT, args.b_bg, SH, SG, 0.12751743f  };
          pg8::gemm_phase<pg8::EpiI8Proj, pg8::StaticOrder, true, true, true>(F.lds + RING_OFF, g, S, E); }
    }
        if (BOTH(2)) xcd_barrier(bar);
    }
    for (int rep_ = 0; rep_ < ((DUP_PHASE == 3) ? 2 : 1); ++rep_) if (IN(3)) {
        if (rep_) xcd_barrier(bar);
    {
        int atid = F.tid; asm volatile("" : "+v"(atid)); const int alane = atid & 63, awave = __builtin_amdgcn_readfirstlane(atid >> 6);
        const int nq = (F.vcu < 256) ? (256 - F.vcu + F.G - 1) / F.G : 0, ntot = 8 * nq;
#define P3_GET(idx, u, md) do { const int i_ = (idx); if (i_ < 4 * nq) { const int quad = F.vcu + (i_ >> 2) * F.G, j = i_ & 3, bh = quad >> 2, r = quad & 3, hh = bh & 15; \
            (u) = att::AUnit{QB + hh * HD, KB + hh * HD, VB + hh * HD, ATT_SB + hh * HD, 2048, 2048, 2048, bh >> 4, (j == 0) ? 15 - r : (j == 1) ? 11 - r : (j == 2) ? 4 + r : r, 0.f, 0, args.sinks}; (md) = 1; } \
          else { const int i2_ = i_ - 4 * nq, quad = F.vcu + (i2_ >> 2) * F.G, id = quad * 4 + (i2_ & 3), g_ = (id >> 6) & 3; \
            (u) = att::AUnit{QA + 4 * g_ * HD, KA + g_ * HD, VA + g_ * HD, ATT_SWA + 4 * g_ * HD, 2048, 512, 2048, id >> 8, id & 63, 0.f, 1, args.sinks + 4 * g_}; (md) = 0; } } while (0)
        if (ntot > 0) {
            att::AUnit cur, nxt; int mcur = 0, mnxt = 0; att::bf16x8 qf[8]; att::u32x4 kr0, kr1, vr0, vr1;
            P3_GET(0, cur, mcur); nxt = cur; att::attn_prefetch(cur, qf, kr0, kr1, vr0, vr1, atid, awave, alane);
            for (int idx = 0; idx < ntot; ++idx) { const bool hn = idx + 1 < ntot; if (hn) P3_GET(idx + 1, nxt, mnxt);
                if (mcur) att::attn_unit<1, (SB_EARLY != 0)>(F.lds, cur, hn, nxt, qf, kr0, kr1, vr0, vr1, atid, awave, alane);
                else      att::attn_unit<0, false>(F.lds, cur, hn, nxt, qf, kr0, kr1, vr0, vr1, atid, awave, alane);
                cur = nxt; mcur = mnxt; }
        }
#undef P3_GET
    }
        if (BOTH(3)) xcd_barrier(bar);
    }
    for (int rep_ = 0; rep_ < ((DUP_PHASE == 4) ? 2 : 1); ++rep_) if (IN(4)) {
        if (rep_) xcd_barrier(bar);
    {
        pg8::Gemm g{ATT_SWA, WPS, ATT_SB, WPB, M, D, 2048}; pg8::PairOrder S; S.S.init(M, D, F.G, (int)blockIdx.x);
        pg8::EpiMix E{{}, BA, (const unsigned char*)GT};
        pg8::gemm_phase<pg8::EpiMix, pg8::PairOrder, true, true>(F.lds + RING_OFF, g, S, E);
    }
        if (BOTH(4)) xcd_barrier(bar);
    }
    for (int rep_ = 0; rep_ < ((DUP_PHASE == 5) ? 2 : 1); ++rep_) if (IN(5)) {
        if (rep_) xcd_barrier(bar);
    {
        pg8::Gemm g{BA, WO, BA, WO, M, D, D}; pg8::StaticOrder S; S.init(M, D, F.G, (int)blockIdx.x);
        pg8::EpiSimple<0> E{BB, D};
        pg8::gemm_phase<pg8::EpiSimple<0>, pg8::StaticOrder, true, true>(F.lds + RING_OFF, g, S, E);
    }
        if (BOTH(5)) xcd_barrier(bar);
    }
    for (int rep_ = 0; rep_ < ((DUP_PHASE == 6) ? 2 : 1); ++rep_) if (IN(6)) {
        if (rep_) xcd_barrier(bar);
    p6_rows(F, args, mod, BB, (unsigned char*)BA, S2);
        if (BOTH(6)) xcd_barrier(bar);
    }
#ifndef IDLE_US
#define IDLE_US 0
#endif
    if (IDLE_US > 0 && IN(7)) { const unsigned long long t0_ = __builtin_amdgcn_s_memrealtime(); while (__builtin_amdgcn_s_memrealtime() - t0_ < (unsigned long long)IDLE_US * 100ull) __builtin_amdgcn_s_sleep(127); }
    for (int rep_ = 0; rep_ < ((DUP_PHASE == 7) ? 2 : 1); ++rep_) if (IN(7)) {
        if (rep_) xcd_barrier(bar);
    {
        pg8::Gemm g{BA, (const bf16*)W8F, BA, (const bf16*)W8F, M, FF, D / 2}; pg8::StaticOrder S; S.init(M, FF, F.G, (int)blockIdx.x);
        pg8::EpiRelu2I8 E{UB, FF, S2, SF};
        pg8::gemm_phase<pg8::EpiRelu2I8, pg8::StaticOrder, true, true, true>(F.lds + RING_OFF, g, S, E);
    }
        if (BOTH(7)) xcd_barrier(bar);
    }
    for (int rep_ = 0; rep_ < ((DUP_PHASE == 8) ? 2 : 1); ++rep_) if (IN(8)) {
        if (rep_) xcd_barrier(bar);
    {
        requant_u(F, UB, U8, SU);
        xcd_barrier(bar);
        pg8::Gemm g{(const bf16*)U8, (const bf16*)W8O, (const bf16*)U8, (const bf16*)W8O, M, D, FF / 2}; pg8::StaticOrder S; S.init(M, D, F.G, (int)blockIdx.x, P8_WGM);
        pg8::EpiFfOutI8 E{BB, D, SU, SO, CO};
        pg8::gemm_phase<pg8::EpiFfOutI8, pg8::StaticOrder, true, true, true>(F.lds + RING_OFF, g, S, E);
    }
        if (BOTH(8)) xcd_barrier(bar);
    }
    for (int rep_ = 0; rep_ < ((DUP_PHASE == 9) ? 2 : 1); ++rep_) if (IN(9)) {
        if (rep_) xcd_barrier(bar);
    p9_rows(F, args, mod, BB);
        if (BOTH(9)) xcd_barrier(bar);
    }
#undef IN
#undef BOTH
}

extern "C" void kernel_launch(void* const* d_in, const int* in_sizes, int n_in, void* d_out, int out_size, void* d_ws, size_t ws_size, hipStream_t stream) {
    static int grid = 0;
    if (grid == 0) {
        if (n_in != 17 || in_sizes[0] != M * D || out_size != M * D || ws_size < WS_END) { fprintf(stderr, "kernel_launch: unexpected shapes / workspace (n_in %d, in0 %d, out %d, ws %zu, need %zu); nothing launched\n", n_in, n_in > 0 ? in_sizes[0] : -1, out_size, ws_size, (size_t)WS_END); grid = -1; return; }
        int dev = 0, cus = 0, per_cu = 0;
        if (hipGetDevice(&dev) != hipSuccess || hipDeviceGetAttribute(&cus, hipDeviceAttributeMultiprocessorCount, dev) != hipSuccess) { fprintf(stderr, "kernel_launch: device query failed\n"); grid = -1; return; }
        if (hipFuncSetAttribute((const void*)fwd_kernel, hipFuncAttributeMaxDynamicSharedMemorySize, LDS_BYTES) != hipSuccess) { fprintf(stderr, "kernel_launch: hipFuncSetAttribute failed\n"); grid = -1; return; }
        if (hipOccupancyMaxActiveBlocksPerMultiprocessor(&per_cu, (const void*)fwd_kernel, NWAVES * 64, LDS_BYTES) != hipSuccess || per_cu < 1) { fprintf(stderr, "kernel_launch: occupancy query says %d blocks per CU\n", per_cu); }
        (void)hipGetLastError();
        grid = cus & ~7;
    }
    if (grid < 0) return;
    if (hipMemsetAsync((char*)d_ws + WS_CTL, 0, CTL_ZERO_BYTES, stream) != hipSuccess) { fprintf(stderr, "kernel_launch: memset failed\n"); return; }
    Args a{};
    a.x = (const float*)d_in[0]; a.c = (const float*)d_in[1]; a.w_ada = (const float*)d_in[2]; a.b_ada = (const float*)d_in[3]; a.g_pre_mix = (const float*)d_in[4]; a.g_post_mix = (const float*)d_in[5];
    a.g_pre_mlp = (const float*)d_in[6]; a.g_post_mlp = (const float*)d_in[7]; a.w_in = (const float*)d_in[8]; a.sinks = (const float*)d_in[9]; a.w_bg = (const float*)d_in[10]; a.b_bg = (const float*)d_in[11];
    a.w_ps = (const float*)d_in[12]; a.w_pb = (const float*)d_in[13]; a.w_out = (const float*)d_in[14]; a.w_f1 = (const float*)d_in[15]; a.w_f2 = (const float*)d_in[16];
    a.out = (float*)d_out; a.ws = (unsigned char*)d_ws;
#ifndef MK_N_LAUNCHES
#define MK_N_LAUNCHES 1
#ifndef DUP_PHASE
#define DUP_PHASE -1
#endif
#endif
    constexpr int NPH = 10;
    for (int li = 0; li < MK_N_LAUNCHES; ++li) {
        a.ph_lo = (MK_N_LAUNCHES == 1) ? 0 : li; a.ph_hi = (MK_N_LAUNCHES == 1) ? NPH : li + 1;
        hipLaunchKernelGGL(fwd_kernel, dim3(grid), dim3(NWAVES * 64), LDS_BYTES, stream, a);
        const hipError_t le = hipPeekAtLastError();
        if (le != hipSuccess) { fprintf(stderr, "kernel_launch: launch failed: %s\n", hipGetErrorName(le)); break; }
    }
}
```

```cpp
#include <hip/hip_runtime.h>
#include <cstdio>
#include <cstdint>
#define MK_N_LAUNCHES 1
#ifndef DUP_PHASE
#define DUP_PHASE -1
#endif
#ifndef DUP_SUB
#define DUP_SUB 0
#endif

namespace pg8 {
#define PG8_LAS __attribute__((address_space(3)))
typedef unsigned short bf16_t;
typedef short bf16x8 __attribute__((ext_vector_type(8)));
typedef float f32x4 __attribute__((ext_vector_type(4)));
typedef unsigned u32x4 __attribute__((ext_vector_type(4)));
typedef int v4i_t __attribute__((ext_vector_type(4)));
typedef unsigned u32x2 __attribute__((ext_vector_type(2)));
constexpr int BM = 256, BK = 64, HALF = 128, HTB = HALF * BK * 2  , STAGE_BYTES = 8 * HTB, NXCD = 8, WGM = 8;

__host__ __device__ __forceinline__ int lds_byte(int r, int c) { const int st = (r >> 4) * 2 + (c >> 5), rr = r & 15, cc = c & 31, ob = rr * 64 + cc * 2; return st * 1024 + (ob ^ (((ob >> 9) & 1) << 5)); }
__host__ __device__ __forceinline__ void stage_rc(int b, int& R, int& C) { const int st = b / 1024, sb = b % 1024, swz = sb ^ (((sb >> 9) & 1) << 5); R = (st >> 1) * 16 + swz / 64; C = (st & 1) * 32 + (swz % 64) / 2; }
__host__ __device__ __forceinline__ int perm32(int rho) { const int n = rho >> 4, i = rho & 15; return 8 * (i >> 2) + 4 * n + (i & 3); }

struct Unit { int pm, pn, kind; };
struct Gemm { const bf16_t* A0; const bf16_t* B0; const bf16_t* A1; const bf16_t* B1; int M, N, K; };

struct StaticOrder {
    int nM, nN, nwg, G, c, wgm;
    __host__ __device__ void init(int M, int N, int G_, int c_, int wgm_ = WGM) { nM = M / BM; nN = N / BM; nwg = nM * nN; G = G_; c = c_; wgm = wgm_; }
    __host__ __device__ bool next(int i, Unit& u) const {
        const long L = (long)i * G + c; if (L >= nwg) return false;
        int wgid = (int)L; { const int q = nwg / NXCD, r = nwg % NXCD, xcd = wgid % NXCD, off = wgid / NXCD; wgid = (xcd < r ? xcd * (q + 1) : r * (q + 1) + (xcd - r) * q) + off; }
        const int nig = wgm * nN, gid = wgid / nig, fm = gid * wgm, gsz = (nM - fm) < wgm ? (nM - fm) : wgm;
        u.pm = fm + ((wgid % nig) % gsz); u.pn = (wgid % nig) / gsz; u.kind = 0; return true;
    }
    __device__ __forceinline__ void a_ready(const Unit&) const {}
    __device__ __forceinline__ void done(const Unit&) const {}
};
struct PairOrder {
    StaticOrder S;
    __host__ __device__ bool next(int i, Unit& u) const { if (!S.next(i >> 1, u)) return false; u.kind = i & 1; return true; }
    __device__ __forceinline__ void a_ready(const Unit&) const {}
    __device__ __forceinline__ void done(const Unit&) const {}
};

typedef float f32x2_t __attribute__((ext_vector_type(2))); typedef __bf16 bf16x2_t __attribute__((ext_vector_type(2)));
__device__ __forceinline__ unsigned cvt_pk_bf16(float lo, float hi) { f32x2_t v = {lo, hi}; bf16x2_t b = __builtin_convertvector(v, bf16x2_t); return __builtin_bit_cast(unsigned, b); }
__device__ __forceinline__ f32x4 bf_lo4(unsigned a, unsigned b) { return (f32x4){__uint_as_float(a << 16), __uint_as_float(a & 0xffff0000u), __uint_as_float(b << 16), __uint_as_float(b & 0xffff0000u)}; }
__device__ __forceinline__ u32x4 pack8(f32x4 v0, f32x4 v1) { u32x4 w; w.x = cvt_pk_bf16(v0[0], v0[1]); w.y = cvt_pk_bf16(v0[2], v0[3]); w.z = cvt_pk_bf16(v1[0], v1[1]); w.w = cvt_pk_bf16(v1[2], v1[3]); return w; }

template <int ACT  , bool NT = false> struct EpiSimple {
    static constexpr bool PERM = true, AFTER_DRAIN = false, CHAIN = false;
    __device__ __forceinline__ bool keep_acc(const Unit&) const { return false; }
    bf16_t* O; int ldc;
    __device__ __forceinline__ void operator()(const f32x4 (&acc)[2][2][4][2], const Unit& u, int wr, int wc, int fr, int fq) const {
        const int row0 = u.pm * BM + wr * 64 + fr, col0 = u.pn * BM + wc * 32 + 8 * fq;
#pragma unroll
        for (int ai = 0; ai < 2; ++ai)
#pragma unroll
            for (int m = 0; m < 4; ++m) { bf16_t* rowp = O + (size_t)(row0 + ai * HALF + m * 16) * ldc + col0;
#pragma unroll
                for (int bj = 0; bj < 2; ++bj) { f32x4 v0 = acc[ai][bj][m][0], v1 = acc[ai][bj][m][1];
                    if (ACT == 1) {
#pragma unroll
                        for (int j = 0; j < 4; ++j) { const float a = fmaxf(v0[j], 0.f), b = fmaxf(v1[j], 0.f); v0[j] = a * a; v1[j] = b * b; } }
                    if (NT) __builtin_nontemporal_store(pack8(v0, v1), (u32x4*)(rowp + bj * HALF)); else *(u32x4*)(rowp + bj * HALF) = pack8(v0, v1); } }
    }
};

struct EpiProj {
    static constexpr bool PERM = true, AFTER_DRAIN = false, CHAIN = false;
    __device__ __forceinline__ bool keep_acc(const Unit&) const { return false; }
    bf16_t *KA, *VA, *VB; const float* cosT; const float* sinT;
    __device__ __forceinline__ void operator()(const f32x4 (&acc)[2][2][4][2], const Unit& u, int wr, int wc, int fr, int fq) const {
        const int pn = u.pn, row0 = u.pm * BM + wr * 64 + fr, cl = wc * 32 + 8 * fq;
        bf16_t* base; int ld, colt; bool rope = false;
        if (pn < 2)       { base = KA; ld = 512;  colt = pn * 256; rope = true; }
        else if (pn < 4)  { base = VA; ld = 512;  colt = (pn - 2) * 256; }
        else              { base = VB; ld = 2048; colt = (pn - 4) * 256; }
        if (rope) {
#pragma unroll
            for (int ai = 0; ai < 2; ++ai)
#pragma unroll
                for (int m = 0; m < 4; ++m) { const int row = row0 + ai * HALF + m * 16; const int pos = row & 4095;
                    const f32x4 c4 = *(const f32x4*)(cosT + pos * 64 + (cl >> 1)), s4 = *(const f32x4*)(sinT + pos * 64 + (cl >> 1));
                    bf16_t* rowp = base + (size_t)row * ld + colt + cl;
#pragma unroll
                    for (int bj = 0; bj < 2; ++bj) { const f32x4 x1 = acc[ai][bj][m][0], x2 = acc[ai][bj][m][1];
                        *(u32x4*)(rowp + bj * HALF) = pack8(x1 * c4 - x2 * s4, x2 * c4 + x1 * s4); } }
        } else {
#pragma unroll
            for (int ai = 0; ai < 2; ++ai)
#pragma unroll
                for (int m = 0; m < 4; ++m) { bf16_t* rowp = base + (size_t)(row0 + ai * HALF + m * 16) * ld + colt + cl;
#pragma unroll
                    for (int bj = 0; bj < 2; ++bj) *(u32x4*)(rowp + bj * HALF) = pack8(acc[ai][bj][m][0], acc[ai][bj][m][1]); }
        }
    }
};

__device__ __forceinline__ f32x4 i2f4(f32x4 a) { const v4i_t i = __builtin_bit_cast(v4i_t, a); return (f32x4){(float)i[0], (float)i[1], (float)i[2], (float)i[3]}; }
struct EpiI8Proj {
    static constexpr bool PERM = true, AFTER_DRAIN = false, CHAIN = false;
    __device__ __forceinline__ bool keep_acc(const Unit&) const { return false; }
    bf16_t *QA, *QB, *KB, *GT; const float* cosT; const float* sinT; const float* gbias; const float* sa; const float* sb; float qscale;
    __device__ __forceinline__ void operator()(const f32x4 (&acc)[2][2][4][2], const Unit& u, int wr, int wc, int fr, int fq) const {
        const int pn = u.pn, row0 = u.pm * BM + wr * 64 + fr, cl = wc * 32 + 8 * fq;
        f32x4 sv[2][2];
#pragma unroll
        for (int bj = 0; bj < 2; ++bj)
#pragma unroll
            for (int n = 0; n < 2; ++n) sv[bj][n] = *(const f32x4*)(sb + pn * 256 + bj * HALF + cl + 4 * n);
        if (pn < 8) {
            const int colt = pn * 256;
#pragma unroll
            for (int ai = 0; ai < 2; ++ai)
#pragma unroll
                for (int m = 0; m < 4; ++m) { const int row = row0 + ai * HALF + m * 16; const int pos = row & 4095; const float sr = sa[row] * qscale;
                    const f32x4 c4 = *(const f32x4*)(cosT + pos * 64 + (cl >> 1)), s4 = *(const f32x4*)(sinT + pos * 64 + (cl >> 1));
                    bf16_t* rowp = QA + (size_t)row * 2048 + colt + cl;
#pragma unroll
                    for (int bj = 0; bj < 2; ++bj) { const f32x4 x1 = i2f4(acc[ai][bj][m][0]) * (sv[bj][0] * sr), x2 = i2f4(acc[ai][bj][m][1]) * (sv[bj][1] * sr);
                        *(u32x4*)(rowp + bj * HALF) = pack8(x1 * c4 - x2 * s4, x2 * c4 + x1 * s4); } }
        } else if (pn < 24) {
            const bool isq = pn < 16; const int colt = (isq ? pn - 8 : pn - 16) * 256; bf16_t* basep = isq ? QB : KB; const float qs = isq ? qscale : 1.f;
#pragma unroll
            for (int ai = 0; ai < 2; ++ai)
#pragma unroll
                for (int m = 0; m < 4; ++m) { const int row = row0 + ai * HALF + m * 16; const float sr = sa[row] * qs; bf16_t* rowp = basep + (size_t)row * 2048 + colt + cl;
#pragma unroll
                    for (int bj = 0; bj < 2; ++bj) *(u32x4*)(rowp + bj * HALF) = pack8(i2f4(acc[ai][bj][m][0]) * (sv[bj][0] * sr), i2f4(acc[ai][bj][m][1]) * (sv[bj][1] * sr)); }
        } else {
            const int colt = (pn - 24) * 256;
            f32x4 bv[2][2];
#pragma unroll
            for (int bj = 0; bj < 2; ++bj)
#pragma unroll
                for (int n = 0; n < 2; ++n) { bv[bj][n] = *(const f32x4*)(gbias + colt + bj * HALF + cl + 4 * n) * -1.44269504089f; sv[bj][n] = sv[bj][n] * -1.44269504089f; }
            unsigned char* tp = (unsigned char*)GT + ((size_t)(u.pm * 32 + (pn - 24)) << 16) + (wr * 4 + wc) * 8192 + (fr + 16 * fq) * 16;
#pragma unroll
            for (int ai = 0; ai < 2; ++ai)
#pragma unroll
                for (int m = 0; m < 4; ++m) { const int row = row0 + ai * HALF + m * 16; const float sr = sa[row]; u32x4 w4;
#pragma unroll
                    for (int bj = 0; bj < 2; ++bj) { f32x4 v0 = i2f4(acc[ai][bj][m][0]) * (sv[bj][0] * sr) + bv[bj][0], v1 = i2f4(acc[ai][bj][m][1]) * (sv[bj][1] * sr) + bv[bj][1];
#pragma unroll
                        for (int j = 0; j < 4; ++j) { v0[j] = __builtin_rintf(255.f * __builtin_amdgcn_rcpf(1.f + __builtin_amdgcn_exp2f(v0[j]))); v1[j] = __builtin_rintf(255.f * __builtin_amdgcn_rcpf(1.f + __builtin_amdgcn_exp2f(v1[j]))); }
                        const unsigned wx = (unsigned)v0[0] | ((unsigned)v0[1] << 8) | ((unsigned)v0[2] << 16) | ((unsigned)v0[3] << 24), wy = (unsigned)v1[0] | ((unsigned)v1[1] << 8) | ((unsigned)v1[2] << 16) | ((unsigned)v1[3] << 24);
                        if (bj == 0) { w4.x = wx; w4.y = wy; } else { w4.z = wx; w4.w = wy; } }
                    *(u32x4*)(tp + (ai * 4 + m) * 1024) = w4; }
        }
    }
};
struct EpiFfOutI8 {
    static constexpr bool PERM = true, AFTER_DRAIN = false, CHAIN = false;
    __device__ __forceinline__ bool keep_acc(const Unit&) const { return false; }
    bf16_t* O; int ldc; const float* sa; const float* sb; const int* cs;
    __device__ __forceinline__ void operator()(const f32x4 (&acc)[2][2][4][2], const Unit& u, int wr, int wc, int fr, int fq) const {
        const int row0 = u.pm * BM + wr * 64 + fr, col0 = u.pn * BM + wc * 32 + 8 * fq;
        f32x4 sv[2][2]; v4i_t cv[2][2];
#pragma unroll
        for (int bj = 0; bj < 2; ++bj)
#pragma unroll
            for (int n = 0; n < 2; ++n) { sv[bj][n] = *(const f32x4*)(sb + col0 + bj * HALF + 4 * n); cv[bj][n] = *(const v4i_t*)(cs + col0 + bj * HALF + 4 * n) * 128; }
#pragma unroll
        for (int ai = 0; ai < 2; ++ai)
#pragma unroll
            for (int m = 0; m < 4; ++m) { const int row = row0 + ai * HALF + m * 16; const float sr = sa[row]; bf16_t* rowp = O + (size_t)row * ldc + col0;
#pragma unroll
                for (int bj = 0; bj < 2; ++bj) { const v4i_t i0 = __builtin_bit_cast(v4i_t, acc[ai][bj][m][0]) + cv[bj][0], i1 = __builtin_bit_cast(v4i_t, acc[ai][bj][m][1]) + cv[bj][1];
                    *(u32x4*)(rowp + bj * HALF) = pack8((f32x4){(float)i0[0], (float)i0[1], (float)i0[2], (float)i0[3]} * (sv[bj][0] * sr), (f32x4){(float)i1[0], (float)i1[1], (float)i1[2], (float)i1[3]} * (sv[bj][1] * sr)); } }
    }
};
struct EpiRelu2I8 {
    static constexpr bool PERM = true, AFTER_DRAIN = false, CHAIN = false;
    __device__ __forceinline__ bool keep_acc(const Unit&) const { return false; }
    bf16_t* O; int ldc; const float* sa; const float* sb;
    __device__ __forceinline__ void operator()(const f32x4 (&acc)[2][2][4][2], const Unit& u, int wr, int wc, int fr, int fq) const {
        const int row0 = u.pm * BM + wr * 64 + fr, col0 = u.pn * BM + wc * 32 + 8 * fq;
        f32x4 sv[2][2];
#pragma unroll
        for (int bj = 0; bj < 2; ++bj)
#pragma unroll
            for (int n = 0; n < 2; ++n) sv[bj][n] = *(const f32x4*)(sb + col0 + bj * HALF + 4 * n);
#pragma unroll
        for (int ai = 0; ai < 2; ++ai)
#pragma unroll
            for (int m = 0; m < 4; ++m) { const int row = row0 + ai * HALF + m * 16; const float sr = sa[row]; bf16_t* rowp = O + (size_t)row * ldc + col0;
#pragma unroll
                for (int bj = 0; bj < 2; ++bj) { f32x4 v0 = i2f4(acc[ai][bj][m][0]) * (sv[bj][0] * sr), v1 = i2f4(acc[ai][bj][m][1]) * (sv[bj][1] * sr);
#pragma unroll
                    for (int j = 0; j < 4; ++j) { const float p = fmaxf(v0[j], 0.f), q = fmaxf(v1[j], 0.f); v0[j] = p * p; v1[j] = q * q; }
                    *(u32x4*)(rowp + bj * HALF) = pack8(v0, v1); } }
    }
};

struct EpiMix {
    static constexpr bool PERM = true, AFTER_DRAIN = false, CHAIN = true;
    mutable u32x4 gbk[7];
    bf16_t* O; const unsigned char* G;
    static __device__ __forceinline__ f32x4 ub4(unsigned w) { return (f32x4){(float)(w & 255u), (float)((w >> 8) & 255u), (float)((w >> 16) & 255u), (float)(w >> 24)}; }
    __device__ __forceinline__ void operator()(f32x4 (&acc)[2][2][4][2], const Unit& u, int wr, int wc, int fr, int fq) const {
        const int row0 = u.pm * BM + wr * 64 + fr, col0 = u.pn * BM + wc * 32 + 8 * fq; const int kind = u.kind;
        const unsigned char* ta = G + ((size_t)(u.pm * 32 + u.pn) << 16) + (wr * 4 + wc) * 8192 + (fr + 16 * fq) * 16;
        const unsigned char* tb = ta + ((size_t)16 << 16);
        if (kind == 0) {
#pragma unroll
            for (int ai = 0; ai < 2; ++ai)
#pragma unroll
                for (int m = 0; m < 4; ++m) { const u32x4 ga4 = *(const u32x4*)(ta + (ai * 4 + m) * 1024), gb4 = *(const u32x4*)(tb + (ai * 4 + m) * 1024); if (ai * 4 + m < 7) gbk[(ai * 4 + m) % 7] = gb4;
#pragma unroll
                    for (int bj = 0; bj < 2; ++bj) { const unsigned gax = bj ? ga4.z : ga4.x, gay = bj ? ga4.w : ga4.y, gbx = bj ? gb4.z : gb4.x, gby = bj ? gb4.w : gb4.y;
                        f32x4 b0 = ub4(gbx), b1 = ub4(gby);
#pragma unroll
                        for (int j = 0; j < 4; ++j) { b0[j] = __builtin_amdgcn_rcpf(fmaxf(b0[j], 2.3191e-10f)); b1[j] = __builtin_amdgcn_rcpf(fmaxf(b1[j], 2.3191e-10f)); }
                        acc[ai][bj][m][0] *= ub4(gax) * b0; acc[ai][bj][m][1] *= ub4(gay) * b1; } }
        } else {
#pragma unroll
            for (int ai = 0; ai < 2; ++ai)
#pragma unroll
                for (int m = 0; m < 4; ++m) { const size_t row = (size_t)(row0 + ai * HALF + m * 16); const u32x4 gb4 = (ai * 4 + m < 7) ? gbk[(ai * 4 + m) % 7] : *(const u32x4*)(tb + (ai * 4 + m) * 1024);
#pragma unroll
                    for (int bj = 0; bj < 2; ++bj) { const int col = col0 + bj * HALF; const unsigned gbx = bj ? gb4.z : gb4.x, gby = bj ? gb4.w : gb4.y;
                        f32x4 b0 = ub4(gbx), b1 = ub4(gby);
#pragma unroll
                        for (int j = 0; j < 4; ++j) { b0[j] = fmaxf(b0[j], 2.3191e-10f) * (1.f / 255.f); b1[j] = fmaxf(b1[j], 2.3191e-10f) * (1.f / 255.f); }
                        *(u32x4*)(O + row * 4096 + col) = pack8(acc[ai][bj][m][0] * b0, acc[ai][bj][m][1] * b1); } }
        }
    }
    __device__ __forceinline__ bool keep_acc(const Unit& u) const { return u.kind == 0; }
};

template <class Epi, class Sched, bool ALIGN_EPI = false, bool SP2 = false, bool I8 = false>
__device__ __forceinline__ void gemm_phase(PG8_LAS unsigned char* lds, const Gemm g, const Sched& S, const Epi& E) {
    int tid_ = threadIdx.x; asm volatile("" : "+v"(tid_));
    const int tid = tid_, wid = __builtin_amdgcn_readfirstlane(tid >> 6), lane = tid & 63, wr = wid >> 2, wc = wid & 3, fr = lane & 15, fq = lane >> 4;
    const int K = g.K, nt = K / BK;
    unsigned voffA[2], voffB[2];
#pragma unroll
    for (int i = 0; i < 2; ++i) { int R, C; stage_rc(tid * 16 + i * 8192, R, C); const int Rb = Epi::PERM ? ((R & ~31) + perm32(R & 31)) : R;
        voffA[i] = (unsigned)(R * K + C) * 2u; voffB[i] = (unsigned)(Rb * K + C) * 2u; }
    const size_t kstep = (size_t)(BK * 2);
    const size_t hstep = (size_t)HALF * K * 2;
    const size_t tstep = 2 * hstep;
    const unsigned ldsw = (unsigned)wid * 1024u;
    const int aoff = lds_byte(wr * 64 + fr, fq * 8), boff = lds_byte(wc * 32 + fr, fq * 8);
#define PG8_SA(b, h) (((b) * 2 + (h)) * HTB)
#define PG8_SB(b, h) ((4 + (b) * 2 + (h)) * HTB)
#define PG8_STAGE(bufoff, gbase, voff) do { _Pragma("unroll") for (int _i = 0; _i < 2; ++_i) \
        __builtin_amdgcn_global_load_lds((const unsigned*)((const char*)(gbase) + (voff)[_i]), (PG8_LAS unsigned*)(lds + (bufoff) + ldsw + _i * 8192), 16, 0, 0); } while (0)
#define PG8_LDA(dst, b, h) do { _Pragma("unroll") for (int m = 0; m < 4; ++m) _Pragma("unroll") for (int k = 0; k < 2; ++k) dst[m][k] = *(const PG8_LAS bf16x8*)(lds + PG8_SA(b, h) + aoff + m * 2048 + k * 1024); } while (0)
#define PG8_LDB(dst, b, h) do { _Pragma("unroll") for (int n = 0; n < 2; ++n) _Pragma("unroll") for (int k = 0; k < 2; ++k) dst[n][k] = *(const PG8_LAS bf16x8*)(lds + PG8_SB(b, h) + boff + n * 2048 + k * 1024); } while (0)
#define PG8_MMA(ai, bj, At, Bt) do { __builtin_amdgcn_s_setprio(1); _Pragma("unroll") for (int m = 0; m < 4; ++m) _Pragma("unroll") for (int n = 0; n < 2; ++n) _Pragma("unroll") for (int k = 0; k < 2; ++k) { \
        if constexpr (I8) acc[ai][bj][m][n] = __builtin_bit_cast(f32x4, __builtin_amdgcn_mfma_i32_16x16x64_i8(__builtin_bit_cast(v4i_t, Bt[n][k]), __builtin_bit_cast(v4i_t, At[m][k]), __builtin_bit_cast(v4i_t, acc[ai][bj][m][n]), 0, 0, 0)); \
        else acc[ai][bj][m][n] = __builtin_amdgcn_mfma_f32_16x16x32_bf16(Bt[n][k], At[m][k], acc[ai][bj][m][n], 0, 0, 0); } __builtin_amdgcn_s_setprio(0); } while (0)
#define PG8_WAIT_V(n) asm volatile("s_waitcnt vmcnt(" #n ")" ::: "memory")
#define PG8_WAIT_L(n) asm volatile("s_waitcnt lgkmcnt(" #n ")" ::: "memory")
#define PG8_BAR __builtin_amdgcn_s_barrier()
#define PG8_SCHED __builtin_amdgcn_sched_barrier(0)
    Unit cur, nxt; int ui = 0;
    if (!S.next(0, cur)) return;
    f32x4 acc[2][2][4][2];
#pragma unroll
    for (int a = 0; a < 2; ++a)
#pragma unroll
        for (int b = 0; b < 2; ++b)
#pragma unroll
            for (int m = 0; m < 4; ++m)
#pragma unroll
                for (int n = 0; n < 2; ++n) acc[a][b][m][n] = (f32x4){0.f, 0.f, 0.f, 0.f};
    bf16x8 At[4][2], B0[2][2], B1[2][2];
    const char* cA = (const char*)(cur.kind ? g.A1 : g.A0) + (size_t)cur.pm * tstep; const char* cB = (const char*)(cur.kind ? g.B1 : g.B0) + (size_t)cur.pn * tstep;
    S.a_ready(cur);
    if constexpr (SP2) {
        PG8_STAGE(PG8_SB(0, 0), cB, voffB); PG8_STAGE(PG8_SB(0, 1), cB + hstep, voffB); PG8_STAGE(PG8_SA(0, 0), cA, voffA); PG8_STAGE(PG8_SA(0, 1), cA + hstep, voffA);
        if (wr == 1) PG8_BAR;
        PG8_WAIT_V(2); PG8_BAR;
        PG8_STAGE(PG8_SB(1, 0), cB + kstep, voffB); PG8_STAGE(PG8_SA(1, 0), cA + kstep, voffA); PG8_STAGE(PG8_SB(1, 1), cB + hstep + kstep, voffB);
        PG8_WAIT_V(6); PG8_BAR;
    } else {
        PG8_STAGE(PG8_SB(0, 0), cB, voffB); PG8_STAGE(PG8_SA(0, 0), cA, voffA); PG8_STAGE(PG8_SB(0, 1), cB + hstep, voffB); PG8_STAGE(PG8_SA(0, 1), cA + hstep, voffA);
        if (wr == 1) PG8_BAR;
        PG8_WAIT_V(4); PG8_BAR;
        PG8_STAGE(PG8_SB(1, 0), cB + kstep, voffB); PG8_STAGE(PG8_SA(1, 0), cA + kstep, voffA); PG8_STAGE(PG8_SB(1, 1), cB + hstep + kstep, voffB);
        PG8_WAIT_V(6); PG8_BAR;
    }
    for (;;) {
        const bool has_next = S.next(ui + 1, nxt);
        const char* nA = has_next ? (const char*)(nxt.kind ? g.A1 : g.A0) + (size_t)nxt.pm * tstep : cA; const char* nB = has_next ? (const char*)(nxt.kind ? g.B1 : g.B0) + (size_t)nxt.pn * tstep : cB;
        for (int t = 0; t < nt; t += 2) {
            const bool last = (t == nt - 2);
            const char* a1 = cA + (size_t)(t + 1) * kstep;
            const char* a2 = last ? nA : cA + (size_t)(t + 2) * kstep; const char* b2 = last ? nB : cB + (size_t)(t + 2) * kstep;
            const char* a3 = a2 + kstep; const char* b3 = b2 + kstep;
            if (last && has_next) S.a_ready(nxt);
            if constexpr (SP2) {
            PG8_LDB(B0, 0, 0); PG8_LDB(B1, 0, 1); PG8_SCHED; PG8_LDA(At, 0, 0); PG8_STAGE(PG8_SA(1, 1), a1 + hstep, voffA);
            PG8_WAIT_V(8); PG8_WAIT_L(0); PG8_BAR; PG8_MMA(0, 0, At, B0); PG8_MMA(0, 1, At, B1); PG8_BAR; PG8_SCHED;
            PG8_LDA(At, 0, 1); PG8_STAGE(PG8_SB(0, 0), b2, voffB); PG8_STAGE(PG8_SB(0, 1), b2 + hstep, voffB); PG8_STAGE(PG8_SA(0, 0), a2, voffA);
            PG8_WAIT_V(8); PG8_WAIT_L(0); PG8_BAR; PG8_MMA(1, 0, At, B0); PG8_MMA(1, 1, At, B1); PG8_BAR; PG8_SCHED;
            PG8_LDB(B0, 1, 0); PG8_LDB(B1, 1, 1); PG8_SCHED; PG8_LDA(At, 1, 0); PG8_STAGE(PG8_SA(0, 1), a2 + hstep, voffA);
            PG8_WAIT_V(8); PG8_WAIT_L(0); PG8_BAR; PG8_MMA(0, 0, At, B0); PG8_MMA(0, 1, At, B1); PG8_BAR; PG8_SCHED;
            PG8_LDA(At, 1, 1); PG8_STAGE(PG8_SB(1, 0), b3, voffB); PG8_STAGE(PG8_SB(1, 1), b3 + hstep, voffB); PG8_STAGE(PG8_SA(1, 0), a3, voffA);
            PG8_WAIT_V(8); PG8_WAIT_L(0); PG8_BAR; PG8_MMA(1, 0, At, B0); PG8_MMA(1, 1, At, B1); PG8_BAR; PG8_SCHED;
            } else {
            PG8_LDB(B0, 0, 0); PG8_SCHED; PG8_LDA(At, 0, 0); PG8_STAGE(PG8_SA(1, 1), a1 + hstep, voffA);
            PG8_WAIT_L(8); PG8_BAR; PG8_WAIT_L(0); PG8_MMA(0, 0, At, B0); PG8_BAR; PG8_SCHED;
            PG8_LDB(B1, 0, 1); PG8_STAGE(PG8_SB(0, 0), b2, voffB);
            PG8_BAR; PG8_WAIT_L(0); PG8_MMA(0, 1, At, B1); PG8_BAR;
            PG8_LDA(At, 0, 1); PG8_STAGE(PG8_SA(0, 0), a2, voffA);
            PG8_BAR; PG8_WAIT_L(0); PG8_MMA(1, 0, At, B0); PG8_BAR; PG8_SCHED;
            PG8_STAGE(PG8_SB(0, 1), b2 + hstep, voffB);
            PG8_WAIT_V(6); PG8_BAR; PG8_MMA(1, 1, At, B1); PG8_BAR;
            PG8_LDB(B0, 1, 0); PG8_SCHED; PG8_LDA(At, 1, 0); PG8_STAGE(PG8_SA(0, 1), a2 + hstep, voffA);
            PG8_WAIT_L(8); PG8_BAR; PG8_WAIT_L(0); PG8_MMA(0, 0, At, B0); PG8_BAR; PG8_SCHED;
            PG8_LDB(B1, 1, 1); PG8_STAGE(PG8_SB(1, 0), b3, voffB);
            PG8_BAR; PG8_WAIT_L(0); PG8_MMA(0, 1, At, B1); PG8_BAR;
            PG8_LDA(At, 1, 1); PG8_STAGE(PG8_SA(1, 0), a3, voffA);
            PG8_BAR; PG8_WAIT_L(0); PG8_MMA(1, 0, At, B0); PG8_BAR; PG8_SCHED;
            PG8_STAGE(PG8_SB(1, 1), b3 + hstep, voffB);
            PG8_WAIT_V(6); PG8_BAR; PG8_MMA(1, 1, At, B1); PG8_BAR;
            }
        }
        if constexpr (ALIGN_EPI) { if (wr == 0) PG8_BAR; }
        if constexpr (!Epi::AFTER_DRAIN) { E(acc, cur, wr, wc, fr, fq); S.done(cur); }
        if (!has_next) break;
        if (!(Epi::CHAIN && E.keep_acc(cur))) {
#pragma unroll
        for (int a = 0; a < 2; ++a)
#pragma unroll
            for (int b = 0; b < 2; ++b)
#pragma unroll
                for (int m = 0; m < 4; ++m)
#pragma unroll
                    for (int n = 0; n < 2; ++n) acc[a][b][m][n] = (f32x4){0.f, 0.f, 0.f, 0.f};
        }
        cur = nxt; cA = nA; cB = nB; ++ui;
        if constexpr (ALIGN_EPI) { if (wr == 1) PG8_BAR; }
    }
    PG8_WAIT_V(0);
    if constexpr (!ALIGN_EPI) { if (wr == 0) PG8_BAR; }
    PG8_BAR;
#undef PG8_SA
#undef PG8_SB
#undef PG8_STAGE
#undef PG8_LDA
#undef PG8_LDB
#undef PG8_MMA
#undef PG8_WAIT_V
#undef PG8_WAIT_L
#undef PG8_BAR
#undef PG8_SCHED
}
}


namespace att {
#define ATT_LAS __attribute__((address_space(3)))
typedef unsigned short bf16;
typedef short bf16x8 __attribute__((ext_vector_type(8)));
typedef short s16x4 __attribute__((ext_vector_type(4)));
typedef float f32x16 __attribute__((ext_vector_type(16)));
typedef float f32x2_t __attribute__((ext_vector_type(2)));
typedef __bf16 bf16x2_t __attribute__((ext_vector_type(2)));
typedef unsigned u32x4 __attribute__((ext_vector_type(4)));
typedef unsigned u32x2 __attribute__((ext_vector_type(2)));
constexpr int TILE_BYTES = 64 * 256, BUF_BYTES = 2 * TILE_BYTES, FLAG_OFF = 2 * BUF_BYTES, LDS_BYTES = FLAG_OFF + 256;
__device__ __forceinline__ unsigned cvtpk(float lo, float hi) { f32x2_t v = {lo, hi}; bf16x2_t b = __builtin_convertvector(v, bf16x2_t); return __builtin_bit_cast(unsigned, b); }
__device__ __forceinline__ int crow(int i, int h) { return (i & 3) + 8 * (i >> 2) + 4 * h; }
__device__ __forceinline__ unsigned off_b(unsigned row, unsigned ch) { return 256u * row + 16u * (ch ^ (((row & 3) << 2) | ((row >> 2) & 3))); }
__device__ __forceinline__ s16x4 trread(const ATT_LAS unsigned char* p) { return __builtin_bit_cast(s16x4, __builtin_amdgcn_ds_read_tr16_b64_v4i16((ATT_LAS s16x4*)p)); }
#define ATT_MFMA(a, b, c) __builtin_amdgcn_mfma_f32_32x32x16_bf16((a), (b), (c), 0, 0, 0)

struct AUnit { const bf16* Q; const bf16* K; const bf16* V; bf16* O; int pq, pk, po, b, qb; float sink2; int gqa; const float* sk; };
__device__ __forceinline__ void attn_prefetch(const AUnit& u, bf16x8 (&qf)[8], u32x4& kr0, u32x4& kr1, u32x4& vr0, u32x4& vr1, int tid, int wid, int lane) {
    int ln_ = lane, td_ = tid; asm volatile("" : "+v"(ln_), "+v"(td_));
    const int r32 = ln_ & 31, h = ln_ >> 5, tq = (u.gqa ? 64 * u.qb + 32 * (wid & 1) : 256 * u.qb + 32 * wid) + r32; const size_t rowbase = (size_t)u.b * 4096;
    { const char* qb_ = (const char*)(u.Q + rowbase * u.pq + (u.gqa ? (wid >> 1) * 128 : 0)); const unsigned qo = (unsigned)(tq * u.pq + 8 * h) * 2u;
#pragma unroll
      for (int s = 0; s < 8; ++s) qf[s] = *(const bf16x8*)(qb_ + qo + 32 * s); }
    const int lrow = td_ >> 4, lch = td_ & 15; const unsigned kvo = (unsigned)(lrow * u.pk + 8 * lch) * 2u;
    const size_t o = ((size_t)rowbase + (size_t)(64 * (u.gqa ? u.qb : 4 * u.qb + 3))) * u.pk * 2; const char* k = (const char*)u.K + o; const char* v = (const char*)u.V + o;
    kr0 = *(const u32x4*)(k + kvo); kr1 = *(const u32x4*)(k + (size_t)64 * u.pk + kvo); vr0 = *(const u32x4*)(v + kvo); vr1 = *(const u32x4*)(v + (size_t)64 * u.pk + kvo);
}
template <int MODE, bool EARLY>
__device__ __forceinline__ void attn_unit(ATT_LAS unsigned char* lds, const AUnit& U, bool has_next, const AUnit& N, bf16x8 (&qf)[8], u32x4& kr0, u32x4& kr1, u32x4& vr0, u32x4& vr1, int tid, int wid, int lane) {
    const bf16* __restrict__ Kh = U.K; const bf16* __restrict__ Vh = U.V; bf16* __restrict__ Oh = U.O + (MODE == 0 ? (wid >> 1) * 128 : 0); const int pk = U.pk, po = U.po, b = U.b, qb = U.qb;
    const float sink2 = (MODE == 0) ? U.sk[wid >> 1] * 1.44269504089f : 0.f;
    int ln_ = lane, td_ = tid; asm volatile("" : "+v"(ln_), "+v"(td_));
    const int r32 = ln_ & 31, h = ln_ >> 5;
    const int t0 = (MODE == 0) ? 64 * qb + 32 * (wid & 1) : 256 * qb + 32 * wid, tq = t0 + r32;
    const size_t rowbase = (size_t)b * 4096;
    f32x16 oacc[4];
#pragma unroll
    for (int c = 0; c < 4; ++c)
#pragma unroll
        for (int i = 0; i < 16; ++i) oacc[c][i] = 0.f;
    float carry = 0.f, mrun = sink2, lrun = (h == 0) ? 1.f : 0.f;
    const int kt_hi = (MODE == 0) ? qb : 4 * qb + 3, kt_lo = (MODE == 0) ? ((qb - 2) > 0 ? (qb - 2) : 0) : 0;
    const int lrow = td_ >> 4, lch = td_ & 15;
    const unsigned lw = off_b((unsigned)lrow, (unsigned)lch);
    const unsigned kvo = (unsigned)(lrow * pk + 8 * lch) * 2u;
    const char* kgb = (const char*)(Kh + rowbase * pk); const char* vgb = (const char*)(Vh + rowbase * pk);
    const unsigned xk = (unsigned)(((r32 & 3) << 2) | ((r32 >> 2) & 3));
    const int q4 = (ln_ & 15) >> 2, p4 = ln_ & 3, blk = (ln_ >> 4) & 1;
    unsigned vaddr[4][2];
#pragma unroll
    for (int c = 0; c < 4; ++c)
#pragma unroll
        for (int t = 0; t < 2; ++t) { const unsigned row = (unsigned)(8 * t + 4 * h + q4), x = (unsigned)((q4 << 2) | ((2 * t + h) & 3)), ch = (unsigned)(4 * c + 2 * blk + (p4 >> 1));
            vaddr[c][t] = 256u * row + 16u * (ch ^ x) + 8u * (unsigned)(p4 & 1); }
#define ATT_GLOAD(kt) do { const size_t _o = (size_t)(64 * (kt)) * pk * 2; const char* _k = kgb + _o; const char* _v = vgb + _o; kr0 = *(const u32x4*)(_k + kvo); kr1 = *(const u32x4*)(_k + (size_t)64 * pk + kvo); vr0 = *(const u32x4*)(_v + kvo); vr1 = *(const u32x4*)(_v + (size_t)64 * pk + kvo); } while (0)
#define ATT_LSTORE(bf) do { ATT_LAS unsigned char* _b = lds + (bf) * BUF_BYTES + lw; *(ATT_LAS u32x4*)_b = kr0; *(ATT_LAS u32x4*)(_b + 8192) = kr1; *(ATT_LAS u32x4*)(_b + TILE_BYTES) = vr0; *(ATT_LAS u32x4*)(_b + TILE_BYTES + 8192) = vr1; } while (0)
    int buf = 0;
    ATT_LSTORE(0); __syncthreads();
    for (int kt = kt_hi; kt >= kt_lo; --kt) {
        const bool more = kt > kt_lo;
        if (more) ATT_GLOAD(kt - 1);
        const int kbase = 64 * kt;
        bool relevant, masked;
        if (MODE == 1) { relevant = kbase <= t0 + 30; masked = kbase + 63 >= t0; }
        else { relevant = (kbase <= t0 + 31) && (kbase + 63 >= t0 - 127); masked = !((kbase + 63 <= t0) && (kbase >= t0 - 96)); }
        if (relevant) {
            const ATT_LAS unsigned char* Kb = lds + buf * BUF_BYTES; const ATT_LAS unsigned char* Vb = Kb + TILE_BYTES;
            f32x16 sacc[2];
#pragma unroll
            for (int kb = 0; kb < 2; ++kb) {
#pragma unroll
                for (int i = 0; i < 16; ++i) sacc[kb][i] = 0.f;
#pragma unroll
                for (int s = 0; s < 8; ++s) { const bf16x8 kf = *(const ATT_LAS bf16x8*)(Kb + kb * 8192 + 256 * r32 + 16 * (((unsigned)(2 * s + h)) ^ xk)); sacc[kb] = ATT_MFMA(kf, qf[s], sacc[kb]); }
            }
            bf16x8 pf[2][2];
            if (MODE == 1) {
#pragma unroll
                for (int kk = 0; kk < 2; ++kk) { const int kb = 1 - kk; const int sb0 = kbase + 32 * kb;
                    float sp[16], A[16];
#pragma unroll
                    for (int i = 0; i < 16; ++i) { const float z = sacc[kb][i]; const float e = __builtin_amdgcn_exp2f(-__builtin_fabsf(z)); sp[i] = fmaxf(z, 0.f) + __builtin_amdgcn_logf(1.f + e); }
                    if (masked) {
#pragma unroll
                        for (int i = 0; i < 16; ++i) sp[i] = (sb0 + crow(i, h) < tq) ? sp[i] : 0.f; }
                    float G[4], Gp[4], T[4];
#pragma unroll
                    for (int g = 0; g < 4; ++g) { G[g] = (sp[4 * g] + sp[4 * g + 1]) + (sp[4 * g + 2] + sp[4 * g + 3]); Gp[g] = __shfl_xor(G[g], 32); T[g] = G[g] + Gp[g]; }
                    float R[4]; R[3] = carry; R[2] = R[3] + T[3]; R[1] = R[2] + T[2]; R[0] = R[1] + T[1]; carry = R[0] + T[0];
#pragma unroll
                    for (int g = 0; g < 4; ++g) { const float S3 = R[g] + (h == 0 ? Gp[g] : 0.f), S2 = S3 + sp[4 * g + 3], S1 = S2 + sp[4 * g + 2], S0 = S1 + sp[4 * g + 1];
                        A[4 * g + 3] = __builtin_amdgcn_exp2f(sacc[kb][4 * g + 3] - sp[4 * g + 3] - S3); A[4 * g + 2] = __builtin_amdgcn_exp2f(sacc[kb][4 * g + 2] - sp[4 * g + 2] - S2);
                        A[4 * g + 1] = __builtin_amdgcn_exp2f(sacc[kb][4 * g + 1] - sp[4 * g + 1] - S1); A[4 * g + 0] = __builtin_amdgcn_exp2f(sacc[kb][4 * g + 0] - sp[4 * g + 0] - S0); }
                    if (masked) {
#pragma unroll
                        for (int i = 0; i < 16; ++i) A[i] = (sb0 + crow(i, h) < tq) ? A[i] : 0.f; }
#pragma unroll
                    for (int s2 = 0; s2 < 2; ++s2) { u32x4 w; w.x = cvtpk(A[8 * s2], A[8 * s2 + 1]); w.y = cvtpk(A[8 * s2 + 2], A[8 * s2 + 3]); w.z = cvtpk(A[8 * s2 + 4], A[8 * s2 + 5]); w.w = cvtpk(A[8 * s2 + 6], A[8 * s2 + 7]); pf[kb][s2] = __builtin_bit_cast(bf16x8, w); }
                }
            } else {
                if (masked) {
#pragma unroll
                    for (int kb = 0; kb < 2; ++kb)
#pragma unroll
                        for (int i = 0; i < 16; ++i) { const int key = kbase + 32 * kb + crow(i, h); const bool valid = (key <= tq) && (key + 127 >= tq); sacc[kb][i] = valid ? sacc[kb][i] : -__builtin_inff(); } }
                float tmax = sacc[0][0];
#pragma unroll
                for (int kb = 0; kb < 2; ++kb)
#pragma unroll
                    for (int i = 0; i < 16; ++i) tmax = fmaxf(tmax, sacc[kb][i]);
                tmax = fmaxf(tmax, __shfl_xor(tmax, 32));
                const float mnew = fmaxf(mrun, tmax), alpha = __builtin_amdgcn_exp2f(mrun - mnew); mrun = mnew;
                float psum = 0.f;
#pragma unroll
                for (int kb = 0; kb < 2; ++kb) { float P[16];
#pragma unroll
                    for (int i = 0; i < 16; ++i) { P[i] = __builtin_amdgcn_exp2f(sacc[kb][i] - mnew); psum += P[i]; }
#pragma unroll
                    for (int s2 = 0; s2 < 2; ++s2) { u32x4 w; w.x = cvtpk(P[8 * s2], P[8 * s2 + 1]); w.y = cvtpk(P[8 * s2 + 2], P[8 * s2 + 3]); w.z = cvtpk(P[8 * s2 + 4], P[8 * s2 + 5]); w.w = cvtpk(P[8 * s2 + 6], P[8 * s2 + 7]); pf[kb][s2] = __builtin_bit_cast(bf16x8, w); } }
                lrun = lrun * alpha + psum;
#pragma unroll
                for (int c = 0; c < 4; ++c)
#pragma unroll
                    for (int i = 0; i < 16; ++i) oacc[c][i] *= alpha;
            }
#pragma unroll
            for (int kb = 0; kb < 2; ++kb)
#pragma unroll
                for (int s2 = 0; s2 < 2; ++s2)
#pragma unroll
                    for (int c = 0; c < 4; ++c) { const s16x4 lo = trread(Vb + vaddr[c][0] + 4096 * (2 * kb + s2)), hi = trread(Vb + vaddr[c][1] + 4096 * (2 * kb + s2));
                        const bf16x8 vf = __builtin_shufflevector(lo, hi, 0, 1, 2, 3, 4, 5, 6, 7); oacc[c] = ATT_MFMA(vf, pf[kb][s2], oacc[c]); }
        }
        if (more) ATT_LSTORE(buf ^ 1);
        if (EARLY && MODE == 1) {
            volatile ATT_LAS unsigned* fl = (volatile ATT_LAS unsigned*)(lds + FLAG_OFF) + (kt & 1) * 8;
            const bool done = __all(carry > 160.f);
            if (lane == 0) fl[wid] = done ? 1u : 0u;
            __syncthreads();
            unsigned alld = 1u;
#pragma unroll
            for (int w = 0; w < 8; ++w) alld &= fl[w];
            buf ^= 1;
            if (alld) break;
        } else { __syncthreads(); buf ^= 1; }
    }
#undef ATT_GLOAD
#undef ATT_LSTORE
    if (MODE == 0) { const float lt = lrun + __shfl_xor(lrun, 32); const float inv = 1.f / lt;
#pragma unroll
        for (int c = 0; c < 4; ++c)
#pragma unroll
            for (int i = 0; i < 16; ++i) oacc[c][i] *= inv; }
    if (has_next) attn_prefetch(N, qf, kr0, kr1, vr0, vr1, tid, wid, lane);
    { int l2 = lane; asm volatile("" : "+v"(l2)); const int r2 = l2 & 31, h2 = l2 >> 5;
      char* ob = (char*)(Oh + rowbase * po); const unsigned oo = (unsigned)((t0 + r2) * po) * 2u + 16u * (unsigned)h2;
#pragma unroll
      for (int c = 0; c < 4; ++c)
#pragma unroll
        for (int gp = 0; gp < 2; ++gp) { const int g0 = 2 * gp;
            const unsigned x0 = cvtpk(oacc[c][4 * g0], oacc[c][4 * g0 + 1]), x1 = cvtpk(oacc[c][4 * g0 + 2], oacc[c][4 * g0 + 3]);
            const unsigned y0 = cvtpk(oacc[c][4 * g0 + 4], oacc[c][4 * g0 + 5]), y1 = cvtpk(oacc[c][4 * g0 + 6], oacc[c][4 * g0 + 7]);
            const auto s0 = __builtin_amdgcn_permlane32_swap(x0, y0, false, false); const auto s1 = __builtin_amdgcn_permlane32_swap(x1, y1, false, false);
            u32x4 w; w.x = s0[0]; w.y = s1[0]; w.z = s0[1]; w.w = s1[1];
            *(u32x4*)(ob + oo + 64 * c + 32 * gp) = w; } }
    if (EARLY && MODE == 1) __syncthreads();
}
}


constexpr int NWAVES = 8;
constexpr int BATCH = 4, SEQ = 4096, D = 4096, M = BATCH * SEQ, HD = 128, FF = 4 * D;
constexpr int D_IN = 9216, NG = 8192, N1 = D_IN + NG, NMOD = 6 * D;
constexpr float NORM_EPS = 1e-6f;
constexpr size_t MiB = 1u << 20;
constexpr size_t WS_CTL = 0, CTL_ZERO_BYTES = 49152;
constexpr size_t WS_CMX = 16384;
constexpr size_t WS_MOD = 1 * MiB, WS_COS = 2 * MiB, WS_SIN = 3 * MiB;
constexpr size_t WS_W1 = 4 * MiB;
constexpr size_t WS_WPS = 140 * MiB, WS_WPB = 156 * MiB;
constexpr size_t WS_WO = 172 * MiB;
constexpr size_t WS_WF1 = 204 * MiB;
constexpr size_t WS_WF2 = 332 * MiB;
constexpr size_t WS_A = 460 * MiB;
constexpr size_t WS_B = 588 * MiB;
constexpr size_t WS_C = 716 * MiB;
constexpr size_t WS_H8 = WS_C + 544 * MiB;
constexpr size_t WS_W8G = WS_H8 + 64 * MiB;
constexpr size_t WS_W8F = WS_W8G + 56 * MiB;
constexpr size_t WS_W8O = WS_W8F + 64 * MiB;
constexpr size_t WS_END = WS_W8O + 64 * MiB;
constexpr size_t WS_U8 = WS_W1;
constexpr size_t WS_SU = 320 * 1024, WS_SO = 384 * 1024, WS_CO = 32768;
constexpr int NB16 = 3072, NI8 = 14336;
constexpr size_t WS_SH = 64 * 1024, WS_S2 = 128 * 1024, WS_SG = 192 * 1024, WS_SF = 256 * 1024;
constexpr int CW_BAR = 0, CW_KS = 3520;
constexpr int RING_OFF = 0, RING_BYTES = 131072, LDSCTL_OFF = 139264, MISC_OFF = LDSCTL_OFF + 320, LDS_BYTES = 147456;

#define GAS __attribute__((address_space(1)))
#define LAS __attribute__((address_space(3)))
typedef unsigned short bf16;
typedef unsigned v4u __attribute__((ext_vector_type(4)));
typedef unsigned v2u __attribute__((ext_vector_type(2)));
typedef float f32x4 __attribute__((ext_vector_type(4)));
#define LDS_WAIT() asm volatile("s_waitcnt lgkmcnt(0)" ::: "memory")
__device__ __forceinline__ unsigned f2bf(float f) { unsigned u = __builtin_bit_cast(unsigned, f); return (u + 0x7fffu + ((u >> 16) & 1u)) >> 16; }
__device__ __forceinline__ unsigned pk2(float lo, float hi) { return f2bf(lo) | (f2bf(hi) << 16); }

#define XB_TMO      128
#define XB_XCNT(j)  (256  + 64 * (j))
#define XB_XSUB(j)  (1280 + 64 * (j))
#define XB_XGEN(j)  (2304 + 64 * (j))
#define XB_TOP      3328
#define XB_TOPGEN   3392
#define XCD_BAR_WORDS 3456
#define XB_SPIN_CAP (1u << 18)
__device__ __forceinline__ unsigned xb_ld(unsigned* p)              { return __hip_atomic_load(p, __ATOMIC_RELAXED, __HIP_MEMORY_SCOPE_AGENT); }
__device__ __forceinline__ unsigned xb_add(unsigned* p, unsigned v) { return __hip_atomic_fetch_add(p, v, __ATOMIC_RELAXED, __HIP_MEMORY_SCOPE_AGENT); }
__device__ __forceinline__ unsigned xb_xcc_id() { return (unsigned)__builtin_amdgcn_s_getreg((3 << 11) | 20) & 0xFu; }
#define XB_SPIN(cond, bar) do { unsigned _sp = 0; while (cond) { __builtin_amdgcn_s_sleep(1); \
    if ((++_sp & 255u) == 0u) { if (xb_ld(&(bar)[XB_TMO])) break; if (_sp > XB_SPIN_CAP) { atomicAdd(&(bar)[XB_TMO], 1u); break; } } } } while (0)
struct XcdBarrier { unsigned* bar; unsigned x; volatile LAS unsigned* st; };
__device__ __forceinline__ XcdBarrier xcd_barrier_post(unsigned* bar, volatile LAS unsigned* st) {
    XcdBarrier b; b.bar = bar; b.x = xb_xcc_id(); b.st = st;
    if (threadIdx.x == 0) (void)xb_add(&bar[XB_XCNT(b.x)], 1u);
    return b;
}
__device__ __forceinline__ void xcd_barrier_complete(unsigned* bar, unsigned x, unsigned& nloc, unsigned& nx) {
    const unsigned G = gridDim.x * gridDim.y * gridDim.z;
    unsigned sum, cnt, mine, sp = 0u;
    for (;;) {
        sum = 0u; cnt = 0u; mine = 0u;
#pragma unroll
        for (unsigned j = 0; j < 16; ++j) { const unsigned c = xb_ld(&bar[XB_XCNT(j)]); sum += c; cnt += (c > 0u) ? 1u : 0u; mine = (j == x) ? c : mine; }
        if (sum == G) break;
        __builtin_amdgcn_s_sleep(1);
        if ((++sp & 255u) == 0u) { if (xb_ld(&bar[XB_TMO])) break; if (sp > XB_SPIN_CAP) { atomicAdd(&bar[XB_TMO], 1u); break; } }
    }
    nloc = mine > 0u ? mine : 1u; nx = cnt > 0u ? cnt : 1u;
}
__device__ __forceinline__ void xcd_barrier(const XcdBarrier& b) {
    asm volatile("s_waitcnt vmcnt(0)" ::: "memory");
    __syncthreads();
    if (threadIdx.x == 0) {
        unsigned* bar = b.bar;
        __builtin_amdgcn_s_waitcnt(0);
        unsigned nloc = b.st[0], nx = b.st[1];
        if (nloc == 0u) { xcd_barrier_complete(bar, b.x, nloc, nx); b.st[0] = nloc; b.st[1] = nx; }
        const unsigned old = xb_add(&bar[XB_XSUB(b.x)], 1u);
        const unsigned gen = old / nloc;
        if (old + 1u == (gen + 1u) * nloc) {
            __builtin_amdgcn_fence(__ATOMIC_RELEASE, "agent");
            asm volatile("s_waitcnt vmcnt(0)" ::: "memory");
            const unsigned og = xb_add(&bar[XB_TOP], 1u);
            const unsigned tg = og / nx;
            if (og + 1u == (tg + 1u) * nx) xb_add(&bar[XB_TOPGEN], 1u);
            else XB_SPIN(xb_ld(&bar[XB_TOPGEN]) == tg, bar);
            __builtin_amdgcn_fence(__ATOMIC_ACQUIRE, "agent");
            xb_add(&bar[XB_XGEN(b.x)], 1u);
            asm volatile("s_waitcnt vmcnt(0)" ::: "memory");
        } else {
            XB_SPIN(xb_ld(&bar[XB_XGEN(b.x)]) == gen, bar);
            __builtin_amdgcn_fence(__ATOMIC_ACQUIRE, "agent");
            asm volatile("s_waitcnt vmcnt(0)" ::: "memory");
        }
    }
    __syncthreads();
}

struct Frame {
    LAS unsigned char* lds;
    int tid, lane, wave, vcu, G;
};
struct Args {
    const float *x, *c, *w_ada, *b_ada, *g_pre_mix, *g_post_mix, *g_pre_mlp, *g_post_mlp, *w_in, *sinks, *w_bg, *b_bg, *w_ps, *w_pb, *w_out, *w_f1, *w_f2;
    float* out; unsigned char* ws; int ph_lo, ph_hi;
};

__device__ __forceinline__ float wave_sum(float v) {
#pragma unroll
    for (int o = 1; o < 64; o <<= 1) v += __shfl_xor(v, o);
    return v;
}
__device__ const double ROPE_INVF[64] = {1.0, 0.8659643233600653, 0.7498942093324559, 0.6493816315762113, 0.5623413251903491, 0.4869675251658631, 0.4216965034285822, 0.3651741272548377, 0.31622776601683794, 0.27384196342643613, 0.23713737056616552, 0.2053525026457146, 0.1778279410038923, 0.1539926526059492, 0.1333521432163324, 0.11547819846894582, 0.1, 0.08659643233600653, 0.07498942093324558, 0.06493816315762113, 0.05623413251903491, 0.04869675251658631, 0.042169650342858224, 0.03651741272548377, 0.03162277660168379, 0.027384196342643614, 0.023713737056616554, 0.02053525026457146, 0.01778279410038923, 0.01539926526059492, 0.01333521432163324, 0.011547819846894581, 0.01, 0.008659643233600654, 0.007498942093324558, 0.006493816315762113, 0.005623413251903491, 0.004869675251658631, 0.004216965034285823, 0.003651741272548377, 0.0031622776601683794, 0.0027384196342643613, 0.0023713737056616554, 0.002053525026457146, 0.0017782794100389228, 0.001539926526059492, 0.001333521432163324, 0.0011547819846894581, 0.001, 0.0008659643233600654, 0.0007498942093324559, 0.0006493816315762113, 0.0005623413251903491, 0.0004869675251658631, 0.00042169650342858224, 0.0003651741272548377, 0.00031622776601683794, 0.0002738419634264361, 0.00023713737056616554, 0.0002053525026457146, 0.00017782794100389227, 0.0001539926526059492, 0.0001333521432163324, 0.00011547819846894582};

struct TDesc { const float* W; bf16* WT; int K, N, row_off, rope_lim, item, fp8; };
__device__ __forceinline__ void p0_tr_load(const TDesc& t, f32x4 (&v)[16], int lane) {
    const int nblk = t.N / 64, kb = t.item / nblk, nb = t.item % nblk, k0 = 64 * kb, n0 = 64 * nb;
    const int kq = lane >> 4, nn = 4 * (lane & 15);
#pragma unroll
    for (int i = 0; i < 16; ++i) v[i] = *(const f32x4*)(t.W + (size_t)(k0 + 4 * i + kq) * t.N + n0 + nn);
}
__device__ __forceinline__ void p0_tr_store(const TDesc& t, const f32x4 (&v)[16], LAS float* scr, int lane) {
    const int nblk = t.N / 64, kb = t.item / nblk, nb = t.item % nblk, k0 = 64 * kb, n0 = 64 * nb;
    const int kq = lane >> 4, nn = 4 * (lane & 15);
#pragma unroll
    for (int i = 0; i < 16; ++i) { LAS float* s = scr + (4 * i + kq) * 65 + nn; s[0] = v[i].x; s[1] = v[i].y; s[2] = v[i].z; s[3] = v[i].w; }
    LDS_WAIT(); asm volatile("" ::: "memory");
    const int c = lane & 7;
#pragma unroll
    for (int j = 0; j < 8; ++j) { const int n = (lane >> 3) + 8 * j; const LAS float* s = scr + (8 * c) * 65 + n;
        v4u o; o.x = pk2(s[0 * 65], s[1 * 65]); o.y = pk2(s[2 * 65], s[3 * 65]); o.z = pk2(s[4 * 65], s[5 * 65]); o.w = pk2(s[6 * 65], s[7 * 65]);
        int nd = n0 + n;
        if (t.rope_lim) {
            int sb_, sd_; bool rp_ = false;
            if (nd < 2048) { sb_ = 0; sd_ = 3072; rp_ = true; } else if (nd < 2560) { sb_ = 2048; sd_ = 0; rp_ = true; } else if (nd < 3072) { sb_ = 2560; sd_ = 512; }
            else if (nd < 5120) { sb_ = 3072; sd_ = 5120; } else if (nd < 7168) { sb_ = 5120; sd_ = 7168; } else { sb_ = 7168; sd_ = 1024; }
            int loc = nd - sb_; if (rp_) { const int d = loc & 127; loc = (loc & ~127) + (d < 64 ? 8 * (d >> 2) + (d & 3) : 8 * ((d - 64) >> 2) + 4 + (d & 3)); }
            nd = sd_ + loc; }
        *(v4u*)(t.WT + (size_t)(t.row_off + nd) * t.K + k0 + 8 * c) = o; }
    LDS_WAIT(); asm volatile("" ::: "memory");
}
__device__ __forceinline__ void p0_gemv(Frame& F, const Args& a, float* mod) {
    LAS f32x4* cact = (LAS f32x4*)F.lds;
    LAS float* red = (LAS float*)(F.lds + 65536);
    for (int k = F.tid; k < D; k += NWAVES * 64) { f32x4 v;
#pragma unroll
        for (int b = 0; b < 4; ++b) { const float xx = a.c[b * D + k]; v[b] = xx / (1.f + expf(-xx)); }
        cact[k] = v; }
    __syncthreads();
    const int half = F.lane >> 5, l32 = F.lane & 31; const bool act = l32 < 24;
    for (int cg = F.vcu; cg < NMOD / 96; cg += F.G) {
        f32x4 acc[4];
#pragma unroll
        for (int b = 0; b < 4; ++b) acc[b] = (f32x4){0.f, 0.f, 0.f, 0.f};
        const int kbase = 512 * F.wave + half;
        const float* wp = a.w_ada + (size_t)kbase * NMOD + 96 * cg + 4 * (act ? l32 : 0);
#define GV_LOAD(w, kk) _Pragma("unroll") for (int u = 0; u < 16; ++u) w[u] = *(const f32x4*)(wp + (size_t)(2 * ((kk) + u)) * NMOD)
#define GV_FMA(w, kk) _Pragma("unroll") for (int u = 0; u < 16; ++u) { const f32x4 ca = cact[kbase + 2 * ((kk) + u)]; _Pragma("unroll") for (int b = 0; b < 4; ++b) acc[b] += w[u] * ca[b]; }
        f32x4 wA[16], wB[16];
        GV_LOAD(wA, 0);
#pragma unroll 1
        for (int kk = 0; kk < 224; kk += 32) {
            GV_LOAD(wB, kk + 16); asm volatile("" ::: "memory");
            GV_FMA(wA, kk);
            GV_LOAD(wA, kk + 32); asm volatile("" ::: "memory");
            GV_FMA(wB, kk + 16);
        }
        GV_LOAD(wB, 240); asm volatile("" ::: "memory");
        GV_FMA(wA, 224);
        GV_FMA(wB, 240);
#undef GV_LOAD
#undef GV_FMA
#pragma unroll
        for (int b = 0; b < 4; ++b)
#pragma unroll
            for (int j = 0; j < 4; ++j) acc[b][j] += __shfl_xor(acc[b][j], 32);
        if (half == 0 && act) {
#pragma unroll
            for (int b = 0; b < 4; ++b) *(LAS f32x4*)(red + (F.wave * 4 + b) * 96 + 4 * l32) = acc[b]; }
        __syncthreads();
        if (F.tid < 384) { const int b = F.tid / 96, j = F.tid % 96; float s = 0.f;
#pragma unroll
            for (int w = 0; w < 8; ++w) s += red[(w * 4 + b) * 96 + j];
            mod[b * NMOD + 96 * cg + j] = s + a.b_ada[96 * cg + j]; }
        __syncthreads();
    }
}
__device__ __forceinline__ void p0_rope_table(Frame& F, float* cosT, float* sinT) {
    const double TWO_PI_HI = 6.283185307179586232, TWO_PI_LO = 2.4492935982947064e-16, INV_2PI = 0.15915494309189533577;
    for (int idx = F.vcu * (NWAVES * 64) + F.tid; idx < SEQ * 64; idx += F.G * NWAVES * 64) {
        const int pos = idx >> 6, i = idx & 63;
        const double ang = (double)pos * ROPE_INVF[i];
        const double n = __builtin_rint(ang * INV_2PI);
        double r = __builtin_fma(-n, TWO_PI_HI, ang); r = __builtin_fma(-n, TWO_PI_LO, r);
        const double r2 = r * r; double tc = 1.0, ts = r, sc = 1.0, ss = r;
#pragma unroll 1
        for (int k = 1; k <= 15; ++k) { tc *= -r2 / (double)((2 * k - 1) * (2 * k)); ts *= -r2 / (double)((2 * k) * (2 * k + 1)); sc += tc; ss += ts; }
        cosT[idx] = (float)sc; sinT[idx] = (float)ss;
    }
}

__device__ __forceinline__ f32x4 ld_bf4(const bf16* p) { const v2u w = *(const v2u*)p; return (f32x4){__uint_as_float(w.x << 16), __uint_as_float(w.x & 0xffff0000u), __uint_as_float(w.y << 16), __uint_as_float(w.y & 0xffff0000u)}; }
__device__ __forceinline__ void st_bf4(bf16* p, f32x4 v) { v2u w; w.x = pk2(v.x, v.y); w.y = pk2(v.z, v.w); *(v2u*)p = w; }
__device__ __forceinline__ float sumsq4(f32x4 v) { return (v.x * v.x + v.y * v.y) + (v.z * v.z + v.w * v.w); }

#define LAUNDER_PTR(p) asm volatile("" : "+s"(p))
__device__ __forceinline__ float wave_max(float v) {
#pragma unroll
    for (int o = 1; o < 64; o <<= 1) v = fmaxf(v, __shfl_xor(v, o));
    return v;
}
__device__ __forceinline__ float amax4(f32x4 v) { return fmaxf(fmaxf(__builtin_fabsf(v.x), __builtin_fabsf(v.y)), fmaxf(__builtin_fabsf(v.z), __builtin_fabsf(v.w))); }
__device__ __forceinline__ unsigned q4_i8(f32x4 v, float inv) {
    const int a = (int)__builtin_rintf(v.x * inv), b = (int)__builtin_rintf(v.y * inv), c = (int)__builtin_rintf(v.z * inv), d = (int)__builtin_rintf(v.w * inv);
    return (unsigned)(a & 255) | ((unsigned)(b & 255) << 8) | ((unsigned)(c & 255) << 16) | ((unsigned)d << 24); }
constexpr int SLAB_PITCH = 8192 + 16;
struct SDesc { const float* W; unsigned char* dst; float* sc; int N, c0, r0, rope; };
template <int H> __device__ __forceinline__ void slab_load(const SDesc& s, f32x4 (&va)[8], f32x4 (&vb)[8], int tid) {
    const float* p = s.W + (size_t)(2 * (tid >> 2) + 2048 * H) * s.N + s.c0 + 4 * (tid & 3);
#pragma unroll
    for (int i = 0; i < 8; ++i) { const float* q = p + (size_t)(256 * i) * s.N; va[i] = *(const f32x4*)q; vb[i] = *(const f32x4*)(q + s.N); }
}
template <int H> __device__ __forceinline__ void slab_stage(LAS unsigned char* lds, const f32x4 (&va)[8], const f32x4 (&vb)[8], int tid) {
    LAS unsigned char* t = lds + (4 * (tid & 3)) * SLAB_PITCH + 4 * (tid >> 2) + 4096 * H;
#pragma unroll
    for (int i = 0; i < 8; ++i)
#pragma unroll
        for (int j = 0; j < 4; ++j) *(LAS unsigned*)(t + j * SLAB_PITCH + 512 * i) = pg8::cvt_pk_bf16(va[i][j], vb[i][j]);
}
__device__ __forceinline__ void slab_quant(const SDesc& s, const LAS unsigned char* lds, int wave, int lane) {
#pragma unroll 1
    for (int rr = 0; rr < 2; ++rr) { const int n = 2 * wave + rr;
        v4u w[8]; float am = 0.f;
#pragma unroll
        for (int j = 0; j < 8; ++j) w[j] = *(const LAS v4u*)(lds + n * SLAB_PITCH + 16 * (lane + 64 * j));
#pragma unroll
        for (int j = 0; j < 8; ++j)
#pragma unroll
            for (int e = 0; e < 4; ++e) { const unsigned x = w[j][e]; am = fmaxf(am, fmaxf(__builtin_fabsf(__uint_as_float(x << 16)), __builtin_fabsf(__uint_as_float(x & 0xffff0000u)))); }
        am = wave_max(am); const float inv = am > 0.f ? 127.f / am : 0.f;
        int loc = s.c0 + n; if (s.rope) { const int d = loc & 127; loc = (loc & ~127) + (d < 64 ? 8 * (d >> 2) + (d & 3) : 8 * ((d - 64) >> 2) + 4 + (d & 3)); }
        const int drow = s.r0 + loc;
        if (lane == 0) s.sc[drow] = am * (1.f / 127.f);
#pragma unroll
        for (int j = 0; j < 8; ++j) { v2u o;
            o.x = q4_i8((f32x4){__uint_as_float(w[j].x << 16), __uint_as_float(w[j].x & 0xffff0000u), __uint_as_float(w[j].y << 16), __uint_as_float(w[j].y & 0xffff0000u)}, inv);
            o.y = q4_i8((f32x4){__uint_as_float(w[j].z << 16), __uint_as_float(w[j].z & 0xffff0000u), __uint_as_float(w[j].w << 16), __uint_as_float(w[j].w & 0xffff0000u)}, inv);
            *(v2u*)(s.dst + (size_t)drow * D + 8 * (lane + 64 * j)) = o; }
    }
}
__device__ __forceinline__ void ks_quant(const LAS unsigned char* lds, unsigned char* dst, float* sc, int* csum, int cs, int q, unsigned mb0, unsigned mb1, int wave, int lane) {
#pragma unroll 1
    for (int rr = 0; rr < 2; ++rr) { const int n = 2 * wave + rr, col = 16 * cs + n;
        v4u w[8];
#pragma unroll
        for (int j = 0; j < 8; ++j) w[j] = *(const LAS v4u*)(lds + n * SLAB_PITCH + 16 * (lane + 64 * j));
        const float am = __uint_as_float(rr ? mb1 : mb0), inv = am > 0.f ? 127.f / am : 0.f;
        if (lane == 0 && q == 0) sc[col] = am * (1.f / 127.f);
        float qs = 0.f;
#pragma unroll
        for (int j = 0; j < 8; ++j) { v2u o; float t[8];
#pragma unroll
            for (int e = 0; e < 4; ++e) { const unsigned x = w[j][e]; t[2 * e] = __builtin_rintf(__uint_as_float(x << 16) * inv); t[2 * e + 1] = __builtin_rintf(__uint_as_float(x & 0xffff0000u) * inv); }
#pragma unroll
            for (int e = 0; e < 8; ++e) qs += t[e];
            o.x = ((unsigned)(int)t[0] & 255u) | (((unsigned)(int)t[1] & 255u) << 8) | (((unsigned)(int)t[2] & 255u) << 16) | ((unsigned)(int)t[3] << 24);
            o.y = ((unsigned)(int)t[4] & 255u) | (((unsigned)(int)t[5] & 255u) << 8) | (((unsigned)(int)t[6] & 255u) << 16) | ((unsigned)(int)t[7] << 24);
            *(v2u*)(dst + (size_t)col * FF + 4096 * q + 8 * (lane + 64 * j)) = o; }
        qs = wave_sum(qs);
        if (lane == 0) atomicAdd(csum + col, (int)qs);
    }
}
__device__ __forceinline__ void p1_rows(Frame& F, const Args& a, const float* mod, bf16* H, unsigned char* H8, float* SH) {
    int lane_ = F.lane; asm volatile("" : "+v"(lane_)); const int LN = lane_;
    const int gw = F.vcu * NWAVES + F.wave, NGW = F.G * NWAVES;
    for (int r0 = gw * 8; r0 < M; r0 += NGW * 8) {
        const int b = r0 >> 12;
#pragma unroll 1
        for (int r = 0; r < 8; ++r) { const size_t row = (size_t)(r0 + r);
            const float* mb = mod + b * NMOD; const float* gp = a.g_pre_mix; LAUNDER_PTR(mb); LAUNDER_PTR(gp);
            f32x4 v[16]; float ss = 0.f;
#pragma unroll
            for (int j = 0; j < 16; ++j) { v[j] = *(const f32x4*)(a.x + row * D + 4 * LN + 256 * j); ss += sumsq4(v[j]); }
            const float rstd = 1.f / sqrtf(wave_sum(ss) * (1.f / D) + NORM_EPS);
            float am = 0.f;
#pragma unroll
            for (int j = 0; j < 16; ++j) { const int col = 4 * LN + 256 * j; if ((j & 3) == 0) asm volatile("" ::: "memory");
                const f32x4 av = *(const GAS f32x4*)(gp + col) * (*(const GAS f32x4*)(mb + D + col) + 1.f);
                v[j] = v[j] * rstd * av + *(const GAS f32x4*)(mb + col);
                st_bf4(H + row * D + col, v[j]); am = fmaxf(am, amax4(v[j])); }
            am = wave_max(am); const float inv = am > 0.f ? 127.f / am : 0.f;
            if (LN == 0) SH[row] = am * (1.f / 127.f);
#pragma unroll
            for (int j = 0; j < 16; ++j) *(unsigned*)(H8 + row * D + 4 * LN + 256 * j) = q4_i8(v[j], inv);
        }
    }
}
__device__ __forceinline__ void quant_rows(Frame& F, const bf16* __restrict__ src, unsigned char* __restrict__ dst, float* __restrict__ sc, int nrows) {
    int lane_ = F.lane; asm volatile("" : "+v"(lane_)); const int LN = lane_;
    const int gw = F.vcu * NWAVES + F.wave, NGW = F.G * NWAVES;
#pragma unroll 1
    for (int n = gw; n < nrows; n += NGW) {
        v4u w[8]; float am = 0.f;
#pragma unroll
        for (int j = 0; j < 8; ++j) w[j] = *(const v4u*)(src + (size_t)n * D + 8 * (LN + 64 * j));
#pragma unroll
        for (int j = 0; j < 8; ++j) {
#pragma unroll
            for (int e = 0; e < 4; ++e) { const unsigned x = w[j][e]; am = fmaxf(am, fmaxf(__builtin_fabsf(__uint_as_float(x << 16)), __builtin_fabsf(__uint_as_float(x & 0xffff0000u)))); } }
        am = wave_max(am); const float inv = am > 0.f ? 127.f / am : 0.f;
        if (LN == 0) sc[n] = am * (1.f / 127.f);
#pragma unroll
        for (int j = 0; j < 8; ++j) { v2u o;
            o.x = q4_i8((f32x4){__uint_as_float(w[j].x << 16), __uint_as_float(w[j].x & 0xffff0000u), __uint_as_float(w[j].y << 16), __uint_as_float(w[j].y & 0xffff0000u)}, inv);
            o.y = q4_i8((f32x4){__uint_as_float(w[j].z << 16), __uint_as_float(w[j].z & 0xffff0000u), __uint_as_float(w[j].w << 16), __uint_as_float(w[j].w & 0xffff0000u)}, inv);
            *(v2u*)(dst + (size_t)n * D + 8 * (LN + 64 * j)) = o; }
    }
}
__device__ __forceinline__ void quant_rows_long(Frame& F, const bf16* __restrict__ src, unsigned char* __restrict__ dst, float* __restrict__ sc, int* __restrict__ csum, int nrows) {
    int lane_ = F.lane; asm volatile("" : "+v"(lane_)); const int LN = lane_;
    const int gw = F.vcu * NWAVES + F.wave, NGW = F.G * NWAVES;
#pragma unroll 1
    for (int n = gw; n < nrows; n += NGW) {
        float am = 0.f;
#pragma unroll 1
        for (int c = 0; c < 4; ++c) { v4u w[8];
#pragma unroll
            for (int j = 0; j < 8; ++j) w[j] = *(const v4u*)(src + (size_t)n * FF + c * 4096 + 8 * (LN + 64 * j));
#pragma unroll
            for (int j = 0; j < 8; ++j)
#pragma unroll
                for (int e = 0; e < 4; ++e) { const unsigned x = w[j][e]; am = fmaxf(am, fmaxf(__builtin_fabsf(__uint_as_float(x << 16)), __builtin_fabsf(__uint_as_float(x & 0xffff0000u)))); } }
        am = wave_max(am); const float inv = am > 0.f ? 127.f / am : 0.f;
        float qs = 0.f;
#pragma unroll 1
        for (int c = 0; c < 4; ++c) { v4u w[8];
#pragma unroll
            for (int j = 0; j < 8; ++j) w[j] = *(const v4u*)(src + (size_t)n * FF + c * 4096 + 8 * (LN + 64 * j));
#pragma unroll
            for (int j = 0; j < 8; ++j) { v2u o; float t[8];
#pragma unroll
                for (int e = 0; e < 4; ++e) { const unsigned x = w[j][e]; t[2 * e] = __builtin_rintf(__uint_as_float(x << 16) * inv); t[2 * e + 1] = __builtin_rintf(__uint_as_float(x & 0xffff0000u) * inv); }
#pragma unroll
                for (int e = 0; e < 8; ++e) qs += t[e];
                o.x = ((unsigned)(int)t[0] & 255u) | (((unsigned)(int)t[1] & 255u) << 8) | (((unsigned)(int)t[2] & 255u) << 16) | ((unsigned)(int)t[3] << 24);
                o.y = ((unsigned)(int)t[4] & 255u) | (((unsigned)(int)t[5] & 255u) << 8) | (((unsigned)(int)t[6] & 255u) << 16) | ((unsigned)(int)t[7] << 24);
                *(v2u*)(dst + (size_t)n * FF + c * 4096 + 8 * (LN + 64 * j)) = o; } }
        qs = wave_sum(qs);
        if (LN == 0) { sc[n] = am * (1.f / 127.f); csum[n] = (int)qs; }
    }
}
__device__ __forceinline__ void requant_u(Frame& F, const bf16* __restrict__ U, unsigned char* __restrict__ U8, float* __restrict__ su) {
    int lane_ = F.lane; asm volatile("" : "+v"(lane_)); const int LN = lane_;
    LAS float* red = (LAS float*)(F.lds + RING_OFF);
    const int q = F.wave & 3, half = F.wave >> 2;
    const size_t coff = (size_t)q * 4096 + 8 * LN;
#define RQ_LOAD(w, r) _Pragma("unroll") for (int j = 0; j < 8; ++j) w[j] = *(const v4u*)(U + (size_t)(r) * FF + coff + 512 * j)
    v4u wc[8], wn[8];
    if (F.vcu < M / 2) RQ_LOAD(wc, 2 * F.vcu + half);
#pragma unroll 1
    for (int pi = F.vcu, p = 0; pi < M / 2; pi += F.G, ++p) { const int r = 2 * pi + half, rn = 2 * (pi + F.G < M / 2 ? pi + F.G : pi) + half;
        float am = 0.f;
#pragma unroll
        for (int j = 0; j < 8; ++j)
#pragma unroll
            for (int e = 0; e < 4; ++e) { const unsigned x = wc[j][e]; am = fmaxf(am, fmaxf(__uint_as_float(x << 16), __uint_as_float(x & 0xffff0000u))); }
        am = wave_max(am);
        if (LN == 0) red[(p & 1) * 8 + F.wave] = am;
        RQ_LOAD(wn, rn);
        __syncthreads();
        { const LAS float* rp = red + (p & 1) * 8 + 4 * half; am = fmaxf(fmaxf(rp[0], rp[1]), fmaxf(rp[2], rp[3])); }
        const float inv = am > 0.f ? 255.f / am : 0.f;
        if (LN == 0 && q == 0) su[r] = am * (1.f / 255.f);
#pragma unroll
        for (int j = 0; j < 8; ++j) { v2u o; int t[8];
#pragma unroll
            for (int e = 0; e < 4; ++e) { const unsigned x = wc[j][e]; t[2 * e] = (int)__builtin_rintf(__uint_as_float(x << 16) * inv) - 128; t[2 * e + 1] = (int)__builtin_rintf(__uint_as_float(x & 0xffff0000u) * inv) - 128; }
            o.x = ((unsigned)t[0] & 255u) | (((unsigned)t[1] & 255u) << 8) | (((unsigned)t[2] & 255u) << 16) | ((unsigned)t[3] << 24);
            o.y = ((unsigned)t[4] & 255u) | (((unsigned)t[5] & 255u) << 8) | (((unsigned)t[6] & 255u) << 16) | ((unsigned)t[7] << 24);
            *(v2u*)(U8 + (size_t)r * FF + coff + 512 * j) = o; }
#pragma unroll
        for (int j = 0; j < 8; ++j) wc[j] = wn[j];
    }
#undef RQ_LOAD
    __syncthreads();
}
__device__ __forceinline__ f32x4 unpk4(v2u w) { return (f32x4){__uint_as_float(w.x << 16), __uint_as_float(w.x & 0xffff0000u), __uint_as_float(w.y << 16), __uint_as_float(w.y & 0xffff0000u)}; }
__device__ __forceinline__ void p6_rows(Frame& F, const Args& a, const float* mod, const bf16* MX, unsigned char* H2, float* S2) {
    int lane_ = F.lane; asm volatile("" : "+v"(lane_)); const int LN = lane_;
    const int gw = F.vcu * NWAVES + F.wave, NGW = F.G * NWAVES;
    for (int r0 = gw * 8; r0 < M; r0 += NGW * 8) {
        const int b = r0 >> 12;
#pragma unroll 1
        for (int r = 0; r < 8; ++r) { const size_t row = (size_t)(r0 + r);
            const float* mb = mod + b * NMOD; LAUNDER_PTR(mb);
            v2u mp[16]; f32x4 xr[16]; float ss = 0.f;
#pragma unroll
            for (int j = 0; j < 16; ++j) mp[j] = *(const v2u*)(MX + row * D + 4 * LN + 256 * j);
#pragma unroll
            for (int j = 0; j < 16; ++j) xr[j] = *(const f32x4*)(a.x + row * D + 4 * LN + 256 * j);
#pragma unroll
            for (int j = 0; j < 16; ++j) ss += sumsq4(unpk4(mp[j]));
            const float rstd = 1.f / sqrtf(wave_sum(ss) * (1.f / D) + NORM_EPS);
            float ss2 = 0.f;
#pragma unroll
            for (int j = 0; j < 16; ++j) { const int col = 4 * LN + 256 * j; if ((j & 3) == 0) asm volatile("" ::: "memory");
                const f32x4 g1 = *(const GAS f32x4*)(mb + 2 * D + col) * *(const f32x4*)(a.g_post_mix + col);
                xr[j] = xr[j] + g1 * (unpk4(mp[j]) * rstd);
                *(f32x4*)(a.out + row * D + col) = xr[j]; ss2 += sumsq4(xr[j]); }
            const float rstd2 = 1.f / sqrtf(wave_sum(ss2) * (1.f / D) + NORM_EPS);
            float am = 0.f;
#pragma unroll
            for (int j = 0; j < 16; ++j) { const int col = 4 * LN + 256 * j; if ((j & 3) == 0) asm volatile("" ::: "memory");
                const f32x4 a2 = *(const f32x4*)(a.g_pre_mlp + col) * (*(const GAS f32x4*)(mb + 4 * D + col) + 1.f);
                xr[j] = xr[j] * rstd2 * a2 + *(const GAS f32x4*)(mb + 3 * D + col); am = fmaxf(am, amax4(xr[j])); }
            am = wave_max(am); const float inv = am > 0.f ? 127.f / am : 0.f;
            if (LN == 0) S2[row] = am * (1.f / 127.f);
#pragma unroll
            for (int j = 0; j < 16; ++j) *(unsigned*)(H2 + row * D + 4 * LN + 256 * j) = q4_i8(xr[j], inv);
        }
    }
}
__device__ __forceinline__ void p9_rows(Frame& F, const Args& a, const float* mod, const bf16* FB) {
    int lane_ = F.lane; asm volatile("" : "+v"(lane_)); const int LN = lane_;
    const int gw = F.vcu * NWAVES + F.wave, NGW = F.G * NWAVES;
    for (int r0 = gw * 8; r0 < M; r0 += NGW * 8) {
        const int b = r0 >> 12;
#pragma unroll 1
        for (int r = 0; r < 8; ++r) { const size_t row = (size_t)(r0 + r);
            const float* mb = mod + b * NMOD; LAUNDER_PTR(mb);
            v2u mp[16]; f32x4 xr[16]; float ss = 0.f;
#pragma unroll
            for (int j = 0; j < 16; ++j) mp[j] = *(const v2u*)(FB + row * D + 4 * LN + 256 * j);
#pragma unroll
            for (int j = 0; j < 16; ++j) xr[j] = *(const f32x4*)(a.out + row * D + 4 * LN + 256 * j);
#pragma unroll
            for (int j = 0; j < 16; ++j) ss += sumsq4(unpk4(mp[j]));
            const float rstd = 1.f / sqrtf(wave_sum(ss) * (1.f / D) + NORM_EPS);
#pragma unroll
            for (int j = 0; j < 16; ++j) { const int col = 4 * LN + 256 * j; if ((j & 3) == 0) asm volatile("" ::: "memory");
                const f32x4 g2 = *(const GAS f32x4*)(mb + 5 * D + col) * *(const f32x4*)(a.g_post_mlp + col);
                *(f32x4*)(a.out + row * D + col) = xr[j] + g2 * (unpk4(mp[j]) * rstd); }
        }
    }
}

#ifndef P7_NT
#define P7_NT false
#endif
#ifndef P8_WGM
#define P8_WGM 8
#endif
#ifndef SB_EARLY
#define SB_EARLY 1
#endif
__global__ void __launch_bounds__(NWAVES * 64, 2) fwd_kernel(Args args) {
    extern __shared__ __attribute__((aligned(16))) unsigned char lds[];
    Frame F;
    F.lds = (LAS unsigned char*)lds;
    F.tid = threadIdx.x; F.lane = F.tid & 63; F.wave = __builtin_amdgcn_readfirstlane(F.tid >> 6);
    F.G = gridDim.x; { const int bx = blockIdx.x; F.vcu = (F.G % 8 == 0) ? (bx % 8) * (F.G / 8) + bx / 8 : bx; }
    unsigned char* ws = args.ws;
    unsigned* ctl = (unsigned*)(ws + WS_CTL);
    float* mod = (float*)(ws + WS_MOD); float* cosT = (float*)(ws + WS_COS); float* sinT = (float*)(ws + WS_SIN);
    bf16* W1 = (bf16*)(ws + WS_W1); bf16* WPS = (bf16*)(ws + WS_WPS); bf16* WPB = (bf16*)(ws + WS_WPB); bf16* WO = (bf16*)(ws + WS_WO); bf16* WF1 = (bf16*)(ws + WS_WF1); bf16* WF2 = (bf16*)(ws + WS_WF2);
    bf16* BA = (bf16*)(ws + WS_A); bf16* BB = (bf16*)(ws + WS_B); unsigned char* H8 = ws + WS_H8; unsigned char* W8G = ws + WS_W8G; unsigned char* W8F = ws + WS_W8F;
    float* SH = (float*)(ws + WS_SH); float* S2 = (float*)(ws + WS_S2); float* SG = (float*)(ws + WS_SG); float* SF = (float*)(ws + WS_SF);
    unsigned char* W8O = ws + WS_W8O; unsigned char* U8 = ws + WS_U8; float* SU = (float*)(ws + WS_SU); float* SO = (float*)(ws + WS_SO); int* CO = (int*)(ws + WS_CO);
    bf16* QA = (bf16*)(ws + WS_C); bf16* KA = (bf16*)(ws + WS_C + 64 * MiB); bf16* VA = (bf16*)(ws + WS_C + 80 * MiB); bf16* QB = (bf16*)(ws + WS_C + 96 * MiB);
    bf16* KB = (bf16*)(ws + WS_C + 160 * MiB); bf16* VB = (bf16*)(ws + WS_C + 224 * MiB); bf16* GT = (bf16*)(ws + WS_C + 288 * MiB); bf16* UB = (bf16*)(ws + WS_C);
    bf16* ATT_SWA = BB; bf16* ATT_SB = BB + (size_t)M * 2048;
    for (int u = F.tid; u < (LDS_BYTES - LDSCTL_OFF) / 4; u += NWAVES * 64) ((LAS unsigned*)(F.lds + LDSCTL_OFF))[u] = 0u;
    __syncthreads();
    XcdBarrier bar = xcd_barrier_post(ctl + CW_BAR, (volatile LAS unsigned*)(F.lds + MISC_OFF) + 8);

    const int lo = args.ph_lo, hi = args.ph_hi;
#define IN(k) (lo <= (k) && (k) < hi)
#define BOTH(k) (IN(k) && IN((k) + 1))
    for (int rep_ = 0; rep_ < ((DUP_PHASE == 0) ? 2 : 1); ++rep_) if (IN(0)) {
        if (rep_) xcd_barrier(bar);
    {
        for (int sr_ = 0; sr_ < ((DUP_SUB == 3) ? 2 : 1); ++sr_) p0_gemv(F, args, mod);
        p0_rope_table(F, cosT, sinT);
        {
            constexpr int NSLAB = 1920;
#define SLAB_DECODE(sd, s_) do { int q_ = (s_); \
                if (q_ < 128) { sd = SDesc{args.w_in, W8G, SG, D_IN, 16 * q_, 0, 1}; break; } q_ -= 128; \
                if (q_ < 256) { sd = SDesc{args.w_in, W8G, SG, D_IN, 3072 + 16 * q_, 2048 - 3072, 0}; break; } q_ -= 256; \
                if (q_ < 512) { sd = SDesc{args.w_bg, W8G, SG, NG, 16 * q_, 6144, 0}; break; } q_ -= 512; \
                sd = SDesc{args.w_f1, W8F, SF, FF, 16 * q_, 0, 0}; } while (0)
            int stid = F.tid; asm volatile("" : "+v"(stid)); const int slane = stid & 63, swave = __builtin_amdgcn_readfirstlane(stid >> 6);
            const int nmine = 7 + ((F.G == 256 && F.vcu >= 128) ? 1 : 0);
            auto slab_of = [&](int i) -> int { if (F.G == 256) return i < 7 ? 256 * i + F.vcu : 1792 + F.vcu - 128; return F.vcu + i * F.G; };
            auto have = [&](int i) -> bool { if (F.G == 256) return i < nmine; return F.vcu + i * F.G < NSLAB; };
            for (int sr_ = 0; sr_ < ((DUP_SUB == 1) ? 2 : 1); ++sr_) if (have(0)) {
                SDesc sc_; SLAB_DECODE(sc_, slab_of(0)); f32x4 va0[8], vb0[8], va1[8], vb1[8]; slab_load<0>(sc_, va0, vb0, stid); slab_load<1>(sc_, va1, vb1, stid);
                for (int i = 0;; ++i) {
                    const bool more = have(i + 1); SDesc sn_ = sc_; if (more) SLAB_DECODE(sn_, slab_of(i + 1));
                    slab_stage<0>(F.lds, va0, vb0, stid); asm volatile("" ::: "memory");
                    if (more) slab_load<0>(sn_, va0, vb0, stid);
                    asm volatile("" ::: "memory");
                    slab_stage<1>(F.lds, va1, vb1, stid); asm volatile("" ::: "memory");
                    if (more) slab_load<1>(sn_, va1, vb1, stid);
                    __syncthreads();
                    slab_quant(sc_, F.lds, swave, slane);
                    __syncthreads();
                    if (!more) break;
                    sc_ = sn_;
                }
            }
#undef SLAB_DECODE
            {
                unsigned* kcnt = ctl + CW_KS; unsigned* cmx = (unsigned*)(ws + WS_CMX);
                int it = F.vcu;
                if (it < 1024) {
                    SDesc sc_{args.w_f2 + (size_t)(it & 3) * 4096 * D, W8O, SO, D, 16 * (it >> 2), 0, 0};
                    f32x4 va0[8], vb0[8], va1[8], vb1[8]; slab_load<0>(sc_, va0, vb0, stid); slab_load<1>(sc_, va1, vb1, stid);
                    for (;;) {
                        const int cs = it >> 2, q = it & 3, itn = it + F.G; const bool more = itn < 1024;
                        slab_stage<0>(F.lds, va0, vb0, stid); slab_stage<1>(F.lds, va1, vb1, stid);
                        __syncthreads();
                        {
                            unsigned got = 0u;
#pragma unroll 1
                            for (int rr = 0; rr < 2; ++rr) { const int n = 2 * swave + rr; float am = 0.f;
#pragma unroll
                                for (int j = 0; j < 8; ++j) { const v4u w = *(const LAS v4u*)(F.lds + n * SLAB_PITCH + 16 * (slane + 64 * j));
#pragma unroll
                                    for (int e = 0; e < 4; ++e) { const unsigned x = w[e]; am = fmaxf(am, fmaxf(__builtin_fabsf(__uint_as_float(x << 16)), __builtin_fabsf(__uint_as_float(x & 0xffff0000u)))); } }
                                am = wave_max(am);
                                if (slane == 0) got |= atomicMax(cmx + 16 * cs + n, __float_as_uint(am)); }
                            asm volatile("" :: "v"(got));
                        }
                        asm volatile("s_waitcnt vmcnt(0)" ::: "memory");
                        __syncthreads();
                        if (stid == 0) { (void)xb_add(&kcnt[cs], 1u); XB_SPIN(xb_ld(&kcnt[cs]) < 4u, ctl + CW_BAR); }
                        __syncthreads();
                        const unsigned mb0 = xb_ld(cmx + 16 * cs + 2 * swave), mb1 = xb_ld(cmx + 16 * cs + 2 * swave + 1);
                        SDesc sn_ = sc_;
                        if (more) { sn_ = SDesc{args.w_f2 + (size_t)(itn & 3) * 4096 * D, W8O, SO, D, 16 * (itn >> 2), 0, 0}; slab_load<0>(sn_, va0, vb0, stid); slab_load<1>(sn_, va1, vb1, stid); }
                        ks_quant(F.lds, W8O, SO, CO, cs, q, mb0, mb1, swave, slane);
                        __syncthreads();
                        if (!more) break;
                        it = itn; sc_ = sn_;
                    }
                }
            }
        }
        LAS float* scr = (LAS float*)(F.lds + F.wave * 16640);
        const int gw = F.vcu * NWAVES + F.wave, NGW = F.G * NWAVES;
        constexpr int I_IN = (D / 64) * 48, I_PS = (2048 / 64) * (D / 64), I_O = (D / 64) * (D / 64);
        constexpr int NITEMS = I_IN + 2 * I_PS + I_O;
#define P0_DECODE(t, it) do { int r_ = (it); \
            if (r_ < I_IN) { const int kb_ = r_ / 48, nb_ = r_ % 48; t = TDesc{args.w_in, W1, D, D_IN, 0, 2560, kb_ * (D_IN / 64) + (nb_ < 16 ? 32 + nb_ : 96 + nb_), 0}; break; } r_ -= I_IN; \
            if (r_ < I_PS) { t = TDesc{args.w_ps, WPS, 2048, D, 0, 0, r_, 0}; break; } r_ -= I_PS; \
            if (r_ < I_PS) { t = TDesc{args.w_pb, WPB, 2048, D, 0, 0, r_, 0}; break; } r_ -= I_PS; \
            t = TDesc{args.w_out, WO, D, D, 0, 0, r_, 0}; } while (0)
        for (int sr_ = 0; sr_ < ((DUP_SUB == 2) ? 2 : 1); ++sr_) { int it = gw;
        if (it < NITEMS) {
            TDesc tc; P0_DECODE(tc, it); f32x4 vc[16]; p0_tr_load(tc, vc, F.lane);
            for (;;) {
                const int itn = it + NGW; const bool more = itn < NITEMS;
                TDesc tn = tc; f32x4 vn[16];
                if (more) { P0_DECODE(tn, itn); p0_tr_load(tn, vn, F.lane); }
                p0_tr_store(tc, vc, scr, F.lane);
                if (!more) break;
                tc = tn; it = itn;
#pragma unroll
                for (int i = 0; i < 16; ++i) vc[i] = vn[i];
            }
        } }
#undef P0_DECODE
    }
        if (BOTH(0)) xcd_barrier(bar);
    }
    for (int rep_ = 0; rep_ < ((DUP_PHASE == 1) ? 2 : 1); ++rep_) if (IN(1)) {
        if (rep_) xcd_barrier(bar);
    p1_rows(F, args, mod, BA, H8, SH);
        if (BOTH(1)) xcd_barrier(bar);
    }
    for (int rep_ = 0; rep_ < ((DUP_PHASE == 2) ? 2 : 1); ++rep_) if (IN(2)) {
        if (rep_) xcd_barrier(bar);
    {
        { pg8::Gemm g{BA, W1, BA, W1, M, NB16, D}; pg8::StaticOrder S; S.init(M, NB16, F.G, (int)blockIdx.x);
          pg8::EpiProj E{KA, VA, VB, cosT, sinT};
          pg8::gemm_phase<pg8::EpiProj, pg8::StaticOrder, true, true>(F.lds + RING_OFF, g, S, E); }
        { pg8::Gemm g{(const bf16*)H8, (const bf16*)W8G, (const bf16*)H8, (const bf16*)W8G, M, NI8, D / 2}; pg8::StaticOrder S; S.init(M, NI8, F.G, (int)blockIdx.x);
          pg8::EpiI8Proj E{QA, QB, KB, GT, cosT, sinT, args.b_bg, SH, SG, 0.12751743f  };
          pg8::gemm_phase<pg8::EpiI8Proj, pg8::StaticOrder, true, true, true>(F.lds + RING_OFF, g, S, E); }
    }
        if (BOTH(2)) xcd_barrier(bar);
    }
    for (int rep_ = 0; rep_ < ((DUP_PHASE == 3) ? 2 : 1); ++rep_) if (IN(3)) {
        if (rep_) xcd_barrier(bar);
    {
        int atid = F.tid; asm volatile("" : "+v"(atid)); const int alane = atid & 63, awave = __builtin_amdgcn_readfirstlane(atid >> 6);
        const int nq = (F.vcu < 256) ? (256 - F.vcu + F.G - 1) / F.G : 0, ntot = 8 * nq;
#define P3_GET(idx, u, md) do { const int i_ = (idx); if (i_ < 4 * nq) { const int quad = F.vcu + (i_ >> 2) * F.G, j = i_ & 3, bh = quad >> 2, r = quad & 3, hh = bh & 15; \
            (u) = att::AUnit{QB + hh * HD, KB + hh * HD, VB + hh * HD, ATT_SB + hh * HD, 2048, 2048, 2048, bh >> 4, (j == 0) ? 15 - r : (j == 1) ? 11 - r : (j == 2) ? 4 + r : r, 0.f, 0, args.sinks}; (md) = 1; } \
          else { const int i2_ = i_ - 4 * nq, quad = F.vcu + (i2_ >> 2) * F.G, id = quad * 4 + (i2_ & 3), g_ = (id >> 6) & 3; \
            (u) = att::AUnit{QA + 4 * g_ * HD, KA + g_ * HD, VA + g_ * HD, ATT_SWA + 4 * g_ * HD, 2048, 512, 2048, id >> 8, id & 63, 0.f, 1, args.sinks + 4 * g_}; (md) = 0; } } while (0)
        if (ntot > 0) {
            att::AUnit cur, nxt; int mcur = 0, mnxt = 0; att::bf16x8 qf[8]; att::u32x4 kr0, kr1, vr0, vr1;
            P3_GET(0, cur, mcur); nxt = cur; att::attn_prefetch(cur, qf, kr0, kr1, vr0, vr1, atid, awave, alane);
            for (int idx = 0; idx < ntot; ++idx) { const bool hn = idx + 1 < ntot; if (hn) P3_GET(idx + 1, nxt, mnxt);
                if (mcur) att::attn_unit<1, (SB_EARLY != 0)>(F.lds, cur, hn, nxt, qf, kr0, kr1, vr0, vr1, atid, awave, alane);
                else      att::attn_unit<0, false>(F.lds, cur, hn, nxt, qf, kr0, kr1, vr0, vr1, atid, awave, alane);
                cur = nxt; mcur = mnxt; }
        }
#undef P3_GET
    }
        if (BOTH(3)) xcd_barrier(bar);
    }
    for (int rep_ = 0; rep_ < ((DUP_PHASE == 4) ? 2 : 1); ++rep_) if (IN(4)) {
        if (rep_) xcd_barrier(bar);
    {
        pg8::Gemm g{ATT_SWA, WPS, ATT_SB, WPB, M, D, 2048}; pg8::PairOrder S; S.S.init(M, D, F.G, (int)blockIdx.x);
        pg8::EpiMix E{{}, BA, (const unsigned char*)GT};
        pg8::gemm_phase<pg8::EpiMix, pg8::PairOrder, true, true>(F.lds + RING_OFF, g, S, E);
    }
        if (BOTH(4)) xcd_barrier(bar);
    }
    for (int rep_ = 0; rep_ < ((DUP_PHASE == 5) ? 2 : 1); ++rep_) if (IN(5)) {
        if (rep_) xcd_barrier(bar);
    {
        pg8::Gemm g{BA, WO, BA, WO, M, D, D}; pg8::StaticOrder S; S.init(M, D, F.G, (int)blockIdx.x);
        pg8::EpiSimple<0> E{BB, D};
        pg8::gemm_phase<pg8::EpiSimple<0>, pg8::StaticOrder, true, true>(F.lds + RING_OFF, g, S, E);
    }
        if (BOTH(5)) xcd_barrier(bar);
    }
    for (int rep_ = 0; rep_ < ((DUP_PHASE == 6) ? 2 : 1); ++rep_) if (IN(6)) {
        if (rep_) xcd_barrier(bar);
    p6_rows(F, args, mod, BB, (unsigned char*)BA, S2);
        if (BOTH(6)) xcd_barrier(bar);
    }
#ifndef IDLE_US
#define IDLE_US 0
#endif
    if (IDLE_US > 0 && IN(7)) { const unsigned long long t0_ = __builtin_amdgcn_s_memrealtime(); while (__builtin_amdgcn_s_memrealtime() - t0_ < (unsigned long long)IDLE_US * 100ull) __builtin_amdgcn_s_sleep(127); }
    for (int rep_ = 0; rep_ < ((DUP_PHASE == 7) ? 2 : 1); ++rep_) if (IN(7)) {
        if (rep_) xcd_barrier(bar);
    {
        pg8::Gemm g{BA, (const bf16*)W8F, BA, (const bf16*)W8F, M, FF, D / 2}; pg8::StaticOrder S; S.init(M, FF, F.G, (int)blockIdx.x);
        pg8::EpiRelu2I8 E{UB, FF, S2, SF};
        pg8::gemm_phase<pg8::EpiRelu2I8, pg8::StaticOrder, true, true, true>(F.lds + RING_OFF, g, S, E);
    }
        if (BOTH(7)) xcd_barrier(bar);
    }
    for (int rep_ = 0; rep_ < ((DUP_PHASE == 8) ? 2 : 1); ++rep_) if (IN(8)) {
        if (rep_) xcd_barrier(bar);
    {
        requant_u(F, UB, U8, SU);
        xcd_barrier(bar);
        pg8::Gemm g{(const bf16*)U8, (const bf16*)W8O, (const bf16*)U8, (const bf16*)W8O, M, D, FF / 2}; pg8::StaticOrder S; S.init(M, D, F.G, (int)blockIdx.x, P8_WGM);
        pg8::EpiFfOutI8 E{BB, D, SU, SO, CO};
        pg8::gemm_phase<pg8::EpiFfOutI8, pg8::StaticOrder, true, true, true>(F.lds + RING_OFF, g, S, E);
    }
        if (BOTH(8)) xcd_barrier(bar);
    }
    for (int rep_ = 0; rep_ < ((DUP_PHASE == 9) ? 2 : 1); ++rep_) if (IN(9)) {
        if (rep_) xcd_barrier(bar);
    p9_rows(F, args, mod, BB);
        if (BOTH(9)) xcd_barrier(bar);
    }
#undef IN
#undef BOTH
}

extern "C" void kernel_launch(void* const* d_in, const int* in_sizes, int n_in, void* d_out, int out_size, void* d_ws, size_t ws_size, hipStream_t stream) {
    static int grid = 0;
    if (grid == 0) {
        if (n_in != 17 || in_sizes[0] != M * D || out_size != M * D || ws_size < WS_END) { fprintf(stderr, "kernel_launch: unexpected shapes / workspace (n_in %d, in0 %d, out %d, ws %zu, need %zu); nothing launched\n", n_in, n_in > 0 ? in_sizes[0] : -1, out_size, ws_size, (size_t)WS_END); grid = -1; return; }
        int dev = 0, cus = 0, per_cu = 0;
        if (hipGetDevice(&dev) != hipSuccess || hipDeviceGetAttribute(&cus, hipDeviceAttributeMultiprocessorCount, dev) != hipSuccess) { fprintf(stderr, "kernel_launch: device query failed\n"); grid = -1; return; }
        if (hipFuncSetAttribute((const void*)fwd_kernel, hipFuncAttributeMaxDynamicSharedMemorySize, LDS_BYTES) != hipSuccess) { fprintf(stderr, "kernel_launch: hipFuncSetAttribute failed\n"); grid = -1; return; }
        if (hipOccupancyMaxActiveBlocksPerMultiprocessor(&per_cu, (const void*)fwd_kernel, NWAVES * 64, LDS_BYTES) != hipSuccess || per_cu < 1) { fprintf(stderr, "kernel_launch: occupancy query says %d blocks per CU\n", per_cu); }
        (void)hipGetLastError();
        grid = cus & ~7;
    }
    if (grid < 0) return;
    if (hipMemsetAsync((char*)d_ws + WS_CTL, 0, CTL_ZERO_BYTES, stream) != hipSuccess) { fprintf(stderr, "kernel_launch: memset failed\n"); return; }
    Args a{};
    a.x = (const float*)d_in[0]; a.c = (const float*)d_in[1]; a.w_ada = (const float*)d_in[2]; a.b_ada = (const float*)d_in[3]; a.g_pre_mix = (const float*)d_in[4]; a.g_post_mix = (const float*)d_in[5];
    a.g_pre_mlp = (const float*)d_in[6]; a.g_post_mlp = (const float*)d_in[7]; a.w_in = (const float*)d_in[8]; a.sinks = (const float*)d_in[9]; a.w_bg = (const float*)d_in[10]; a.b_bg = (const float*)d_in[11];
    a.w_ps = (const float*)d_in[12]; a.w_pb = (const float*)d_in[13]; a.w_out = (const float*)d_in[14]; a.w_f1 = (const float*)d_in[15]; a.w_f2 = (const float*)d_in[16];
    a.out = (float*)d_out; a.ws = (unsigned char*)d_ws;
#ifndef MK_N_LAUNCHES
#define MK_N_LAUNCHES 1
#ifndef DUP_PHASE
#define DUP_PHASE -1
#endif
#endif
    constexpr int NPH = 10;
    for (int li = 0; li < MK_N_LAUNCHES; ++li) {
        a.ph_lo = (MK_N_LAUNCHES == 1) ? 0 : li; a.ph_hi = (MK_N_LAUNCHES == 1) ? NPH : li + 1;
        hipLaunchKernelGGL(fwd_kernel, dim3(grid), dim3(NWAVES * 64), LDS_BYTES, stream, a);
        const hipError_t le = hipPeekAtLastError();
        if (le != hipSuccess) { fprintf(stderr, "kernel_launch: launch failed: %s\n", hipGetErrorName(le)); break; }
    }
}
```

```cpp
#include <hip/hip_runtime.h>
#include <cstdio>
#include <cstdint>
#define MK_N_LAUNCHES 1
#ifndef DUP_PHASE
#define DUP_PHASE -1
#endif
#ifndef DUP_SUB
#define DUP_SUB 0
#endif

namespace pg8 {
#define PG8_LAS __attribute__((address_space(3)))
typedef unsigned short bf16_t;
typedef short bf16x8 __attribute__((ext_vector_type(8)));
typedef float f32x4 __attribute__((ext_vector_type(4)));
typedef unsigned u32x4 __attribute__((ext_vector_type(4)));
typedef int v4i_t __attribute__((ext_vector_type(4)));
typedef unsigned u32x2 __attribute__((ext_vector_type(2)));
constexpr int BM = 256, BK = 64, HALF = 128, HTB = HALF * BK * 2  , STAGE_BYTES = 8 * HTB, NXCD = 8, WGM = 8;

__host__ __device__ __forceinline__ int lds_byte(int r, int c) { const int st = (r >> 4) * 2 + (c >> 5), rr = r & 15, cc = c & 31, ob = rr * 64 + cc * 2; return st * 1024 + (ob ^ (((ob >> 9) & 1) << 5)); }
__host__ __device__ __forceinline__ void stage_rc(int b, int& R, int& C) { const int st = b / 1024, sb = b % 1024, swz = sb ^ (((sb >> 9) & 1) << 5); R = (st >> 1) * 16 + swz / 64; C = (st & 1) * 32 + (swz % 64) / 2; }
__host__ __device__ __forceinline__ int perm32(int rho) { const int n = rho >> 4, i = rho & 15; return 8 * (i >> 2) + 4 * n + (i & 3); }

struct Unit { int pm, pn, kind; };
struct Gemm { const bf16_t* A0; const bf16_t* B0; const bf16_t* A1; const bf16_t* B1; int M, N, K; };

struct StaticOrder {
    int nM, nN, nwg, G, c, wgm;
    __host__ __device__ void init(int M, int N, int G_, int c_, int wgm_ = WGM) { nM = M / BM; nN = N / BM; nwg = nM * nN; G = G_; c = c_; wgm = wgm_; }
    __host__ __device__ bool next(int i, Unit& u) const {
        const long L = (long)i * G + c; if (L >= nwg) return false;
        int wgid = (int)L; { const int q = nwg / NXCD, r = nwg % NXCD, xcd = wgid % NXCD, off = wgid / NXCD; wgid = (xcd < r ? xcd * (q + 1) : r * (q + 1) + (xcd - r) * q) + off; }
        const int nig = wgm * nN, gid = wgid / nig, fm = gid * wgm, gsz = (nM - fm) < wgm ? (nM - fm) : wgm;
        u.pm = fm + ((wgid % nig) % gsz); u.pn = (wgid % nig) / gsz; u.kind = 0; return true;
    }
    __device__ __forceinline__ void a_ready(const Unit&) const {}
    __device__ __forceinline__ void done(const Unit&) const {}
};
struct PairOrder {
    StaticOrder S;
    __host__ __device__ bool next(int i, Unit& u) const { if (!S.next(i >> 1, u)) return false; u.kind = i & 1; return true; }
    __device__ __forceinline__ void a_ready(const Unit&) const {}
    __device__ __forceinline__ void done(const Unit&) const {}
};

typedef float f32x2_t __attribute__((ext_vector_type(2))); typedef __bf16 bf16x2_t __attribute__((ext_vector_type(2)));
__device__ __forceinline__ unsigned cvt_pk_bf16(float lo, float hi) { f32x2_t v = {lo, hi}; bf16x2_t b = __builtin_convertvector(v, bf16x2_t); return __builtin_bit_cast(unsigned, b); }
__device__ __forceinline__ f32x4 bf_lo4(unsigned a, unsigned b) { return (f32x4){__uint_as_float(a << 16), __uint_as_float(a & 0xffff0000u), __uint_as_float(b << 16), __uint_as_float(b & 0xffff0000u)}; }
__device__ __forceinline__ u32x4 pack8(f32x4 v0, f32x4 v1) { u32x4 w; w.x = cvt_pk_bf16(v0[0], v0[1]); w.y = cvt_pk_bf16(v0[2], v0[3]); w.z = cvt_pk_bf16(v1[0], v1[1]); w.w = cvt_pk_bf16(v1[2], v1[3]); return w; }

template <int ACT  , bool NT = false> struct EpiSimple {
    static constexpr bool PERM = true, AFTER_DRAIN = false, CHAIN = false;
    __device__ __forceinline__ bool keep_acc(const Unit&) const { return false; }
    bf16_t* O; int ldc;
    __device__ __forceinline__ void operator()(const f32x4 (&acc)[2][2][4][2], const Unit& u, int wr, int wc, int fr, int fq) const {
        const int row0 = u.pm * BM + wr * 64 + fr, col0 = u.pn * BM + wc * 32 + 8 * fq;
#pragma unroll
        for (int ai = 0; ai < 2; ++ai)
#pragma unroll
            for (int m = 0; m < 4; ++m) { bf16_t* rowp = O + (size_t)(row0 + ai * HALF + m * 16) * ldc + col0;
#pragma unroll
                for (int bj = 0; bj < 2; ++bj) { f32x4 v0 = acc[ai][bj][m][0], v1 = acc[ai][bj][m][1];
                    if (ACT == 1) {
#pragma unroll
                        for (int j = 0; j < 4; ++j) { const float a = fmaxf(v0[j], 0.f), b = fmaxf(v1[j], 0.f); v0[j] = a * a; v1[j] = b * b; } }
                    if (NT) __builtin_nontemporal_store(pack8(v0, v1), (u32x4*)(rowp + bj * HALF)); else *(u32x4*)(rowp + bj * HALF) = pack8(v0, v1); } }
    }
};

struct EpiProj {
    static constexpr bool PERM = true, AFTER_DRAIN = false, CHAIN = false;
    __device__ __forceinline__ bool keep_acc(const Unit&) const { return false; }
    bf16_t *KA, *VA, *VB; const float* cosT; const float* sinT;
    __device__ __forceinline__ void operator()(const f32x4 (&acc)[2][2][4][2], const Unit& u, int wr, int wc, int fr, int fq) const {
        const int pn = u.pn, row0 = u.pm * BM + wr * 64 + fr, cl = wc * 32 + 8 * fq;
        bf16_t* base; int ld, colt; bool rope = false;
        if (pn < 2)       { base = KA; ld = 512;  colt = pn * 256; rope = true; }
        else if (pn < 4)  { base = VA; ld = 512;  colt = (pn - 2) * 256; }
        else              { base = VB; ld = 2048; colt = (pn - 4) * 256; }
        if (rope) {
#pragma unroll
            for (int ai = 0; ai < 2; ++ai)
#pragma unroll
                for (int m = 0; m < 4; ++m) { const int row = row0 + ai * HALF + m * 16; const int pos = row & 4095;
                    const f32x4 c4 = *(const f32x4*)(cosT + pos * 64 + (cl >> 1)), s4 = *(const f32x4*)(sinT + pos * 64 + (cl >> 1));
                    bf16_t* rowp = base + (size_t)row * ld + colt + cl;
#pragma unroll
                    for (int bj = 0; bj < 2; ++bj) { const f32x4 x1 = acc[ai][bj][m][0], x2 = acc[ai][bj][m][1];
                        *(u32x4*)(rowp + bj * HALF) = pack8(x1 * c4 - x2 * s4, x2 * c4 + x1 * s4); } }
        } else {
#pragma unroll
            for (int ai = 0; ai < 2; ++ai)
#pragma unroll
                for (int m = 0; m < 4; ++m) { bf16_t* rowp = base + (size_t)(row0 + ai * HALF + m * 16) * ld + colt + cl;
#pragma unroll
                    for (int bj = 0; bj < 2; ++bj) *(u32x4*)(rowp + bj * HALF) = pack8(acc[ai][bj][m][0], acc[ai][bj][m][1]); }
        }
    }
};

__device__ __forceinline__ f32x4 i2f4(f32x4 a) { const v4i_t i = __builtin_bit_cast(v4i_t, a); return (f32x4){(float)i[0], (float)i[1], (float)i[2], (float)i[3]}; }
struct EpiI8Proj {
    static constexpr bool PERM = true, AFTER_DRAIN = false, CHAIN = false;
    __device__ __forceinline__ bool keep_acc(const Unit&) const { return false; }
    bf16_t *QA, *QB, *KB, *GT; const float* cosT; const float* sinT; const float* gbias; const float* sa; const float* sb; float qscale;
    __device__ __forceinline__ void operator()(const f32x4 (&acc)[2][2][4][2], const Unit& u, int wr, int wc, int fr, int fq) const {
        const int pn = u.pn, row0 = u.pm * BM + wr * 64 + fr, cl = wc * 32 + 8 * fq;
        f32x4 sv[2][2];
#pragma unroll
        for (int bj = 0; bj < 2; ++bj)
#pragma unroll
            for (int n = 0; n < 2; ++n) sv[bj][n] = *(const f32x4*)(sb + pn * 256 + bj * HALF + cl + 4 * n);
        if (pn < 8) {
            const int colt = pn * 256;
#pragma unroll
            for (int ai = 0; ai < 2; ++ai)
#pragma unroll
                for (int m = 0; m < 4; ++m) { const int row = row0 + ai * HALF + m * 16; const int pos = row & 4095; const float sr = sa[row] * qscale;
                    const f32x4 c4 = *(const f32x4*)(cosT + pos * 64 + (cl >> 1)), s4 = *(const f32x4*)(sinT + pos * 64 + (cl >> 1));
                    bf16_t* rowp = QA + (size_t)row * 2048 + colt + cl;
#pragma unroll
                    for (int bj = 0; bj < 2; ++bj) { const f32x4 x1 = i2f4(acc[ai][bj][m][0]) * (sv[bj][0] * sr), x2 = i2f4(acc[ai][bj][m][1]) * (sv[bj][1] * sr);
                        *(u32x4*)(rowp + bj * HALF) = pack8(x1 * c4 - x2 * s4, x2 * c4 + x1 * s4); } }
        } else if (pn < 24) {
            const bool isq = pn < 16; const int colt = (isq ? pn - 8 : pn - 16) * 256; bf16_t* basep = isq ? QB : KB; const float qs = isq ? qscale : 1.f;
#pragma unroll
            for (int ai = 0; ai < 2; ++ai)
#pragma unroll
                for (int m = 0; m < 4; ++m) { const int row = row0 + ai * HALF + m * 16; const float sr = sa[row] * qs; bf16_t* rowp = basep + (size_t)row * 2048 + colt + cl;
#pragma unroll
                    for (int bj = 0; bj < 2; ++bj) *(u32x4*)(rowp + bj * HALF) = pack8(i2f4(acc[ai][bj][m][0]) * (sv[bj][0] * sr), i2f4(acc[ai][bj][m][1]) * (sv[bj][1] * sr)); }
        } else {
            const int colt = (pn - 24) * 256;
            f32x4 bv[2][2];
#pragma unroll
            for (int bj = 0; bj < 2; ++bj)
#pragma unroll
                for (int n = 0; n < 2; ++n) { bv[bj][n] = *(const f32x4*)(gbias + colt + bj * HALF + cl + 4 * n) * -1.44269504089f; sv[bj][n] = sv[bj][n] * -1.44269504089f; }
            unsigned char* tp = (unsigned char*)GT + ((size_t)(u.pm * 32 + (pn - 24)) << 16) + (wr * 4 + wc) * 8192 + (fr + 16 * fq) * 16;
#pragma unroll
            for (int ai = 0; ai < 2; ++ai)
#pragma unroll
                for (int m = 0; m < 4; ++m) { const int row = row0 + ai * HALF + m * 16; const float sr = sa[row]; u32x4 w4;
#pragma unroll
                    for (int bj = 0; bj < 2; ++bj) { f32x4 v0 = i2f4(acc[ai][bj][m][0]) * (sv[bj][0] * sr) + bv[bj][0], v1 = i2f4(acc[ai][bj][m][1]) * (sv[bj][1] * sr) + bv[bj][1];
#pragma unroll
                        for (int j = 0; j < 4; ++j) { v0[j] = __builtin_rintf(255.f * __builtin_amdgcn_rcpf(1.f + __builtin_amdgcn_exp2f(v0[j]))); v1[j] = __builtin_rintf(255.f * __builtin_amdgcn_rcpf(1.f + __builtin_amdgcn_exp2f(v1[j]))); }
                        const unsigned wx = (unsigned)v0[0] | ((unsigned)v0[1] << 8) | ((unsigned)v0[2] << 16) | ((unsigned)v0[3] << 24), wy = (unsigned)v1[0] | ((unsigned)v1[1] << 8) | ((unsigned)v1[2] << 16) | ((unsigned)v1[3] << 24);
                        if (bj == 0) { w4.x = wx; w4.y = wy; } else { w4.z = wx; w4.w = wy; } }
                    *(u32x4*)(tp + (ai * 4 + m) * 1024) = w4; }
        }
    }
};
struct EpiFfOutI8 {
    static constexpr bool PERM = true, AFTER_DRAIN = false, CHAIN = false;
    __device__ __forceinline__ bool keep_acc(const Unit&) const { return false; }
    bf16_t* O; int ldc; const float* sa; const float* sb; const int* cs;
    __device__ __forceinline__ void operator()(const f32x4 (&acc)[2][2][4][2], const Unit& u, int wr, int wc, int fr, int fq) const {
        const int row0 = u.pm * BM + wr * 64 + fr, col0 = u.pn * BM + wc * 32 + 8 * fq;
        f32x4 sv[2][2]; v4i_t cv[2][2];
#pragma unroll
        for (int bj = 0; bj < 2; ++bj)
#pragma unroll
            for (int n = 0; n < 2; ++n) { sv[bj][n] = *(const f32x4*)(sb + col0 + bj * HALF + 4 * n); cv[bj][n] = *(const v4i_t*)(cs + col0 + bj * HALF + 4 * n) * 128; }
#pragma unroll
        for (int ai = 0; ai < 2; ++ai)
#pragma unroll
            for (int m = 0; m < 4; ++m) { const int row = row0 + ai * HALF + m * 16; const float sr = sa[row]; bf16_t* rowp = O + (size_t)row * ldc + col0;
#pragma unroll
                for (int bj = 0; bj < 2; ++bj) { const v4i_t i0 = __builtin_bit_cast(v4i_t, acc[ai][bj][m][0]) + cv[bj][0], i1 = __builtin_bit_cast(v4i_t, acc[ai][bj][m][1]) + cv[bj][1];
                    *(u32x4*)(rowp + bj * HALF) = pack8((f32x4){(float)i0[0], (float)i0[1], (float)i0[2], (float)i0[3]} * (sv[bj][0] * sr), (f32x4){(float)i1[0], (float)i1[1], (float)i1[2], (float)i1[3]} * (sv[bj][1] * sr)); } }
    }
};
struct EpiRelu2I8 {
    static constexpr bool PERM = true, AFTER_DRAIN = false, CHAIN = false;
    __device__ __forceinline__ bool keep_acc(const Unit&) const { return false; }
    bf16_t* O; int ldc; const float* sa; const float* sb;
    __device__ __forceinline__ void operator()(const f32x4 (&acc)[2][2][4][2], const Unit& u, int wr, int wc, int fr, int fq) const {
        const int row0 = u.pm * BM + wr * 64 + fr, col0 = u.pn * BM + wc * 32 + 8 * fq;
        f32x4 sv[2][2];
#pragma unroll
        for (int bj = 0; bj < 2; ++bj)
#pragma unroll
            for (int n = 0; n < 2; ++n) sv[bj][n] = *(const f32x4*)(sb + col0 + bj * HALF + 4 * n);
#pragma unroll
        for (int ai = 0; ai < 2; ++ai)
#pragma unroll
            for (int m = 0; m < 4; ++m) { const int row = row0 + ai * HALF + m * 16; const float sr = sa[row]; bf16_t* rowp = O + (size_t)row * ldc + col0;
#pragma unroll
                for (int bj = 0; bj < 2; ++bj) { f32x4 v0 = i2f4(acc[ai][bj][m][0]) * (sv[bj][0] * sr), v1 = i2f4(acc[ai][bj][m][1]) * (sv[bj][1] * sr);
#pragma unroll
                    for (int j = 0; j < 4; ++j) { const float p = fmaxf(v0[j], 0.f), q = fmaxf(v1[j], 0.f); v0[j] = p * p; v1[j] = q * q; }
                    *(u32x4*)(rowp + bj * HALF) = pack8(v0, v1); } }
    }
};

struct EpiMix {
    static constexpr bool PERM = true, AFTER_DRAIN = false, CHAIN = true;
    mutable u32x4 gbk[7];
    mutable int npm, npn, nok, pf;
    __device__ __forceinline__ void note_next(const Unit& n, bool has) const { npm = n.pm; npn = n.pn; nok = has ? 1 : 0; }
    bf16_t* O; const unsigned char* G;
    static __device__ __forceinline__ f32x4 ub4(unsigned w) { return (f32x4){(float)(w & 255u), (float)((w >> 8) & 255u), (float)((w >> 16) & 255u), (float)(w >> 24)}; }
    __device__ __forceinline__ void operator()(f32x4 (&acc)[2][2][4][2], const Unit& u, int wr, int wc, int fr, int fq) const {
        const int row0 = u.pm * BM + wr * 64 + fr, col0 = u.pn * BM + wc * 32 + 8 * fq; const int kind = u.kind;
        const unsigned char* ta = G + ((size_t)(u.pm * 32 + u.pn) << 16) + (wr * 4 + wc) * 8192 + (fr + 16 * fq) * 16;
        const unsigned char* tb = ta + ((size_t)16 << 16);
        if (kind == 0) {
            if (!pf) {
#pragma unroll
                for (int i = 0; i < 7; ++i) gbk[i] = *(const u32x4*)(tb + i * 1024); }
#pragma unroll
            for (int ai = 0; ai < 2; ++ai)
#pragma unroll
                for (int m = 0; m < 4; ++m) { const u32x4 ga4 = *(const u32x4*)(ta + (ai * 4 + m) * 1024), gb4 = (ai * 4 + m < 7) ? gbk[(ai * 4 + m) % 7] : *(const u32x4*)(tb + (ai * 4 + m) * 1024);
#pragma unroll
                    for (int bj = 0; bj < 2; ++bj) { const unsigned gax = bj ? ga4.z : ga4.x, gay = bj ? ga4.w : ga4.y, gbx = bj ? gb4.z : gb4.x, gby = bj ? gb4.w : gb4.y;
                        f32x4 b0 = ub4(gbx), b1 = ub4(gby);
#pragma unroll
                        for (int j = 0; j < 4; ++j) { b0[j] = __builtin_amdgcn_rcpf(fmaxf(b0[j], 2.3191e-10f)); b1[j] = __builtin_amdgcn_rcpf(fmaxf(b1[j], 2.3191e-10f)); }
                        acc[ai][bj][m][0] *= ub4(gax) * b0; acc[ai][bj][m][1] *= ub4(gay) * b1; } }
        } else {
            u32x4 nx[7];
            const unsigned char* nb = G + ((size_t)(npm * 32 + npn + 16) << 16) + (wr * 4 + wc) * 8192 + (fr + 16 * fq) * 16;
            if (nok) {
#pragma unroll
                for (int i = 0; i < 7; ++i) nx[i] = *(const u32x4*)(nb + i * 1024); }
#pragma unroll
            for (int ai = 0; ai < 2; ++ai)
#pragma unroll
                for (int m = 0; m < 4; ++m) { const size_t row = (size_t)(row0 + ai * HALF + m * 16); const u32x4 gb4 = (ai * 4 + m < 7) ? gbk[(ai * 4 + m) % 7] : *(const u32x4*)(tb + (ai * 4 + m) * 1024);
#pragma unroll
                    for (int bj = 0; bj < 2; ++bj) { const int col = col0 + bj * HALF; const unsigned gbx = bj ? gb4.z : gb4.x, gby = bj ? gb4.w : gb4.y;
                        f32x4 b0 = ub4(gbx), b1 = ub4(gby);
#pragma unroll
                        for (int j = 0; j < 4; ++j) { b0[j] = fmaxf(b0[j], 2.3191e-10f) * (1.f / 255.f); b1[j] = fmaxf(b1[j], 2.3191e-10f) * (1.f / 255.f); }
                        *(u32x4*)(O + row * 4096 + col) = pack8(acc[ai][bj][m][0] * b0, acc[ai][bj][m][1] * b1); } }
            if (nok) {
#pragma unroll
                for (int i = 0; i < 7; ++i) gbk[i] = nx[i]; }
            pf = nok;
        }
    }
    __device__ __forceinline__ bool keep_acc(const Unit& u) const { return u.kind == 0; }
};

template <class Epi, class Sched, bool ALIGN_EPI = false, bool SP2 = false, bool I8 = false>
__device__ __forceinline__ void gemm_phase(PG8_LAS unsigned char* lds, const Gemm g, const Sched& S, const Epi& E) {
    int tid_ = threadIdx.x; asm volatile("" : "+v"(tid_));
    const int tid = tid_, wid = __builtin_amdgcn_readfirstlane(tid >> 6), lane = tid & 63, wr = wid >> 2, wc = wid & 3, fr = lane & 15, fq = lane >> 4;
    const int K = g.K, nt = K / BK;
    unsigned voffA[2], voffB[2];
#pragma unroll
    for (int i = 0; i < 2; ++i) { int R, C; stage_rc(tid * 16 + i * 8192, R, C); const int Rb = Epi::PERM ? ((R & ~31) + perm32(R & 31)) : R;
        voffA[i] = (unsigned)(R * K + C) * 2u; voffB[i] = (unsigned)(Rb * K + C) * 2u; }
    const size_t kstep = (size_t)(BK * 2);
    const size_t hstep = (size_t)HALF * K * 2;
    const size_t tstep = 2 * hstep;
    const unsigned ldsw = (unsigned)wid * 1024u;
    const int aoff = lds_byte(wr * 64 + fr, fq * 8), boff = lds_byte(wc * 32 + fr, fq * 8);
#define PG8_SA(b, h) (((b) * 2 + (h)) * HTB)
#define PG8_SB(b, h) ((4 + (b) * 2 + (h)) * HTB)
#define PG8_STAGE(bufoff, gbase, voff) do { _Pragma("unroll") for (int _i = 0; _i < 2; ++_i) \
        __builtin_amdgcn_global_load_lds((const unsigned*)((const char*)(gbase) + (voff)[_i]), (PG8_LAS unsigned*)(lds + (bufoff) + ldsw + _i * 8192), 16, 0, 0); } while (0)
#define PG8_LDA(dst, b, h) do { _Pragma("unroll") for (int m = 0; m < 4; ++m) _Pragma("unroll") for (int k = 0; k < 2; ++k) dst[m][k] = *(const PG8_LAS bf16x8*)(lds + PG8_SA(b, h) + aoff + m * 2048 + k * 1024); } while (0)
#define PG8_LDB(dst, b, h) do { _Pragma("unroll") for (int n = 0; n < 2; ++n) _Pragma("unroll") for (int k = 0; k < 2; ++k) dst[n][k] = *(const PG8_LAS bf16x8*)(lds + PG8_SB(b, h) + boff + n * 2048 + k * 1024); } while (0)
#define PG8_MMA(ai, bj, At, Bt) do { __builtin_amdgcn_s_setprio(1); _Pragma("unroll") for (int m = 0; m < 4; ++m) _Pragma("unroll") for (int n = 0; n < 2; ++n) _Pragma("unroll") for (int k = 0; k < 2; ++k) { \
        if constexpr (I8) acc[ai][bj][m][n] = __builtin_bit_cast(f32x4, __builtin_amdgcn_mfma_i32_16x16x64_i8(__builtin_bit_cast(v4i_t, Bt[n][k]), __builtin_bit_cast(v4i_t, At[m][k]), __builtin_bit_cast(v4i_t, acc[ai][bj][m][n]), 0, 0, 0)); \
        else acc[ai][bj][m][n] = __builtin_amdgcn_mfma_f32_16x16x32_bf16(Bt[n][k], At[m][k], acc[ai][bj][m][n], 0, 0, 0); } __builtin_amdgcn_s_setprio(0); } while (0)
#define PG8_WAIT_V(n) asm volatile("s_waitcnt vmcnt(" #n ")" ::: "memory")
#define PG8_WAIT_L(n) asm volatile("s_waitcnt lgkmcnt(" #n ")" ::: "memory")
#define PG8_BAR __builtin_amdgcn_s_barrier()
#define PG8_SCHED __builtin_amdgcn_sched_barrier(0)
    Unit cur, nxt; int ui = 0;
    if (!S.next(0, cur)) return;
    f32x4 acc[2][2][4][2];
#pragma unroll
    for (int a = 0; a < 2; ++a)
#pragma unroll
        for (int b = 0; b < 2; ++b)
#pragma unroll
            for (int m = 0; m < 4; ++m)
#pragma unroll
                for (int n = 0; n < 2; ++n) acc[a][b][m][n] = (f32x4){0.f, 0.f, 0.f, 0.f};
    bf16x8 At[4][2], B0[2][2], B1[2][2];
    const char* cA = (const char*)(cur.kind ? g.A1 : g.A0) + (size_t)cur.pm * tstep; const char* cB = (const char*)(cur.kind ? g.B1 : g.B0) + (size_t)cur.pn * tstep;
    S.a_ready(cur);
    if constexpr (SP2) {
        PG8_STAGE(PG8_SB(0, 0), cB, voffB); PG8_STAGE(PG8_SB(0, 1), cB + hstep, voffB); PG8_STAGE(PG8_SA(0, 0), cA, voffA); PG8_STAGE(PG8_SA(0, 1), cA + hstep, voffA);
        if (wr == 1) PG8_BAR;
        PG8_WAIT_V(2); PG8_BAR;
        PG8_STAGE(PG8_SB(1, 0), cB + kstep, voffB); PG8_STAGE(PG8_SA(1, 0), cA + kstep, voffA); PG8_STAGE(PG8_SB(1, 1), cB + hstep + kstep, voffB);
        PG8_WAIT_V(6); PG8_BAR;
    } else {
        PG8_STAGE(PG8_SB(0, 0), cB, voffB); PG8_STAGE(PG8_SA(0, 0), cA, voffA); PG8_STAGE(PG8_SB(0, 1), cB + hstep, voffB); PG8_STAGE(PG8_SA(0, 1), cA + hstep, voffA);
        if (wr == 1) PG8_BAR;
        PG8_WAIT_V(4); PG8_BAR;
        PG8_STAGE(PG8_SB(1, 0), cB + kstep, voffB); PG8_STAGE(PG8_SA(1, 0), cA + kstep, voffA); PG8_STAGE(PG8_SB(1, 1), cB + hstep + kstep, voffB);
        PG8_WAIT_V(6); PG8_BAR;
    }
    for (;;) {
        const bool has_next = S.next(ui + 1, nxt);
        const char* nA = has_next ? (const char*)(nxt.kind ? g.A1 : g.A0) + (size_t)nxt.pm * tstep : cA; const char* nB = has_next ? (const char*)(nxt.kind ? g.B1 : g.B0) + (size_t)nxt.pn * tstep : cB;
        for (int t = 0; t < nt; t += 2) {
            const bool last = (t == nt - 2);
            const char* a1 = cA + (size_t)(t + 1) * kstep;
            const char* a2 = last ? nA : cA + (size_t)(t + 2) * kstep; const char* b2 = last ? nB : cB + (size_t)(t + 2) * kstep;
            const char* a3 = a2 + kstep; const char* b3 = b2 + kstep;
            if (last && has_next) S.a_ready(nxt);
            if constexpr (SP2) {
            PG8_LDB(B0, 0, 0); PG8_LDB(B1, 0, 1); PG8_SCHED; PG8_LDA(At, 0, 0); PG8_STAGE(PG8_SA(1, 1), a1 + hstep, voffA);
            PG8_WAIT_V(8); PG8_WAIT_L(0); PG8_BAR; PG8_MMA(0, 0, At, B0); PG8_MMA(0, 1, At, B1); PG8_BAR; PG8_SCHED;
            PG8_LDA(At, 0, 1); PG8_STAGE(PG8_SB(0, 0), b2, voffB); PG8_STAGE(PG8_SB(0, 1), b2 + hstep, voffB); PG8_STAGE(PG8_SA(0, 0), a2, voffA);
            PG8_WAIT_V(8); PG8_WAIT_L(0); PG8_BAR; PG8_MMA(1, 0, At, B0); PG8_MMA(1, 1, At, B1); PG8_BAR; PG8_SCHED;
            PG8_LDB(B0, 1, 0); PG8_LDB(B1, 1, 1); PG8_SCHED; PG8_LDA(At, 1, 0); PG8_STAGE(PG8_SA(0, 1), a2 + hstep, voffA);
            PG8_WAIT_V(8); PG8_WAIT_L(0); PG8_BAR; PG8_MMA(0, 0, At, B0); PG8_MMA(0, 1, At, B1); PG8_BAR; PG8_SCHED;
            PG8_LDA(At, 1, 1); PG8_STAGE(PG8_SB(1, 0), b3, voffB); PG8_STAGE(PG8_SB(1, 1), b3 + hstep, voffB); PG8_STAGE(PG8_SA(1, 0), a3, voffA);
            PG8_WAIT_V(8); PG8_WAIT_L(0); PG8_BAR; PG8_MMA(1, 0, At, B0); PG8_MMA(1, 1, At, B1); PG8_BAR; PG8_SCHED;
            } else {
            PG8_LDB(B0, 0, 0); PG8_SCHED; PG8_LDA(At, 0, 0); PG8_STAGE(PG8_SA(1, 1), a1 + hstep, voffA);
            PG8_WAIT_L(8); PG8_BAR; PG8_WAIT_L(0); PG8_MMA(0, 0, At, B0); PG8_BAR; PG8_SCHED;
            PG8_LDB(B1, 0, 1); PG8_STAGE(PG8_SB(0, 0), b2, voffB);
            PG8_BAR; PG8_WAIT_L(0); PG8_MMA(0, 1, At, B1); PG8_BAR;
            PG8_LDA(At, 0, 1); PG8_STAGE(PG8_SA(0, 0), a2, voffA);
            PG8_BAR; PG8_WAIT_L(0); PG8_MMA(1, 0, At, B0); PG8_BAR; PG8_SCHED;
            PG8_STAGE(PG8_SB(0, 1), b2 + hstep, voffB);
            PG8_WAIT_V(6); PG8_BAR; PG8_MMA(1, 1, At, B1); PG8_BAR;
            PG8_LDB(B0, 1, 0); PG8_SCHED; PG8_LDA(At, 1, 0); PG8_STAGE(PG8_SA(0, 1), a2 + hstep, voffA);
            PG8_WAIT_L(8); PG8_BAR; PG8_WAIT_L(0); PG8_MMA(0, 0, At, B0); PG8_BAR; PG8_SCHED;
            PG8_LDB(B1, 1, 1); PG8_STAGE(PG8_SB(1, 0), b3, voffB);
            PG8_BAR; PG8_WAIT_L(0); PG8_MMA(0, 1, At, B1); PG8_BAR;
            PG8_LDA(At, 1, 1); PG8_STAGE(PG8_SA(1, 0), a3, voffA);
            PG8_BAR; PG8_WAIT_L(0); PG8_MMA(1, 0, At, B0); PG8_BAR; PG8_SCHED;
            PG8_STAGE(PG8_SB(1, 1), b3 + hstep, voffB);
            PG8_WAIT_V(6); PG8_BAR; PG8_MMA(1, 1, At, B1); PG8_BAR;
            }
        }
        if constexpr (ALIGN_EPI) { if (wr == 0) PG8_BAR; }
        if constexpr (Epi::CHAIN) E.note_next(nxt, has_next);
        if constexpr (!Epi::AFTER_DRAIN) { E(acc, cur, wr, wc, fr, fq); S.done(cur); }
        if (!has_next) break;
        if (!(Epi::CHAIN && E.keep_acc(cur))) {
#pragma unroll
        for (int a = 0; a < 2; ++a)
#pragma unroll
            for (int b = 0; b < 2; ++b)
#pragma unroll
                for (int m = 0; m < 4; ++m)
#pragma unroll
                    for (int n = 0; n < 2; ++n) acc[a][b][m][n] = (f32x4){0.f, 0.f, 0.f, 0.f};
        }
        cur = nxt; cA = nA; cB = nB; ++ui;
        if constexpr (ALIGN_EPI) { if (wr == 1) PG8_BAR; }
    }
    PG8_WAIT_V(0);
    if constexpr (!ALIGN_EPI) { if (wr == 0) PG8_BAR; }
    PG8_BAR;
#undef PG8_SA
#undef PG8_SB
#undef PG8_STAGE
#undef PG8_LDA
#undef PG8_LDB
#undef PG8_MMA
#undef PG8_WAIT_V
#undef PG8_WAIT_L
#undef PG8_BAR
#undef PG8_SCHED
}
}


namespace att {
#define ATT_LAS __attribute__((address_space(3)))
typedef unsigned short bf16;
typedef short bf16x8 __attribute__((ext_vector_type(8)));
typedef short s16x4 __attribute__((ext_vector_type(4)));
typedef float f32x16 __attribute__((ext_vector_type(16)));
typedef float f32x2_t __attribute__((ext_vector_type(2)));
typedef __bf16 bf16x2_t __attribute__((ext_vector_type(2)));
typedef unsigned u32x4 __attribute__((ext_vector_type(4)));
typedef unsigned u32x2 __attribute__((ext_vector_type(2)));
constexpr int TILE_BYTES = 64 * 256, BUF_BYTES = 2 * TILE_BYTES, FLAG_OFF = 2 * BUF_BYTES, LDS_BYTES = FLAG_OFF + 256;
__device__ __forceinline__ unsigned cvtpk(float lo, float hi) { f32x2_t v = {lo, hi}; bf16x2_t b = __builtin_convertvector(v, bf16x2_t); return __builtin_bit_cast(unsigned, b); }
__device__ __forceinline__ int crow(int i, int h) { return (i & 3) + 8 * (i >> 2) + 4 * h; }
__device__ __forceinline__ unsigned off_b(unsigned row, unsigned ch) { return 256u * row + 16u * (ch ^ (((row & 3) << 2) | ((row >> 2) & 3))); }
__device__ __forceinline__ s16x4 trread(const ATT_LAS unsigned char* p) { return __builtin_bit_cast(s16x4, __builtin_amdgcn_ds_read_tr16_b64_v4i16((ATT_LAS s16x4*)p)); }
#define ATT_MFMA(a, b, c) __builtin_amdgcn_mfma_f32_32x32x16_bf16((a), (b), (c), 0, 0, 0)

struct AUnit { const bf16* Q; const bf16* K; const bf16* V; bf16* O; int pq, pk, po, b, qb; float sink2; int gqa; const float* sk; };
__device__ __forceinline__ void attn_prefetch(const AUnit& u, bf16x8 (&qf)[8], u32x4& kr0, u32x4& kr1, u32x4& vr0, u32x4& vr1, int tid, int wid, int lane) {
    int ln_ = lane, td_ = tid; asm volatile("" : "+v"(ln_), "+v"(td_));
    const int r32 = ln_ & 31, h = ln_ >> 5, tq = (u.gqa ? 64 * u.qb + 32 * (wid & 1) : 256 * u.qb + 32 * wid) + r32; const size_t rowbase = (size_t)u.b * 4096;
    { const char* qb_ = (const char*)(u.Q + rowbase * u.pq + (u.gqa ? (wid >> 1) * 128 : 0)); const unsigned qo = (unsigned)(tq * u.pq + 8 * h) * 2u;
#pragma unroll
      for (int s = 0; s < 8; ++s) qf[s] = *(const bf16x8*)(qb_ + qo + 32 * s); }
    const int lrow = td_ >> 4, lch = td_ & 15; const unsigned kvo = (unsigned)(lrow * u.pk + 8 * lch) * 2u;
    const size_t o = ((size_t)rowbase + (size_t)(64 * (u.gqa ? u.qb : 4 * u.qb + 3))) * u.pk * 2; const char* k = (const char*)u.K + o; const char* v = (const char*)u.V + o;
    kr0 = *(const u32x4*)(k + kvo); kr1 = *(const u32x4*)(k + (size_t)64 * u.pk + kvo); vr0 = *(const u32x4*)(v + kvo); vr1 = *(const u32x4*)(v + (size_t)64 * u.pk + kvo);
}
template <int MODE, bool EARLY>
__device__ __forceinline__ void attn_unit(ATT_LAS unsigned char* lds, const AUnit& U, bool has_next, const AUnit& N, bf16x8 (&qf)[8], u32x4& kr0, u32x4& kr1, u32x4& vr0, u32x4& vr1, int tid, int wid, int lane) {
    const bf16* __restrict__ Kh = U.K; const bf16* __restrict__ Vh = U.V; bf16* __restrict__ Oh = U.O + (MODE == 0 ? (wid >> 1) * 128 : 0); const int pk = U.pk, po = U.po, b = U.b, qb = U.qb;
    const float sink2 = (MODE == 0) ? U.sk[wid >> 1] * 1.44269504089f : 0.f;
    int ln_ = lane, td_ = tid; asm volatile("" : "+v"(ln_), "+v"(td_));
    const int r32 = ln_ & 31, h = ln_ >> 5;
    const int t0 = (MODE == 0) ? 64 * qb + 32 * (wid & 1) : 256 * qb + 32 * wid, tq = t0 + r32;
    const size_t rowbase = (size_t)b * 4096;
    f32x16 oacc[4];
#pragma unroll
    for (int c = 0; c < 4; ++c)
#pragma unroll
        for (int i = 0; i < 16; ++i) oacc[c][i] = 0.f;
    float carry = 0.f, mrun = sink2, lrun = (h == 0) ? 1.f : 0.f;
    const int kt_hi = (MODE == 0) ? qb : 4 * qb + 3, kt_lo = (MODE == 0) ? ((qb - 2) > 0 ? (qb - 2) : 0) : 0;
    const int lrow = td_ >> 4, lch = td_ & 15;
    const unsigned lw = off_b((unsigned)lrow, (unsigned)lch);
    const unsigned kvo = (unsigned)(lrow * pk + 8 * lch) * 2u;
    const char* kgb = (const char*)(Kh + rowbase * pk); const char* vgb = (const char*)(Vh + rowbase * pk);
    const unsigned xk = (unsigned)(((r32 & 3) << 2) | ((r32 >> 2) & 3));
    const int q4 = (ln_ & 15) >> 2, p4 = ln_ & 3, blk = (ln_ >> 4) & 1;
    unsigned vaddr[4][2];
#pragma unroll
    for (int c = 0; c < 4; ++c)
#pragma unroll
        for (int t = 0; t < 2; ++t) { const unsigned row = (unsigned)(8 * t + 4 * h + q4), x = (unsigned)((q4 << 2) | ((2 * t + h) & 3)), ch = (unsigned)(4 * c + 2 * blk + (p4 >> 1));
            vaddr[c][t] = 256u * row + 16u * (ch ^ x) + 8u * (unsigned)(p4 & 1); }
#define ATT_GLOAD(kt) do { const size_t _o = (size_t)(64 * (kt)) * pk * 2; const char* _k = kgb + _o; const char* _v = vgb + _o; kr0 = *(const u32x4*)(_k + kvo); kr1 = *(const u32x4*)(_k + (size_t)64 * pk + kvo); vr0 = *(const u32x4*)(_v + kvo); vr1 = *(const u32x4*)(_v + (size_t)64 * pk + kvo); } while (0)
#define ATT_LSTORE(bf) do { ATT_LAS unsigned char* _b = lds + (bf) * BUF_BYTES + lw; *(ATT_LAS u32x4*)_b = kr0; *(ATT_LAS u32x4*)(_b + 8192) = kr1; *(ATT_LAS u32x4*)(_b + TILE_BYTES) = vr0; *(ATT_LAS u32x4*)(_b + TILE_BYTES + 8192) = vr1; } while (0)
    int buf = 0;
    ATT_LSTORE(0); __syncthreads();
    for (int kt = kt_hi; kt >= kt_lo; --kt) {
        const bool more = kt > kt_lo;
        if (more) ATT_GLOAD(kt - 1);
        const int kbase = 64 * kt;
        bool relevant, masked;
        if (MODE == 1) { relevant = kbase <= t0 + 30; masked = kbase + 63 >= t0; }
        else { relevant = (kbase <= t0 + 31) && (kbase + 63 >= t0 - 127); masked = !((kbase + 63 <= t0) && (kbase >= t0 - 96)); }
        if (relevant) {
            const ATT_LAS unsigned char* Kb = lds + buf * BUF_BYTES; const ATT_LAS unsigned char* Vb = Kb + TILE_BYTES;
            f32x16 sacc[2];
#pragma unroll
            for (int kb = 0; kb < 2; ++kb) {
#pragma unroll
                for (int i = 0; i < 16; ++i) sacc[kb][i] = 0.f;
#pragma unroll
                for (int s = 0; s < 8; ++s) { const bf16x8 kf = *(const ATT_LAS bf16x8*)(Kb + kb * 8192 + 256 * r32 + 16 * (((unsigned)(2 * s + h)) ^ xk)); sacc[kb] = ATT_MFMA(kf, qf[s], sacc[kb]); }
            }
            bf16x8 pf[2][2];
            if (MODE == 1) {
#pragma unroll
                for (int kk = 0; kk < 2; ++kk) { const int kb = 1 - kk; const int sb0 = kbase + 32 * kb;
                    float sp[16], A[16];
#pragma unroll
                    for (int i = 0; i < 16; ++i) { const float z = sacc[kb][i]; const float e = __builtin_amdgcn_exp2f(-__builtin_fabsf(z)); sp[i] = fmaxf(z, 0.f) + __builtin_amdgcn_logf(1.f + e); }
                    if (masked) {
#pragma unroll
                        for (int i = 0; i < 16; ++i) sp[i] = (sb0 + crow(i, h) < tq) ? sp[i] : 0.f; }
                    float G[4], Gp[4], T[4];
#pragma unroll
                    for (int g = 0; g < 4; ++g) { G[g] = (sp[4 * g] + sp[4 * g + 1]) + (sp[4 * g + 2] + sp[4 * g + 3]); Gp[g] = __shfl_xor(G[g], 32); T[g] = G[g] + Gp[g]; }
                    float R[4]; R[3] = carry; R[2] = R[3] + T[3]; R[1] = R[2] + T[2]; R[0] = R[1] + T[1]; carry = R[0] + T[0];
#pragma unroll
                    for (int g = 0; g < 4; ++g) { const float S3 = R[g] + (h == 0 ? Gp[g] : 0.f), S2 = S3 + sp[4 * g + 3], S1 = S2 + sp[4 * g + 2], S0 = S1 + sp[4 * g + 1];
                        A[4 * g + 3] = __builtin_amdgcn_exp2f(sacc[kb][4 * g + 3] - sp[4 * g + 3] - S3); A[4 * g + 2] = __builtin_amdgcn_exp2f(sacc[kb][4 * g + 2] - sp[4 * g + 2] - S2);
                        A[4 * g + 1] = __builtin_amdgcn_exp2f(sacc[kb][4 * g + 1] - sp[4 * g + 1] - S1); A[4 * g + 0] = __builtin_amdgcn_exp2f(sacc[kb][4 * g + 0] - sp[4 * g + 0] - S0); }
                    if (masked) {
#pragma unroll
                        for (int i = 0; i < 16; ++i) A[i] = (sb0 + crow(i, h) < tq) ? A[i] : 0.f; }
#pragma unroll
                    for (int s2 = 0; s2 < 2; ++s2) { u32x4 w; w.x = cvtpk(A[8 * s2], A[8 * s2 + 1]); w.y = cvtpk(A[8 * s2 + 2], A[8 * s2 + 3]); w.z = cvtpk(A[8 * s2 + 4], A[8 * s2 + 5]); w.w = cvtpk(A[8 * s2 + 6], A[8 * s2 + 7]); pf[kb][s2] = __builtin_bit_cast(bf16x8, w); }
                }
            } else {
                if (masked) {
#pragma unroll
                    for (int kb = 0; kb < 2; ++kb)
#pragma unroll
                        for (int i = 0; i < 16; ++i) { const int key = kbase + 32 * kb + crow(i, h); const bool valid = (key <= tq) && (key + 127 >= tq); sacc[kb][i] = valid ? sacc[kb][i] : -__builtin_inff(); } }
                float tmax = sacc[0][0];
#pragma unroll
                for (int kb = 0; kb < 2; ++kb)
#pragma unroll
                    for (int i = 0; i < 16; ++i) tmax = fmaxf(tmax, sacc[kb][i]);
                tmax = fmaxf(tmax, __shfl_xor(tmax, 32));
                const float mnew = fmaxf(mrun, tmax), alpha = __builtin_amdgcn_exp2f(mrun - mnew); mrun = mnew;
                float psum = 0.f;
#pragma unroll
                for (int kb = 0; kb < 2; ++kb) { float P[16];
#pragma unroll
                    for (int i = 0; i < 16; ++i) { P[i] = __builtin_amdgcn_exp2f(sacc[kb][i] - mnew); psum += P[i]; }
#pragma unroll
                    for (int s2 = 0; s2 < 2; ++s2) { u32x4 w; w.x = cvtpk(P[8 * s2], P[8 * s2 + 1]); w.y = cvtpk(P[8 * s2 + 2], P[8 * s2 + 3]); w.z = cvtpk(P[8 * s2 + 4], P[8 * s2 + 5]); w.w = cvtpk(P[8 * s2 + 6], P[8 * s2 + 7]); pf[kb][s2] = __builtin_bit_cast(bf16x8, w); } }
                lrun = lrun * alpha + psum;
#pragma unroll
                for (int c = 0; c < 4; ++c)
#pragma unroll
                    for (int i = 0; i < 16; ++i) oacc[c][i] *= alpha;
            }
#pragma unroll
            for (int kb = 0; kb < 2; ++kb)
#pragma unroll
                for (int s2 = 0; s2 < 2; ++s2)
#pragma unroll
                    for (int c = 0; c < 4; ++c) { const s16x4 lo = trread(Vb + vaddr[c][0] + 4096 * (2 * kb + s2)), hi = trread(Vb + vaddr[c][1] + 4096 * (2 * kb + s2));
                        const bf16x8 vf = __builtin_shufflevector(lo, hi, 0, 1, 2, 3, 4, 5, 6, 7); oacc[c] = ATT_MFMA(vf, pf[kb][s2], oacc[c]); }
        }
        if (more) ATT_LSTORE(buf ^ 1);
        if (EARLY && MODE == 1) {
            volatile ATT_LAS unsigned* fl = (volatile ATT_LAS unsigned*)(lds + FLAG_OFF) + (kt & 1) * 8;
            const bool done = __all(carry > 160.f);
            if (lane == 0) fl[wid] = done ? 1u : 0u;
            __syncthreads();
            unsigned alld = 1u;
#pragma unroll
            for (int w = 0; w < 8; ++w) alld &= fl[w];
            buf ^= 1;
            if (alld) break;
        } else { __syncthreads(); buf ^= 1; }
    }
#undef ATT_GLOAD
#undef ATT_LSTORE
    if (MODE == 0) { const float lt = lrun + __shfl_xor(lrun, 32); const float inv = 1.f / lt;
#pragma unroll
        for (int c = 0; c < 4; ++c)
#pragma unroll
            for (int i = 0; i < 16; ++i) oacc[c][i] *= inv; }
    if (has_next) attn_prefetch(N, qf, kr0, kr1, vr0, vr1, tid, wid, lane);
    { int l2 = lane; asm volatile("" : "+v"(l2)); const int r2 = l2 & 31, h2 = l2 >> 5;
      char* ob = (char*)(Oh + rowbase * po); const unsigned oo = (unsigned)((t0 + r2) * po) * 2u + 16u * (unsigned)h2;
#pragma unroll
      for (int c = 0; c < 4; ++c)
#pragma unroll
        for (int gp = 0; gp < 2; ++gp) { const int g0 = 2 * gp;
            const unsigned x0 = cvtpk(oacc[c][4 * g0], oacc[c][4 * g0 + 1]), x1 = cvtpk(oacc[c][4 * g0 + 2], oacc[c][4 * g0 + 3]);
            const unsigned y0 = cvtpk(oacc[c][4 * g0 + 4], oacc[c][4 * g0 + 5]), y1 = cvtpk(oacc[c][4 * g0 + 6], oacc[c][4 * g0 + 7]);
            const auto s0 = __builtin_amdgcn_permlane32_swap(x0, y0, false, false); const auto s1 = __builtin_amdgcn_permlane32_swap(x1, y1, false, false);
            u32x4 w; w.x = s0[0]; w.y = s1[0]; w.z = s0[1]; w.w = s1[1];
            *(u32x4*)(ob + oo + 64 * c + 32 * gp) = w; } }
    if (EARLY && MODE == 1) __syncthreads();
}
}


constexpr int NWAVES = 8;
constexpr int BATCH = 4, SEQ = 4096, D = 4096, M = BATCH * SEQ, HD = 128, FF = 4 * D;
constexpr int D_IN = 9216, NG = 8192, N1 = D_IN + NG, NMOD = 6 * D;
constexpr float NORM_EPS = 1e-6f;
constexpr size_t MiB = 1u << 20;
constexpr size_t WS_CTL = 0, CTL_ZERO_BYTES = 49152;
constexpr size_t WS_CMX = 16384;
constexpr size_t WS_MOD = 1 * MiB, WS_COS = 2 * MiB, WS_SIN = 3 * MiB;
constexpr size_t WS_W1 = 4 * MiB;
constexpr size_t WS_WPS = 140 * MiB, WS_WPB = 156 * MiB;
constexpr size_t WS_WO = 172 * MiB;
constexpr size_t WS_WF1 = 204 * MiB;
constexpr size_t WS_WF2 = 332 * MiB;
constexpr size_t WS_A = 460 * MiB;
constexpr size_t WS_B = 588 * MiB;
constexpr size_t WS_C = 716 * MiB;
constexpr size_t WS_H8 = WS_C + 544 * MiB;
constexpr size_t WS_W8G = WS_H8 + 64 * MiB;
constexpr size_t WS_W8F = WS_W8G + 56 * MiB;
constexpr size_t WS_W8O = WS_W8F + 64 * MiB;
constexpr size_t WS_END = WS_W8O + 64 * MiB;
constexpr size_t WS_U8 = WS_W1;
constexpr size_t WS_SU = 320 * 1024, WS_SO = 384 * 1024, WS_CO = 32768;
constexpr int NB16 = 3072, NI8 = 14336;
constexpr size_t WS_SH = 64 * 1024, WS_S2 = 128 * 1024, WS_SG = 192 * 1024, WS_SF = 256 * 1024;
constexpr int CW_BAR = 0, CW_KS = 3520;
constexpr int RING_OFF = 0, RING_BYTES = 131072, LDSCTL_OFF = 139264, MISC_OFF = LDSCTL_OFF + 320, LDS_BYTES = 147456;

#define GAS __attribute__((address_space(1)))
#define LAS __attribute__((address_space(3)))
typedef unsigned short bf16;
typedef unsigned v4u __attribute__((ext_vector_type(4)));
typedef unsigned v2u __attribute__((ext_vector_type(2)));
typedef float f32x4 __attribute__((ext_vector_type(4)));
#define LDS_WAIT() asm volatile("s_waitcnt lgkmcnt(0)" ::: "memory")
__device__ __forceinline__ unsigned f2bf(float f) { unsigned u = __builtin_bit_cast(unsigned, f); return (u + 0x7fffu + ((u >> 16) & 1u)) >> 16; }
__device__ __forceinline__ unsigned pk2(float lo, float hi) { return f2bf(lo) | (f2bf(hi) << 16); }

#define XB_TMO      128
#define XB_XCNT(j)  (256  + 64 * (j))
#define XB_XSUB(j)  (1280 + 64 * (j))
#define XB_XGEN(j)  (2304 + 64 * (j))
#define XB_TOP      3328
#define XB_TOPGEN   3392
#define XCD_BAR_WORDS 3456
#define XB_SPIN_CAP (1u << 18)
__device__ __forceinline__ unsigned xb_ld(unsigned* p)              { return __hip_atomic_load(p, __ATOMIC_RELAXED, __HIP_MEMORY_SCOPE_AGENT); }
__device__ __forceinline__ unsigned xb_add(unsigned* p, unsigned v) { return __hip_atomic_fetch_add(p, v, __ATOMIC_RELAXED, __HIP_MEMORY_SCOPE_AGENT); }
__device__ __forceinline__ unsigned xb_xcc_id() { return (unsigned)__builtin_amdgcn_s_getreg((3 << 11) | 20) & 0xFu; }
#define XB_SPIN(cond, bar) do { unsigned _sp = 0; while (cond) { __builtin_amdgcn_s_sleep(1); \
    if ((++_sp & 255u) == 0u) { if (xb_ld(&(bar)[XB_TMO])) break; if (_sp > XB_SPIN_CAP) { atomicAdd(&(bar)[XB_TMO], 1u); break; } } } } while (0)
struct XcdBarrier { unsigned* bar; unsigned x; volatile LAS unsigned* st; };
__device__ __forceinline__ XcdBarrier xcd_barrier_post(unsigned* bar, volatile LAS unsigned* st) {
    XcdBarrier b; b.bar = bar; b.x = xb_xcc_id(); b.st = st;
    if (threadIdx.x == 0) (void)xb_add(&bar[XB_XCNT(b.x)], 1u);
    return b;
}
__device__ __forceinline__ void xcd_barrier_complete(unsigned* bar, unsigned x, unsigned& nloc, unsigned& nx) {
    const unsigned G = gridDim.x * gridDim.y * gridDim.z;
    unsigned sum, cnt, mine, sp = 0u;
    for (;;) {
        sum = 0u; cnt = 0u; mine = 0u;
#pragma unroll
        for (unsigned j = 0; j < 16; ++j) { const unsigned c = xb_ld(&bar[XB_XCNT(j)]); sum += c; cnt += (c > 0u) ? 1u : 0u; mine = (j == x) ? c : mine; }
        if (sum == G) break;
        __builtin_amdgcn_s_sleep(1);
        if ((++sp & 255u) == 0u) { if (xb_ld(&bar[XB_TMO])) break; if (sp > XB_SPIN_CAP) { atomicAdd(&bar[XB_TMO], 1u); break; } }
    }
    nloc = mine > 0u ? mine : 1u; nx = cnt > 0u ? cnt : 1u;
}
__device__ __forceinline__ void xcd_barrier(const XcdBarrier& b) {
    asm volatile("s_waitcnt vmcnt(0)" ::: "memory");
    __syncthreads();
    if (threadIdx.x == 0) {
        unsigned* bar = b.bar;
        __builtin_amdgcn_s_waitcnt(0);
        unsigned nloc = b.st[0], nx = b.st[1];
        if (nloc == 0u) { xcd_barrier_complete(bar, b.x, nloc, nx); b.st[0] = nloc; b.st[1] = nx; }
        const unsigned old = xb_add(&bar[XB_XSUB(b.x)], 1u);
        const unsigned gen = old / nloc;
        if (old + 1u == (gen + 1u) * nloc) {
            __builtin_amdgcn_fence(__ATOMIC_RELEASE, "agent");
            asm volatile("s_waitcnt vmcnt(0)" ::: "memory");
            const unsigned og = xb_add(&bar[XB_TOP], 1u);
            const unsigned tg = og / nx;
            if (og + 1u == (tg + 1u) * nx) xb_add(&bar[XB_TOPGEN], 1u);
            else XB_SPIN(xb_ld(&bar[XB_TOPGEN]) == tg, bar);
            __builtin_amdgcn_fence(__ATOMIC_ACQUIRE, "agent");
            xb_add(&bar[XB_XGEN(b.x)], 1u);
            asm volatile("s_waitcnt vmcnt(0)" ::: "memory");
        } else {
            XB_SPIN(xb_ld(&bar[XB_XGEN(b.x)]) == gen, bar);
            __builtin_amdgcn_fence(__ATOMIC_ACQUIRE, "agent");
            asm volatile("s_waitcnt vmcnt(0)" ::: "memory");
        }
    }
    __syncthreads();
}

struct Frame {
    LAS unsigned char* lds;
    int tid, lane, wave, vcu, G;
};
struct Args {
    const float *x, *c, *w_ada, *b_ada, *g_pre_mix, *g_post_mix, *g_pre_mlp, *g_post_mlp, *w_in, *sinks, *w_bg, *b_bg, *w_ps, *w_pb, *w_out, *w_f1, *w_f2;
    float* out; unsigned char* ws; int ph_lo, ph_hi;
};

__device__ __forceinline__ float wave_sum(float v) {
#pragma unroll
    for (int o = 1; o < 64; o <<= 1) v += __shfl_xor(v, o);
    return v;
}
__device__ const double ROPE_INVF[64] = {1.0, 0.8659643233600653, 0.7498942093324559, 0.6493816315762113, 0.5623413251903491, 0.4869675251658631, 0.4216965034285822, 0.3651741272548377, 0.31622776601683794, 0.27384196342643613, 0.23713737056616552, 0.2053525026457146, 0.1778279410038923, 0.1539926526059492, 0.1333521432163324, 0.11547819846894582, 0.1, 0.08659643233600653, 0.07498942093324558, 0.06493816315762113, 0.05623413251903491, 0.04869675251658631, 0.042169650342858224, 0.03651741272548377, 0.03162277660168379, 0.027384196342643614, 0.023713737056616554, 0.02053525026457146, 0.01778279410038923, 0.01539926526059492, 0.01333521432163324, 0.011547819846894581, 0.01, 0.008659643233600654, 0.007498942093324558, 0.006493816315762113, 0.005623413251903491, 0.004869675251658631, 0.004216965034285823, 0.003651741272548377, 0.0031622776601683794, 0.0027384196342643613, 0.0023713737056616554, 0.002053525026457146, 0.0017782794100389228, 0.001539926526059492, 0.001333521432163324, 0.0011547819846894581, 0.001, 0.0008659643233600654, 0.0007498942093324559, 0.0006493816315762113, 0.0005623413251903491, 0.0004869675251658631, 0.00042169650342858224, 0.0003651741272548377, 0.00031622776601683794, 0.0002738419634264361, 0.00023713737056616554, 0.0002053525026457146, 0.00017782794100389227, 0.0001539926526059492, 0.0001333521432163324, 0.00011547819846894582};

struct TDesc { const float* W; bf16* WT; int K, N, row_off, rope_lim, item, fp8; };
__device__ __forceinline__ void p0_tr_load(const TDesc& t, f32x4 (&v)[16], int lane) {
    const int nblk = t.N / 64, kb = t.item / nblk, nb = t.item % nblk, k0 = 64 * kb, n0 = 64 * nb;
    const int kq = lane >> 4, nn = 4 * (lane & 15);
#pragma unroll
    for (int i = 0; i < 16; ++i) v[i] = *(const f32x4*)(t.W + (size_t)(k0 + 4 * i + kq) * t.N + n0 + nn);
}
__device__ __forceinline__ void p0_tr_store(const TDesc& t, const f32x4 (&v)[16], LAS float* scr, int lane) {
    const int nblk = t.N / 64, kb = t.item / nblk, nb = t.item % nblk, k0 = 64 * kb, n0 = 64 * nb;
    const int kq = lane >> 4, nn = 4 * (lane & 15);
#pragma unroll
    for (int i = 0; i < 16; ++i) { LAS float* s = scr + (4 * i + kq) * 65 + nn; s[0] = v[i].x; s[1] = v[i].y; s[2] = v[i].z; s[3] = v[i].w; }
    LDS_WAIT(); asm volatile("" ::: "memory");
    const int c = lane & 7;
#pragma unroll
    for (int j = 0; j < 8; ++j) { const int n = (lane >> 3) + 8 * j; const LAS float* s = scr + (8 * c) * 65 + n;
        v4u o; o.x = pk2(s[0 * 65], s[1 * 65]); o.y = pk2(s[2 * 65], s[3 * 65]); o.z = pk2(s[4 * 65], s[5 * 65]); o.w = pk2(s[6 * 65], s[7 * 65]);
        int nd = n0 + n;
        if (t.rope_lim) {
            int sb_, sd_; bool rp_ = false;
            if (nd < 2048) { sb_ = 0; sd_ = 3072; rp_ = true; } else if (nd < 2560) { sb_ = 2048; sd_ = 0; rp_ = true; } else if (nd < 3072) { sb_ = 2560; sd_ = 512; }
            else if (nd < 5120) { sb_ = 3072; sd_ = 5120; } else if (nd < 7168) { sb_ = 5120; sd_ = 7168; } else { sb_ = 7168; sd_ = 1024; }
            int loc = nd - sb_; if (rp_) { const int d = loc & 127; loc = (loc & ~127) + (d < 64 ? 8 * (d >> 2) + (d & 3) : 8 * ((d - 64) >> 2) + 4 + (d & 3)); }
            nd = sd_ + loc; }
        *(v4u*)(t.WT + (size_t)(t.row_off + nd) * t.K + k0 + 8 * c) = o; }
    LDS_WAIT(); asm volatile("" ::: "memory");
}
__device__ __forceinline__ void p0_gemv(Frame& F, const Args& a, float* mod) {
    LAS f32x4* cact = (LAS f32x4*)F.lds;
    LAS float* red = (LAS float*)(F.lds + 65536);
    for (int k = F.tid; k < D; k += NWAVES * 64) { f32x4 v;
#pragma unroll
        for (int b = 0; b < 4; ++b) { const float xx = a.c[b * D + k]; v[b] = xx / (1.f + expf(-xx)); }
        cact[k] = v; }
    __syncthreads();
    const int half = F.lane >> 5, l32 = F.lane & 31; const bool act = l32 < 24;
    for (int cg = F.vcu; cg < NMOD / 96; cg += F.G) {
        f32x4 acc[4];
#pragma unroll
        for (int b = 0; b < 4; ++b) acc[b] = (f32x4){0.f, 0.f, 0.f, 0.f};
        const int kbase = 512 * F.wave + half;
        const float* wp = a.w_ada + (size_t)kbase * NMOD + 96 * cg + 4 * (act ? l32 : 0);
#define GV_LOAD(w, kk) _Pragma("unroll") for (int u = 0; u < 16; ++u) w[u] = *(const f32x4*)(wp + (size_t)(2 * ((kk) + u)) * NMOD)
#define GV_FMA(w, kk) _Pragma("unroll") for (int u = 0; u < 16; ++u) { const f32x4 ca = cact[kbase + 2 * ((kk) + u)]; _Pragma("unroll") for (int b = 0; b < 4; ++b) acc[b] += w[u] * ca[b]; }
        f32x4 wA[16], wB[16];
        GV_LOAD(wA, 0);
#pragma unroll 1
        for (int kk = 0; kk < 224; kk += 32) {
            GV_LOAD(wB, kk + 16); asm volatile("" ::: "memory");
            GV_FMA(wA, kk);
            GV_LOAD(wA, kk + 32); asm volatile("" ::: "memory");
            GV_FMA(wB, kk + 16);
        }
        GV_LOAD(wB, 240); asm volatile("" ::: "memory");
        GV_FMA(wA, 224);
        GV_FMA(wB, 240);
#undef GV_LOAD
#undef GV_FMA
#pragma unroll
        for (int b = 0; b < 4; ++b)
#pragma unroll
            for (int j = 0; j < 4; ++j) acc[b][j] += __shfl_xor(acc[b][j], 32);
        if (half == 0 && act) {
#pragma unroll
            for (int b = 0; b < 4; ++b) *(LAS f32x4*)(red + (F.wave * 4 + b) * 96 + 4 * l32) = acc[b]; }
        __syncthreads();
        if (F.tid < 384) { const int b = F.tid / 96, j = F.tid % 96; float s = 0.f;
#pragma unroll
            for (int w = 0; w < 8; ++w) s += red[(w * 4 + b) * 96 + j];
            mod[b * NMOD + 96 * cg + j] = s + a.b_ada[96 * cg + j]; }
        __syncthreads();
    }
}
__device__ __forceinline__ void p0_rope_table(Frame& F, float* cosT, float* sinT) {
    const double TWO_PI_HI = 6.283185307179586232, TWO_PI_LO = 2.4492935982947064e-16, INV_2PI = 0.15915494309189533577;
    for (int idx = F.vcu * (NWAVES * 64) + F.tid; idx < SEQ * 64; idx += F.G * NWAVES * 64) {
        const int pos = idx >> 6, i = idx & 63;
        const double ang = (double)pos * ROPE_INVF[i];
        const double n = __builtin_rint(ang * INV_2PI);
        double r = __builtin_fma(-n, TWO_PI_HI, ang); r = __builtin_fma(-n, TWO_PI_LO, r);
        const double r2 = r * r; double tc = 1.0, ts = r, sc = 1.0, ss = r;
#pragma unroll 1
        for (int k = 1; k <= 15; ++k) { tc *= -r2 / (double)((2 * k - 1) * (2 * k)); ts *= -r2 / (double)((2 * k) * (2 * k + 1)); sc += tc; ss += ts; }
        cosT[idx] = (float)sc; sinT[idx] = (float)ss;
    }
}

__device__ __forceinline__ f32x4 ld_bf4(const bf16* p) { const v2u w = *(const v2u*)p; return (f32x4){__uint_as_float(w.x << 16), __uint_as_float(w.x & 0xffff0000u), __uint_as_float(w.y << 16), __uint_as_float(w.y & 0xffff0000u)}; }
__device__ __forceinline__ void st_bf4(bf16* p, f32x4 v) { v2u w; w.x = pk2(v.x, v.y); w.y = pk2(v.z, v.w); *(v2u*)p = w; }
__device__ __forceinline__ float sumsq4(f32x4 v) { return (v.x * v.x + v.y * v.y) + (v.z * v.z + v.w * v.w); }

#define LAUNDER_PTR(p) asm volatile("" : "+s"(p))
__device__ __forceinline__ float wave_max(float v) {
#pragma unroll
    for (int o = 1; o < 64; o <<= 1) v = fmaxf(v, __shfl_xor(v, o));
    return v;
}
__device__ __forceinline__ float amax4(f32x4 v) { return fmaxf(fmaxf(__builtin_fabsf(v.x), __builtin_fabsf(v.y)), fmaxf(__builtin_fabsf(v.z), __builtin_fabsf(v.w))); }
__device__ __forceinline__ unsigned q4_i8(f32x4 v, float inv) {
    const int a = (int)__builtin_rintf(v.x * inv), b = (int)__builtin_rintf(v.y * inv), c = (int)__builtin_rintf(v.z * inv), d = (int)__builtin_rintf(v.w * inv);
    return (unsigned)(a & 255) | ((unsigned)(b & 255) << 8) | ((unsigned)(c & 255) << 16) | ((unsigned)d << 24); }
constexpr int SLAB_PITCH = 8192 + 16;
struct SDesc { const float* W; unsigned char* dst; float* sc; int N, c0, r0, rope; };
template <int H> __device__ __forceinline__ void slab_load(const SDesc& s, f32x4 (&va)[8], f32x4 (&vb)[8], int tid) {
    const float* p = s.W + (size_t)(2 * (tid >> 2) + 2048 * H) * s.N + s.c0 + 4 * (tid & 3);
#pragma unroll
    for (int i = 0; i < 8; ++i) { const float* q = p + (size_t)(256 * i) * s.N; va[i] = *(const f32x4*)q; vb[i] = *(const f32x4*)(q + s.N); }
}
template <int H> __device__ __forceinline__ void slab_stage(LAS unsigned char* lds, const f32x4 (&va)[8], const f32x4 (&vb)[8], int tid) {
    LAS unsigned char* t = lds + (4 * (tid & 3)) * SLAB_PITCH + 4 * (tid >> 2) + 4096 * H;
#pragma unroll
    for (int i = 0; i < 8; ++i)
#pragma unroll
        for (int j = 0; j < 4; ++j) *(LAS unsigned*)(t + j * SLAB_PITCH + 512 * i) = pg8::cvt_pk_bf16(va[i][j], vb[i][j]);
}
__device__ __forceinline__ void slab_quant(const SDesc& s, const LAS unsigned char* lds, int wave, int lane) {
#pragma unroll 1
    for (int rr = 0; rr < 2; ++rr) { const int n = 2 * wave + rr;
        v4u w[8]; float am = 0.f;
#pragma unroll
        for (int j = 0; j < 8; ++j) w[j] = *(const LAS v4u*)(lds + n * SLAB_PITCH + 16 * (lane + 64 * j));
#pragma unroll
        for (int j = 0; j < 8; ++j)
#pragma unroll
            for (int e = 0; e < 4; ++e) { const unsigned x = w[j][e]; am = fmaxf(am, fmaxf(__builtin_fabsf(__uint_as_float(x << 16)), __builtin_fabsf(__uint_as_float(x & 0xffff0000u)))); }
        am = wave_max(am); const float inv = am > 0.f ? 127.f / am : 0.f;
        int loc = s.c0 + n; if (s.rope) { const int d = loc & 127; loc = (loc & ~127) + (d < 64 ? 8 * (d >> 2) + (d & 3) : 8 * ((d - 64) >> 2) + 4 + (d & 3)); }
        const int drow = s.r0 + loc;
        if (lane == 0) s.sc[drow] = am * (1.f / 127.f);
#pragma unroll
        for (int j = 0; j < 8; ++j) { v2u o;
            o.x = q4_i8((f32x4){__uint_as_float(w[j].x << 16), __uint_as_float(w[j].x & 0xffff0000u), __uint_as_float(w[j].y << 16), __uint_as_float(w[j].y & 0xffff0000u)}, inv);
            o.y = q4_i8((f32x4){__uint_as_float(w[j].z << 16), __uint_as_float(w[j].z & 0xffff0000u), __uint_as_float(w[j].w << 16), __uint_as_float(w[j].w & 0xffff0000u)}, inv);
            *(v2u*)(s.dst + (size_t)drow * D + 8 * (lane + 64 * j)) = o; }
    }
}
__device__ __forceinline__ void ks_quant(const LAS unsigned char* lds, unsigned char* dst, float* sc, int* csum, int cs, int q, unsigned mb0, unsigned mb1, int wave, int lane) {
#pragma unroll 1
    for (int rr = 0; rr < 2; ++rr) { const int n = 2 * wave + rr, col = 16 * cs + n;
        v4u w[8];
#pragma unroll
        for (int j = 0; j < 8; ++j) w[j] = *(const LAS v4u*)(lds + n * SLAB_PITCH + 16 * (lane + 64 * j));
        const float am = __uint_as_float(rr ? mb1 : mb0), inv = am > 0.f ? 127.f / am : 0.f;
        if (lane == 0 && q == 0) sc[col] = am * (1.f / 127.f);
        float qs = 0.f;
#pragma unroll
        for (int j = 0; j < 8; ++j) { v2u o; float t[8];
#pragma unroll
            for (int e = 0; e < 4; ++e) { const unsigned x = w[j][e]; t[2 * e] = __builtin_rintf(__uint_as_float(x << 16) * inv); t[2 * e + 1] = __builtin_rintf(__uint_as_float(x & 0xffff0000u) * inv); }
#pragma unroll
            for (int e = 0; e < 8; ++e) qs += t[e];
            o.x = ((unsigned)(int)t[0] & 255u) | (((unsigned)(int)t[1] & 255u) << 8) | (((unsigned)(int)t[2] & 255u) << 16) | ((unsigned)(int)t[3] << 24);
            o.y = ((unsigned)(int)t[4] & 255u) | (((unsigned)(int)t[5] & 255u) << 8) | (((unsigned)(int)t[6] & 255u) << 16) | ((unsigned)(int)t[7] << 24);
            *(v2u*)(dst + (size_t)col * FF + 4096 * q + 8 * (lane + 64 * j)) = o; }
        qs = wave_sum(qs);
        if (lane == 0) atomicAdd(csum + col, (int)qs);
    }
}
__device__ __forceinline__ void p1_rows(Frame& F, const Args& a, const float* mod, bf16* H, unsigned char* H8, float* SH) {
    int lane_ = F.lane; asm volatile("" : "+v"(lane_)); const int LN = lane_;
    const int gw = F.vcu * NWAVES + F.wave, NGW = F.G * NWAVES;
    for (int r0 = gw * 8; r0 < M; r0 += NGW * 8) {
        const int b = r0 >> 12;
#pragma unroll 1
        for (int r = 0; r < 8; ++r) { const size_t row = (size_t)(r0 + r);
            const float* mb = mod + b * NMOD; const float* gp = a.g_pre_mix; LAUNDER_PTR(mb); LAUNDER_PTR(gp);
            f32x4 v[16]; float ss = 0.f;
#pragma unroll
            for (int j = 0; j < 16; ++j) { v[j] = *(const f32x4*)(a.x + row * D + 4 * LN + 256 * j); ss += sumsq4(v[j]); }
            const float rstd = 1.f / sqrtf(wave_sum(ss) * (1.f / D) + NORM_EPS);
            float am = 0.f;
#pragma unroll
            for (int j = 0; j < 16; ++j) { const int col = 4 * LN + 256 * j; if ((j & 3) == 0) asm volatile("" ::: "memory");
                const f32x4 av = *(const GAS f32x4*)(gp + col) * (*(const GAS f32x4*)(mb + D + col) + 1.f);
                v[j] = v[j] * rstd * av + *(const GAS f32x4*)(mb + col);
                st_bf4(H + row * D + col, v[j]); am = fmaxf(am, amax4(v[j])); }
            am = wave_max(am); const float inv = am > 0.f ? 127.f / am : 0.f;
            if (LN == 0) SH[row] = am * (1.f / 127.f);
#pragma unroll
            for (int j = 0; j < 16; ++j) *(unsigned*)(H8 + row * D + 4 * LN + 256 * j) = q4_i8(v[j], inv);
        }
    }
}
__device__ __forceinline__ void quant_rows(Frame& F, const bf16* __restrict__ src, unsigned char* __restrict__ dst, float* __restrict__ sc, int nrows) {
    int lane_ = F.lane; asm volatile("" : "+v"(lane_)); const int LN = lane_;
    const int gw = F.vcu * NWAVES + F.wave, NGW = F.G * NWAVES;
#pragma unroll 1
    for (int n = gw; n < nrows; n += NGW) {
        v4u w[8]; float am = 0.f;
#pragma unroll
        for (int j = 0; j < 8; ++j) w[j] = *(const v4u*)(src + (size_t)n * D + 8 * (LN + 64 * j));
#pragma unroll
        for (int j = 0; j < 8; ++j) {
#pragma unroll
            for (int e = 0; e < 4; ++e) { const unsigned x = w[j][e]; am = fmaxf(am, fmaxf(__builtin_fabsf(__uint_as_float(x << 16)), __builtin_fabsf(__uint_as_float(x & 0xffff0000u)))); } }
        am = wave_max(am); const float inv = am > 0.f ? 127.f / am : 0.f;
        if (LN == 0) sc[n] = am * (1.f / 127.f);
#pragma unroll
        for (int j = 0; j < 8; ++j) { v2u o;
            o.x = q4_i8((f32x4){__uint_as_float(w[j].x << 16), __uint_as_float(w[j].x & 0xffff0000u), __uint_as_float(w[j].y << 16), __uint_as_float(w[j].y & 0xffff0000u)}, inv);
            o.y = q4_i8((f32x4){__uint_as_float(w[j].z << 16), __uint_as_float(w[j].z & 0xffff0000u), __uint_as_float(w[j].w << 16), __uint_as_float(w[j].w & 0xffff0000u)}, inv);
            *(v2u*)(dst + (size_t)n * D + 8 * (LN + 64 * j)) = o; }
    }
}
__device__ __forceinline__ void quant_rows_long(Frame& F, const bf16* __restrict__ src, unsigned char* __restrict__ dst, float* __restrict__ sc, int* __restrict__ csum, int nrows) {
    int lane_ = F.lane; asm volatile("" : "+v"(lane_)); const int LN = lane_;
    const int gw = F.vcu * NWAVES + F.wave, NGW = F.G * NWAVES;
#pragma unroll 1
    for (int n = gw; n < nrows; n += NGW) {
        float am = 0.f;
#pragma unroll 1
        for (int c = 0; c < 4; ++c) { v4u w[8];
#pragma unroll
            for (int j = 0; j < 8; ++j) w[j] = *(const v4u*)(src + (size_t)n * FF + c * 4096 + 8 * (LN + 64 * j));
#pragma unroll
            for (int j = 0; j < 8; ++j)
#pragma unroll
                for (int e = 0; e < 4; ++e) { const unsigned x = w[j][e]; am = fmaxf(am, fmaxf(__builtin_fabsf(__uint_as_float(x << 16)), __builtin_fabsf(__uint_as_float(x & 0xffff0000u)))); } }
        am = wave_max(am); const float inv = am > 0.f ? 127.f / am : 0.f;
        float qs = 0.f;
#pragma unroll 1
        for (int c = 0; c < 4; ++c) { v4u w[8];
#pragma unroll
            for (int j = 0; j < 8; ++j) w[j] = *(const v4u*)(src + (size_t)n * FF + c * 4096 + 8 * (LN + 64 * j));
#pragma unroll
            for (int j = 0; j < 8; ++j) { v2u o; float t[8];
#pragma unroll
                for (int e = 0; e < 4; ++e) { const unsigned x = w[j][e]; t[2 * e] = __builtin_rintf(__uint_as_float(x << 16) * inv); t[2 * e + 1] = __builtin_rintf(__uint_as_float(x & 0xffff0000u) * inv); }
#pragma unroll
                for (int e = 0; e < 8; ++e) qs += t[e];
                o.x = ((unsigned)(int)t[0] & 255u) | (((unsigned)(int)t[1] & 255u) << 8) | (((unsigned)(int)t[2] & 255u) << 16) | ((unsigned)(int)t[3] << 24);
                o.y = ((unsigned)(int)t[4] & 255u) | (((unsigned)(int)t[5] & 255u) << 8) | (((unsigned)(int)t[6] & 255u) << 16) | ((unsigned)(int)t[7] << 24);
                *(v2u*)(dst + (size_t)n * FF + c * 4096 + 8 * (LN + 64 * j)) = o; } }
        qs = wave_sum(qs);
        if (LN == 0) { sc[n] = am * (1.f / 127.f); csum[n] = (int)qs; }
    }
}
__device__ __forceinline__ void requant_u(Frame& F, const bf16* __restrict__ U, unsigned char* __restrict__ U8, float* __restrict__ su) {
    int lane_ = F.lane; asm volatile("" : "+v"(lane_)); const int LN = lane_;
    LAS float* red = (LAS float*)(F.lds + RING_OFF);
    const int q = F.wave & 3, half = F.wave >> 2;
    const size_t coff = (size_t)q * 4096 + 8 * LN;
#define RQ_LOAD(w, r) _Pragma("unroll") for (int j = 0; j < 8; ++j) w[j] = *(const v4u*)(U + (size_t)(r) * FF + coff + 512 * j)
    v4u wc[8], wn[8];
    if (F.vcu < M / 2) RQ_LOAD(wc, 2 * F.vcu + half);
#pragma unroll 1
    for (int pi = F.vcu, p = 0; pi < M / 2; pi += F.G, ++p) { const int r = 2 * pi + half, rn = 2 * (pi + F.G < M / 2 ? pi + F.G : pi) + half;
        float am = 0.f;
#pragma unroll
        for (int j = 0; j < 8; ++j)
#pragma unroll
            for (int e = 0; e < 4; ++e) { const unsigned x = wc[j][e]; am = fmaxf(am, fmaxf(__uint_as_float(x << 16), __uint_as_float(x & 0xffff0000u))); }
        am = wave_max(am);
        if (LN == 0) red[(p & 1) * 8 + F.wave] = am;
        RQ_LOAD(wn, rn);
        __syncthreads();
        { const LAS float* rp = red + (p & 1) * 8 + 4 * half; am = fmaxf(fmaxf(rp[0], rp[1]), fmaxf(rp[2], rp[3])); }
        const float inv = am > 0.f ? 255.f / am : 0.f;
        if (LN == 0 && q == 0) su[r] = am * (1.f / 255.f);
#pragma unroll
        for (int j = 0; j < 8; ++j) { v2u o; int t[8];
#pragma unroll
            for (int e = 0; e < 4; ++e) { const unsigned x = wc[j][e]; t[2 * e] = (int)__builtin_rintf(__uint_as_float(x << 16) * inv) - 128; t[2 * e + 1] = (int)__builtin_rintf(__uint_as_float(x & 0xffff0000u) * inv) - 128; }
            o.x = ((unsigned)t[0] & 255u) | (((unsigned)t[1] & 255u) << 8) | (((unsigned)t[2] & 255u) << 16) | ((unsigned)t[3] << 24);
            o.y = ((unsigned)t[4] & 255u) | (((unsigned)t[5] & 255u) << 8) | (((unsigned)t[6] & 255u) << 16) | ((unsigned)t[7] << 24);
            *(v2u*)(U8 + (size_t)r * FF + coff + 512 * j) = o; }
#pragma unroll
        for (int j = 0; j < 8; ++j) wc[j] = wn[j];
    }
#undef RQ_LOAD
    __syncthreads();
}
__device__ __forceinline__ f32x4 unpk4(v2u w) { return (f32x4){__uint_as_float(w.x << 16), __uint_as_float(w.x & 0xffff0000u), __uint_as_float(w.y << 16), __uint_as_float(w.y & 0xffff0000u)}; }
__device__ __forceinline__ void p6_rows(Frame& F, const Args& a, const float* mod, const bf16* MX, unsigned char* H2, float* S2) {
    int lane_ = F.lane; asm volatile("" : "+v"(lane_)); const int LN = lane_;
    const int gw = F.vcu * NWAVES + F.wave, NGW = F.G * NWAVES;
    for (int r0 = gw * 8; r0 < M; r0 += NGW * 8) {
        const int b = r0 >> 12;
#pragma unroll 1
        for (int r = 0; r < 8; ++r) { const size_t row = (size_t)(r0 + r);
            const float* mb = mod + b * NMOD; LAUNDER_PTR(mb);
            v2u mp[16]; f32x4 xr[16]; float ss = 0.f;
#pragma unroll
            for (int j = 0; j < 16; ++j) mp[j] = *(const v2u*)(MX + row * D + 4 * LN + 256 * j);
#pragma unroll
            for (int j = 0; j < 16; ++j) xr[j] = *(const f32x4*)(a.x + row * D + 4 * LN + 256 * j);
#pragma unroll
            for (int j = 0; j < 16; ++j) ss += sumsq4(unpk4(mp[j]));
            const float rstd = 1.f / sqrtf(wave_sum(ss) * (1.f / D) + NORM_EPS);
            float ss2 = 0.f;
#pragma unroll
            for (int j = 0; j < 16; ++j) { const int col = 4 * LN + 256 * j; if ((j & 3) == 0) asm volatile("" ::: "memory");
                const f32x4 g1 = *(const GAS f32x4*)(mb + 2 * D + col) * *(const f32x4*)(a.g_post_mix + col);
                xr[j] = xr[j] + g1 * (unpk4(mp[j]) * rstd);
                *(f32x4*)(a.out + row * D + col) = xr[j]; ss2 += sumsq4(xr[j]); }
            const float rstd2 = 1.f / sqrtf(wave_sum(ss2) * (1.f / D) + NORM_EPS);
            float am = 0.f;
#pragma unroll
            for (int j = 0; j < 16; ++j) { const int col = 4 * LN + 256 * j; if ((j & 3) == 0) asm volatile("" ::: "memory");
                const f32x4 a2 = *(const f32x4*)(a.g_pre_mlp + col) * (*(const GAS f32x4*)(mb + 4 * D + col) + 1.f);
                xr[j] = xr[j] * rstd2 * a2 + *(const GAS f32x4*)(mb + 3 * D + col); am = fmaxf(am, amax4(xr[j])); }
            am = wave_max(am); const float inv = am > 0.f ? 127.f / am : 0.f;
            if (LN == 0) S2[row] = am * (1.f / 127.f);
#pragma unroll
            for (int j = 0; j < 16; ++j) *(unsigned*)(H2 + row * D + 4 * LN + 256 * j) = q4_i8(xr[j], inv);
        }
    }
}
__device__ __forceinline__ void p9_rows(Frame& F, const Args& a, const float* mod, const bf16* FB) {
    int lane_ = F.lane; asm volatile("" : "+v"(lane_)); const int LN = lane_;
    const int gw = F.vcu * NWAVES + F.wave, NGW = F.G * NWAVES;
    for (int r0 = gw * 8; r0 < M; r0 += NGW * 8) {
        const int b = r0 >> 12;
#pragma unroll 1
        for (int r = 0; r < 8; ++r) { const size_t row = (size_t)(r0 + r);
            const float* mb = mod + b * NMOD; LAUNDER_PTR(mb);
            v2u mp[16]; f32x4 xr[16]; float ss = 0.f;
#pragma unroll
            for (int j = 0; j < 16; ++j) mp[j] = *(const v2u*)(FB + row * D + 4 * LN + 256 * j);
#pragma unroll
            for (int j = 0; j < 16; ++j) xr[j] = *(const f32x4*)(a.out + row * D + 4 * LN + 256 * j);
#pragma unroll
            for (int j = 0; j < 16; ++j) ss += sumsq4(unpk4(mp[j]));
            const float rstd = 1.f / sqrtf(wave_sum(ss) * (1.f / D) + NORM_EPS);
#pragma unroll
            for (int j = 0; j < 16; ++j) { const int col = 4 * LN + 256 * j; if ((j & 3) == 0) asm volatile("" ::: "memory");
                const f32x4 g2 = *(const GAS f32x4*)(mb + 5 * D + col) * *(const f32x4*)(a.g_post_mlp + col);
                *(f32x4*)(a.out + row * D + col) = xr[j] + g2 * (unpk4(mp[j]) * rstd); }
        }
    }
}

#ifndef P7_NT
#define P7_NT false
#endif
#ifndef P8_WGM
#define P8_WGM 8
#endif
#ifndef SB_EARLY
#define SB_EARLY 1
#endif
__global__ void __launch_bounds__(NWAVES * 64, 2) fwd_kernel(Args args) {
    extern __shared__ __attribute__((aligned(16))) unsigned char lds[];
    Frame F;
    F.lds = (LAS unsigned char*)lds;
    F.tid = threadIdx.x; F.lane = F.tid & 63; F.wave = __builtin_amdgcn_readfirstlane(F.tid >> 6);
    F.G = gridDim.x; { const int bx = blockIdx.x; F.vcu = (F.G % 8 == 0) ? (bx % 8) * (F.G / 8) + bx / 8 : bx; }
    unsigned char* ws = args.ws;
    unsigned* ctl = (unsigned*)(ws + WS_CTL);
    float* mod = (float*)(ws + WS_MOD); float* cosT = (float*)(ws + WS_COS); float* sinT = (float*)(ws + WS_SIN);
    bf16* W1 = (bf16*)(ws + WS_W1); bf16* WPS = (bf16*)(ws + WS_WPS); bf16* WPB = (bf16*)(ws + WS_WPB); bf16* WO = (bf16*)(ws + WS_WO); bf16* WF1 = (bf16*)(ws + WS_WF1); bf16* WF2 = (bf16*)(ws + WS_WF2);
    bf16* BA = (bf16*)(ws + WS_A); bf16* BB = (bf16*)(ws + WS_B); unsigned char* H8 = ws + WS_H8; unsigned char* W8G = ws + WS_W8G; unsigned char* W8F = ws + WS_W8F;
    float* SH = (float*)(ws + WS_SH); float* S2 = (float*)(ws + WS_S2); float* SG = (float*)(ws + WS_SG); float* SF = (float*)(ws + WS_SF);
    unsigned char* W8O = ws + WS_W8O; unsigned char* U8 = ws + WS_U8; float* SU = (float*)(ws + WS_SU); float* SO = (float*)(ws + WS_SO); int* CO = (int*)(ws + WS_CO);
    bf16* QA = (bf16*)(ws + WS_C); bf16* KA = (bf16*)(ws + WS_C + 64 * MiB); bf16* VA = (bf16*)(ws + WS_C + 80 * MiB); bf16* QB = (bf16*)(ws + WS_C + 96 * MiB);
    bf16* KB = (bf16*)(ws + WS_C + 160 * MiB); bf16* VB = (bf16*)(ws + WS_C + 224 * MiB); bf16* GT = (bf16*)(ws + WS_C + 288 * MiB); bf16* UB = (bf16*)(ws + WS_C);
    bf16* ATT_SWA = BB; bf16* ATT_SB = BB + (size_t)M * 2048;
    for (int u = F.tid; u < (LDS_BYTES - LDSCTL_OFF) / 4; u += NWAVES * 64) ((LAS unsigned*)(F.lds + LDSCTL_OFF))[u] = 0u;
    __syncthreads();
    XcdBarrier bar = xcd_barrier_post(ctl + CW_BAR, (volatile LAS unsigned*)(F.lds + MISC_OFF) + 8);

    const int lo = args.ph_lo, hi = args.ph_hi;
#define IN(k) (lo <= (k) && (k) < hi)
#define BOTH(k) (IN(k) && IN((k) + 1))
    for (int rep_ = 0; rep_ < ((DUP_PHASE == 0) ? 2 : 1); ++rep_) if (IN(0)) {
        if (rep_) xcd_barrier(bar);
    {
        for (int sr_ = 0; sr_ < ((DUP_SUB == 3) ? 2 : 1); ++sr_) p0_gemv(F, args, mod);
        p0_rope_table(F, cosT, sinT);
        {
            constexpr int NSLAB = 1920;
#define SLAB_DECODE(sd, s_) do { int q_ = (s_); \
                if (q_ < 128) { sd = SDesc{args.w_in, W8G, SG, D_IN, 16 * q_, 0, 1}; break; } q_ -= 128; \
                if (q_ < 256) { sd = SDesc{args.w_in, W8G, SG, D_IN, 3072 + 16 * q_, 2048 - 3072, 0}; break; } q_ -= 256; \
                if (q_ < 512) { sd = SDesc{args.w_bg, W8G, SG, NG, 16 * q_, 6144, 0}; break; } q_ -= 512; \
                sd = SDesc{args.w_f1, W8F, SF, FF, 16 * q_, 0, 0}; } while (0)
            int stid = F.tid; asm volatile("" : "+v"(stid)); const int slane = stid & 63, swave = __builtin_amdgcn_readfirstlane(stid >> 6);
            const int nmine = 7 + ((F.G == 256 && F.vcu >= 128) ? 1 : 0);
            auto slab_of = [&](int i) -> int { if (F.G == 256) return i < 7 ? 256 * i + F.vcu : 1792 + F.vcu - 128; return F.vcu + i * F.G; };
            auto have = [&](int i) -> bool { if (F.G == 256) return i < nmine; return F.vcu + i * F.G < NSLAB; };
            for (int sr_ = 0; sr_ < ((DUP_SUB == 1) ? 2 : 1); ++sr_) if (have(0)) {
                SDesc sc_; SLAB_DECODE(sc_, slab_of(0)); f32x4 va0[8], vb0[8], va1[8], vb1[8]; slab_load<0>(sc_, va0, vb0, stid); slab_load<1>(sc_, va1, vb1, stid);
                for (int i = 0;; ++i) {
                    const bool more = have(i + 1); SDesc sn_ = sc_; if (more) SLAB_DECODE(sn_, slab_of(i + 1));
                    slab_stage<0>(F.lds, va0, vb0, stid); asm volatile("" ::: "memory");
                    if (more) slab_load<0>(sn_, va0, vb0, stid);
                    asm volatile("" ::: "memory");
                    slab_stage<1>(F.lds, va1, vb1, stid); asm volatile("" ::: "memory");
                    if (more) slab_load<1>(sn_, va1, vb1, stid);
                    __syncthreads();
                    slab_quant(sc_, F.lds, swave, slane);
                    __syncthreads();
                    if (!more) break;
                    sc_ = sn_;
                }
            }
#undef SLAB_DECODE
            {
                unsigned* kcnt = ctl + CW_KS; unsigned* cmx = (unsigned*)(ws + WS_CMX);
                int it = F.vcu;
                if (it < 1024) {
                    SDesc sc_{args.w_f2 + (size_t)(it & 3) * 4096 * D, W8O, SO, D, 16 * (it >> 2), 0, 0};
                    f32x4 va0[8], vb0[8], va1[8], vb1[8]; slab_load<0>(sc_, va0, vb0, stid); slab_load<1>(sc_, va1, vb1, stid);
                    for (;;) {
                        const int cs = it >> 2, q = it & 3, itn = it + F.G; const bool more = itn < 1024;
                        slab_stage<0>(F.lds, va0, vb0, stid); slab_stage<1>(F.lds, va1, vb1, stid);
                        __syncthreads();
                        {
                            unsigned got = 0u;
#pragma unroll 1
                            for (int rr = 0; rr < 2; ++rr) { const int n = 2 * swave + rr; float am = 0.f;
#pragma unroll
                                for (int j = 0; j < 8; ++j) { const v4u w = *(const LAS v4u*)(F.lds + n * SLAB_PITCH + 16 * (slane + 64 * j));
#pragma unroll
                                    for (int e = 0; e < 4; ++e) { const unsigned x = w[e]; am = fmaxf(am, fmaxf(__builtin_fabsf(__uint_as_float(x << 16)), __builtin_fabsf(__uint_as_float(x & 0xffff0000u)))); } }
                                am = wave_max(am);
                                if (slane == 0) got |= atomicMax(cmx + 16 * cs + n, __float_as_uint(am)); }
                            asm volatile("" :: "v"(got));
                        }
                        asm volatile("s_waitcnt vmcnt(0)" ::: "memory");
                        __syncthreads();
                        if (stid == 0) { (void)xb_add(&kcnt[cs], 1u); XB_SPIN(xb_ld(&kcnt[cs]) < 4u, ctl + CW_BAR); }
                        __syncthreads();
                        const unsigned mb0 = xb_ld(cmx + 16 * cs + 2 * swave), mb1 = xb_ld(cmx + 16 * cs + 2 * swave + 1);
                        SDesc sn_ = sc_;
                        if (more) { sn_ = SDesc{args.w_f2 + (size_t)(itn & 3) * 4096 * D, W8O, SO, D, 16 * (itn >> 2), 0, 0}; slab_load<0>(sn_, va0, vb0, stid); slab_load<1>(sn_, va1, vb1, stid); }
                        ks_quant(F.lds, W8O, SO, CO, cs, q, mb0, mb1, swave, slane);
                        __syncthreads();
                        if (!more) break;
                        it = itn; sc_ = sn_;
                    }
                }
            }
        }
        LAS float* scr = (LAS float*)(F.lds + F.wave * 16640);
        const int gw = F.vcu * NWAVES + F.wave, NGW = F.G * NWAVES;
        constexpr int I_IN = (D / 64) * 48, I_PS = (2048 / 64) * (D / 64), I_O = (D / 64) * (D / 64);
        constexpr int NITEMS = I_IN + 2 * I_PS + I_O;
#define P0_DECODE(t, it) do { int r_ = (it); \
            if (r_ < I_IN) { const int kb_ = r_ / 48, nb_ = r_ % 48; t = TDesc{args.w_in, W1, D, D_IN, 0, 2560, kb_ * (D_IN / 64) + (nb_ < 16 ? 32 + nb_ : 96 + nb_), 0}; break; } r_ -= I_IN; \
            if (r_ < I_PS) { t = TDesc{args.w_ps, WPS, 2048, D, 0, 0, r_, 0}; break; } r_ -= I_PS; \
            if (r_ < I_PS) { t = TDesc{args.w_pb, WPB, 2048, D, 0, 0, r_, 0}; break; } r_ -= I_PS; \
            t = TDesc{args.w_out, WO, D, D, 0, 0, r_, 0}; } while (0)
        for (int sr_ = 0; sr_ < ((DUP_SUB == 2) ? 2 : 1); ++sr_) { int it = gw;
        if (it < NITEMS) {
            TDesc tc; P0_DECODE(tc, it); f32x4 vc[16]; p0_tr_load(tc, vc, F.lane);
            for (;;) {
                const int itn = it + NGW; const bool more = itn < NITEMS;
                TDesc tn = tc; f32x4 vn[16];
                if (more) { P0_DECODE(tn, itn); p0_tr_load(tn, vn, F.lane); }
                p0_tr_store(tc, vc, scr, F.lane);
                if (!more) break;
                tc = tn; it = itn;
#pragma unroll
                for (int i = 0; i < 16; ++i) vc[i] = vn[i];
            }
        } }
#undef P0_DECODE
    }
        if (BOTH(0)) xcd_barrier(bar);
    }
    for (int rep_ = 0; rep_ < ((DUP_PHASE == 1) ? 2 : 1); ++rep_) if (IN(1)) {
        if (rep_) xcd_barrier(bar);
    p1_rows(F, args, mod, BA, H8, SH);
        if (BOTH(1)) xcd_barrier(bar);
    }
    for (int rep_ = 0; rep_ < ((DUP_PHASE == 2) ? 2 : 1); ++rep_) if (IN(2)) {
        if (rep_) xcd_barrier(bar);
    {
        { pg8::Gemm g{BA, W1, BA, W1, M, NB16, D}; pg8::StaticOrder S; S.init(M, NB16, F.G, (int)blockIdx.x);
          pg8::EpiProj E{KA, VA, VB, cosT, sinT};
          pg8::gemm_phase<pg8::EpiProj, pg8::StaticOrder, true, true>(F.lds + RING_OFF, g, S, E); }
        { pg8::Gemm g{(const bf16*)H8, (const bf16*)W8G, (const bf16*)H8, (const bf16*)W8G, M, NI8, D / 2}; pg8::StaticOrder S; S.init(M, NI8, F.G, (int)blockIdx.x);
          pg8::EpiI8Proj E{QA, QB, KB, GT, cosT, sinT, args.b_bg, SH, SG, 0.12751743f  };
          pg8::gemm_phase<pg8::EpiI8Proj, pg8::StaticOrder, true, true, true>(F.lds + RING_OFF, g, S, E); }
    }
        if (BOTH(2)) xcd_barrier(bar);
    }
    for (int rep_ = 0; rep_ < ((DUP_PHASE == 3) ? 2 : 1); ++rep_) if (IN(3)) {
        if (rep_) xcd_barrier(bar);
    {
        int atid = F.tid; asm volatile("" : "+v"(atid)); const int alane = atid & 63, awave = __builtin_amdgcn_readfirstlane(atid >> 6);
        const int nq = (F.vcu < 256) ? (256 - F.vcu + F.G - 1) / F.G : 0, ntot = 8 * nq;
#define P3_GET(idx, u, md) do { const int i_ = (idx); if (i_ < 4 * nq) { const int quad = F.vcu + (i_ >> 2) * F.G, j = i_ & 3, bh = quad >> 2, r = quad & 3, hh = bh & 15; \
            (u) = att::AUnit{QB + hh * HD, KB + hh * HD, VB + hh * HD, ATT_SB + hh * HD, 2048, 2048, 2048, bh >> 4, (j == 0) ? 15 - r : (j == 1) ? 11 - r : (j == 2) ? 4 + r : r, 0.f, 0, args.sinks}; (md) = 1; } \
          else { const int i2_ = i_ - 4 * nq, quad = F.vcu + (i2_ >> 2) * F.G, id = quad * 4 + (i2_ & 3), g_ = (id >> 6) & 3; \
            (u) = att::AUnit{QA + 4 * g_ * HD, KA + g_ * HD, VA + g_ * HD, ATT_SWA + 4 * g_ * HD, 2048, 512, 2048, id >> 8, id & 63, 0.f, 1, args.sinks + 4 * g_}; (md) = 0; } } while (0)
        if (ntot > 0) {
            att::AUnit cur, nxt; int mcur = 0, mnxt = 0; att::bf16x8 qf[8]; att::u32x4 kr0, kr1, vr0, vr1;
            P3_GET(0, cur, mcur); nxt = cur; att::attn_prefetch(cur, qf, kr0, kr1, vr0, vr1, atid, awave, alane);
            for (int idx = 0; idx < ntot; ++idx) { const bool hn = idx + 1 < ntot; if (hn) P3_GET(idx + 1, nxt, mnxt);
                if (mcur) att::attn_unit<1, (SB_EARLY != 0)>(F.lds, cur, hn, nxt, qf, kr0, kr1, vr0, vr1, atid, awave, alane);
                else      att::attn_unit<0, false>(F.lds, cur, hn, nxt, qf, kr0, kr1, vr0, vr1, atid, awave, alane);
                cur = nxt; mcur = mnxt; }
        }
#undef P3_GET
    }
        if (BOTH(3)) xcd_barrier(bar);
    }
    for (int rep_ = 0; rep_ < ((DUP_PHASE == 4) ? 2 : 1); ++rep_) if (IN(4)) {
        if (rep_) xcd_barrier(bar);
    {
        pg8::Gemm g{ATT_SWA, WPS, ATT_SB, WPB, M, D, 2048}; pg8::PairOrder S; S.S.init(M, D, F.G, (int)blockIdx.x);
        pg8::EpiMix E{{}, 0, 0, 0, 0, BA, (const unsigned char*)GT};
        pg8::gemm_phase<pg8::EpiMix, pg8::PairOrder, true, true>(F.lds + RING_OFF, g, S, E);
    }
        if (BOTH(4)) xcd_barrier(bar);
    }
    for (int rep_ = 0; rep_ < ((DUP_PHASE == 5) ? 2 : 1); ++rep_) if (IN(5)) {
        if (rep_) xcd_barrier(bar);
    {
        pg8::Gemm g{BA, WO, BA, WO, M, D, D}; pg8::StaticOrder S; S.init(M, D, F.G, (int)blockIdx.x);
        pg8::EpiSimple<0> E{BB, D};
        pg8::gemm_phase<pg8::EpiSimple<0>, pg8::StaticOrder, true, true>(F.lds + RING_OFF, g, S, E);
    }
        if (BOTH(5)) xcd_barrier(bar);
    }
    for (int rep_ = 0; rep_ < ((DUP_PHASE == 6) ? 2 : 1); ++rep_) if (IN(6)) {
        if (rep_) xcd_barrier(bar);
    p6_rows(F, args, mod, BB, (unsigned char*)BA, S2);
        if (BOTH(6)) xcd_barrier(bar);
    }
#ifndef IDLE_US
#define IDLE_US 0
#endif
    if (IDLE_US > 0 && IN(7)) { const unsigned long long t0_ = __builtin_amdgcn_s_memrealtime(); while (__builtin_amdgcn_s_memrealtime() - t0_ < (unsigned long long)IDLE_US * 100ull) __builtin_amdgcn_s_sleep(127); }
    for (int rep_ = 0; rep_ < ((DUP_PHASE == 7) ? 2 : 1); ++rep_) if (IN(7)) {
        if (rep_) xcd_barrier(bar);
    {
        pg8::Gemm g{BA, (const bf16*)W8F, BA, (const bf16*)W8F, M, FF, D / 2}; pg8::StaticOrder S; S.init(M, FF, F.G, (int)blockIdx.x);
        pg8::EpiRelu2I8 E{UB, FF, S2, SF};
        pg8::gemm_phase<pg8::EpiRelu2I8, pg8::StaticOrder, true, true, true>(F.lds + RING_OFF, g, S, E);
    }
        if (BOTH(7)) xcd_barrier(bar);
    }
    for (int rep_ = 0; rep_ < ((DUP_PHASE == 8) ? 2 : 1); ++rep_) if (IN(8)) {
        if (rep_) xcd_barrier(bar);
    {
        requant_u(F, UB, U8, SU);
        xcd_barrier(bar);
        pg8::Gemm g{(const bf16*)U8, (const bf16*)W8O, (const bf16*)U8, (const bf16*)W8O, M, D, FF / 2}; pg8::StaticOrder S; S.init(M, D, F.G, (int)blockIdx.x, P8_WGM);
        pg8::EpiFfOutI8 E{BB, D, SU, SO, CO};
        pg8::gemm_phase<pg8::EpiFfOutI8, pg8::StaticOrder, true, true, true>(F.lds + RING_OFF, g, S, E);
    }
        if (BOTH(8)) xcd_barrier(bar);
    }
    for (int rep_ = 0; rep_ < ((DUP_PHASE == 9) ? 2 : 1); ++rep_) if (IN(9)) {
        if (rep_) xcd_barrier(bar);
    p9_rows(F, args, mod, BB);
        if (BOTH(9)) xcd_barrier(bar);
    }
#undef IN
#undef BOTH
}

extern "C" void kernel_launch(void* const* d_in, const int* in_sizes, int n_in, void* d_out, int out_size, void* d_ws, size_t ws_size, hipStream_t stream) {
    static int grid = 0;
    if (grid == 0) {
        if (n_in != 17 || in_sizes[0] != M * D || out_size != M * D || ws_size < WS_END) { fprintf(stderr, "kernel_launch: unexpected shapes / workspace (n_in %d, in0 %d, out %d, ws %zu, need %zu); nothing launched\n", n_in, n_in > 0 ? in_sizes[0] : -1, out_size, ws_size, (size_t)WS_END); grid = -1; return; }
        int dev = 0, cus = 0, per_cu = 0;
        if (hipGetDevice(&dev) != hipSuccess || hipDeviceGetAttribute(&cus, hipDeviceAttributeMultiprocessorCount, dev) != hipSuccess) { fprintf(stderr, "kernel_launch: device query failed\n"); grid = -1; return; }
        if (hipFuncSetAttribute((const void*)fwd_kernel, hipFuncAttributeMaxDynamicSharedMemorySize, LDS_BYTES) != hipSuccess) { fprintf(stderr, "kernel_launch: hipFuncSetAttribute failed\n"); grid = -1; return; }
        if (hipOccupancyMaxActiveBlocksPerMultiprocessor(&per_cu, (const void*)fwd_kernel, NWAVES * 64, LDS_BYTES) != hipSuccess || per_cu < 1) { fprintf(stderr, "kernel_launch: occupancy query says %d blocks per CU\n", per_cu); }
        (void)hipGetLastError();
        grid = cus & ~7;
    }
    if (grid < 0) return;
    if (hipMemsetAsync((char*)d_ws + WS_CTL, 0, CTL_ZERO_BYTES, stream) != hipSuccess) { fprintf(stderr, "kernel_launch: memset failed\n"); return; }
    Args a{};
    a.x = (const float*)d_in[0]; a.c = (const float*)d_in[1]; a.w_ada = (const float*)d_in[2]; a.b_ada = (const float*)d_in[3]; a.g_pre_mix = (const float*)d_in[4]; a.g_post_mix = (const float*)d_in[5];
    a.g_pre_mlp = (const float*)d_in[6]; a.g_post_mlp = (const float*)d_in[7]; a.w_in = (const float*)d_in[8]; a.sinks = (const float*)d_in[9]; a.w_bg = (const float*)d_in[10]; a.b_bg = (const float*)d_in[11];
    a.w_ps = (const float*)d_in[12]; a.w_pb = (const float*)d_in[13]; a.w_out = (const float*)d_in[14]; a.w_f1 = (const float*)d_in[15]; a.w_f2 = (const float*)d_in[16];
    a.out = (float*)d_out; a.ws = (unsigned char*)d_ws;
#ifndef MK_N_LAUNCHES
#define MK_N_LAUNCHES 1
#ifndef DUP_PHASE
#define DUP_PHASE -1
#endif
#endif
    constexpr int NPH = 10;
    for (int li = 0; li < MK_N_LAUNCHES; ++li) {
        a.ph_lo = (MK_N_LAUNCHES == 1) ? 0 : li; a.ph_hi = (MK_N_LAUNCHES == 1) ? NPH : li + 1;
        hipLaunchKernelGGL(fwd_kernel, dim3(grid), dim3(NWAVES * 64), LDS_BYTES, stream, a);
        const hipError_t le = hipPeekAtLastError();
        if (le != hipSuccess) { fprintf(stderr, "kernel_launch: launch failed: %s\n", hipGetErrorName(le)); break; }
    }
}
```
